# Optimizing an MI355X kernel written in HIP

```python
import math
import jax, jax.numpy as jnp
from jax import lax
import numpy as np

D_MODEL = 1024
BATCH = 8
SEQ = 8192
DEPTH = 1

MEM_LEN = 256
HEAD_DIM = 64
N_ATTN_HEADS = 8
ROT_DIM = HEAD_DIM // 4
ROPE_THETA = 500000.0
DILATED_PATTERNS = ((128, 1), (512, 4), (2048, 16))
N_RET_HEADS = 4
RET_QK_DIM = 64
RET_V_DIM = 128
RET_CHUNK = 128
RET_THETA = 10000.0
N_MEM_HEADS = 4
MEM_HEAD_DIM = D_MODEL // N_MEM_HEADS
D_FF = 2816
EPS = 1e-6
NEG_INF = -1e30

ATTN_WIDTH = N_ATTN_HEADS * HEAD_DIM
RET_QK_WIDTH = N_RET_HEADS * RET_QK_DIM
RET_WIDTH = N_RET_HEADS * RET_V_DIM
MIX_WIDTH = ATTN_WIDTH + RET_WIDTH
IN_SPLITS = (ATTN_WIDTH, ATTN_WIDTH, ATTN_WIDTH, RET_QK_WIDTH, RET_QK_WIDTH, RET_WIDTH, RET_WIDTH)
IN_COLS = sum(IN_SPLITS)

kernel_name = "hymba_dilated_retention_macaron"


def rmsnorm(x, w):
    x32 = x.astype(jnp.float32)
    y = x32 * lax.rsqrt(jnp.mean(x32 * x32, axis=-1, keepdims=True) + EPS)
    return (y * w.astype(jnp.float32)).astype(x.dtype)


def rotary(x, pos, rot_dim, theta):
    half = rot_dim // 2
    inv = jnp.exp(-math.log(theta) * jnp.arange(half, dtype=jnp.float32) / half)
    ang = pos.astype(jnp.float32)[:, None] * inv[None, :]
    cos = jnp.cos(ang)[None, :, None, :]
    sin = jnp.sin(ang)[None, :, None, :]
    x1 = x[..., :half].astype(jnp.float32)
    x2 = x[..., half:rot_dim].astype(jnp.float32)
    rot = jnp.concatenate([x1 * cos - x2 * sin, x1 * sin + x2 * cos], axis=-1).astype(x.dtype)
    return jnp.concatenate([rot, x[..., rot_dim:]], axis=-1)


def dilated_window_attention(q, k, v, window, dilation):
    B, S, H, Dh = q.shape
    blk = window // dilation
    span = blk * dilation
    s_pad = -(-S // span) * span
    nb = s_pad // span

    def blocks(a):
        a = jnp.pad(a, ((0, 0), (0, s_pad - S), (0, 0), (0, 0)))
        return a.reshape(B, nb, blk, dilation, H, Dh)

    def with_prev(a):
        prev = jnp.pad(a, ((0, 0), (1, 0), (0, 0), (0, 0), (0, 0), (0, 0)))[:, :-1]
        return jnp.concatenate([prev, a], axis=2)

    qb = blocks(q)
    kk = with_prev(blocks(k))
    vv = with_prev(blocks(v))
    s = jnp.einsum('bnqrhd,bnkrhd->bnrhqk', qb, kk).astype(jnp.float32) * (Dh ** -0.5)
    qi = jnp.arange(blk)[:, None]
    kj = jnp.arange(2 * blk)[None, :]
    dist = blk + qi - kj
    band = (dist >= 0) & (dist <= blk)
    not_before_start = (jnp.arange(nb)[:, None, None] > 0) | (kj >= blk)[None]
    mask = band[None] & not_before_start
    s = jnp.where(mask[None, :, None, None], s, NEG_INF)
    m = jnp.max(s, axis=-1, keepdims=True)
    p = jnp.exp(s - m)
    denom = jnp.sum(p, axis=-1, keepdims=True)
    lse = (m + jnp.log(denom))[..., 0]
    o = jnp.einsum('bnrhqk,bnkrhd->bnqrhd', (p / denom).astype(v.dtype), vv)
    o = o.reshape(B, s_pad, H, Dh)[:, :S]
    lse = lse.transpose(0, 1, 4, 2, 3).reshape(B, s_pad, H)[:, :S]
    return o, lse


def mixture_of_dilations(q, k, v):
    outs, lses = [], []
    for window, dilation in DILATED_PATTERNS:
        o, lse = dilated_window_attention(q, k, v, window, dilation)
        outs.append(o)
        lses.append(lse)
    wts = jax.nn.softmax(jnp.stack(lses, axis=0), axis=0)
    o = jnp.einsum('gbsh,gbshd->bshd', wts, jnp.stack(outs, axis=0).astype(jnp.float32))
    return o.astype(q.dtype)


def retention_decays():
    return jnp.log1p(-(2.0 ** (-5.0 - jnp.arange(N_RET_HEADS, dtype=jnp.float32))))


def chunkwise_retention(q, k, v):
    B, S, H, dk = q.shape
    dv = v.shape[-1]
    C = RET_CHUNK
    N = S // C
    log_g = retention_decays()
    k = k * (dk ** -0.5)
    qc = q.reshape(B, N, C, H, dk)
    kc = k.reshape(B, N, C, H, dk)
    vc = v.reshape(B, N, C, H, dv)
    idx = jnp.arange(C, dtype=jnp.float32)
    diff = idx[:, None] - idx[None, :]
    decay_mask = jnp.where(diff[None] >= 0, jnp.exp(log_g[:, None, None] * jnp.maximum(diff, 0.0)[None]), 0.0)
    inner = jnp.einsum('bnqhd,bnkhd->bnhqk', qc, kc) * decay_mask[None, None]
    o_inner = jnp.einsum('bnhqk,bnkhe->bnqhe', inner, vc)
    k_decay = jnp.exp(log_g[:, None] * (C - 1 - idx)[None])
    kv = jnp.einsum('bnkhd,hk,bnkhe->bnhde', kc, k_decay, vc)
    chunk_decay = jnp.exp(log_g * C)[:, None, None]

    def step(R, kv_i):
        return chunk_decay * R + kv_i, R

    R0 = jnp.zeros((B, H, dk, dv), kv.dtype)
    _, R_prev = lax.scan(step, R0, jnp.moveaxis(kv, 1, 0))
    R_prev = jnp.moveaxis(R_prev, 0, 1)
    q_decay = jnp.exp(log_g[:, None] * (idx + 1.0)[None])
    o_cross = jnp.einsum('bnqhd,hq,bnhde->bnqhe', qc, q_decay, R_prev)
    return (o_inner + o_cross).reshape(B, S, H, dv)


def hybrid_mixer(h, w_in, w_out):
    B, S, _ = h.shape
    pos = jnp.arange(S)
    proj = h @ w_in
    aq, ak, av, rq, rk, rv, rg = jnp.split(proj, list(np.cumsum(IN_SPLITS)[:-1]), axis=-1)
    aq = rotary(aq.reshape(B, S, N_ATTN_HEADS, HEAD_DIM), pos, ROT_DIM, ROPE_THETA)
    ak = rotary(ak.reshape(B, S, N_ATTN_HEADS, HEAD_DIM), pos, ROT_DIM, ROPE_THETA)
    av = av.reshape(B, S, N_ATTN_HEADS, HEAD_DIM)
    o_attn = mixture_of_dilations(aq, ak, av).reshape(B, S, ATTN_WIDTH)
    rq = rotary(rq.reshape(B, S, N_RET_HEADS, RET_QK_DIM), pos, RET_QK_DIM, RET_THETA)
    rk = rotary(rk.reshape(B, S, N_RET_HEADS, RET_QK_DIM), pos, RET_QK_DIM, RET_THETA)
    rv = rv.reshape(B, S, N_RET_HEADS, RET_V_DIM)
    r = chunkwise_retention(rq, rk, rv).astype(jnp.float32)
    r = r * lax.rsqrt(jnp.mean(r * r, axis=-1, keepdims=True) + EPS)
    o_ret = (jax.nn.silu(rg.astype(jnp.float32)) * r.reshape(B, S, RET_WIDTH)).astype(h.dtype)
    return jnp.concatenate([o_attn, o_ret], axis=-1) @ w_out


def memory_cross_attention(h, mem_n, w_cq, w_ckv, w_co):
    B, S, _ = h.shape
    M = mem_n.shape[1]
    q = (h @ w_cq).reshape(B, S, N_MEM_HEADS, MEM_HEAD_DIM)
    k, v = jnp.split(mem_n @ w_ckv, 2, axis=-1)
    k = k.reshape(B, M, N_MEM_HEADS, MEM_HEAD_DIM)
    v = v.reshape(B, M, N_MEM_HEADS, MEM_HEAD_DIM)
    s = jnp.einsum('bshd,bmhd->bhsm', q, k).astype(jnp.float32) * (MEM_HEAD_DIM ** -0.5)
    p = jax.nn.softmax(s, axis=-1).astype(v.dtype)
    o = jnp.einsum('bhsm,bmhd->bshd', p, v).reshape(B, S, D_MODEL)
    return o @ w_co


def swiglu(h, w_in, w_out):
    g, u = jnp.split(h @ w_in, 2, axis=-1)
    return (jax.nn.silu(g) * u) @ w_out


def setup_inputs(seed: int = 0) -> dict:
    key = jax.random.key(seed)
    ks = jax.random.split(key, 20)

    def w(k, shape, fan_in):
        return jax.random.normal(k, shape, jnp.float32) * (fan_in ** -0.5)

    def gain(k, shape):
        return 1.0 + 0.01 * jax.random.normal(k, shape, jnp.float32)

    L = DEPTH
    return {
        "x": jax.random.normal(ks[0], (BATCH, SEQ, D_MODEL), jnp.float32),
        "mem": jax.random.normal(ks[1], (BATCH, MEM_LEN, D_MODEL), jnp.float32),
        "norm_ffn1": gain(ks[2], (L, D_MODEL)),
        "w_ffn1_in": w(ks[3], (L, D_MODEL, 2 * D_FF), D_MODEL),
        "w_ffn1_out": w(ks[4], (L, D_FF, D_MODEL), D_FF),
        "norm_mix": gain(ks[5], (L, D_MODEL)),
        "w_in": w(ks[6], (L, D_MODEL, IN_COLS), D_MODEL),
        "w_out": w(ks[7], (L, MIX_WIDTH, D_MODEL), MIX_WIDTH),
        "norm_cross": gain(ks[8], (L, D_MODEL)),
        "norm_mem": gain(ks[9], (L, D_MODEL)),
        "w_cq": w(ks[10], (L, D_MODEL, D_MODEL), D_MODEL),
        "w_ckv": w(ks[11], (L, D_MODEL, 2 * D_MODEL), D_MODEL),
        "w_co": w(ks[12], (L, D_MODEL, D_MODEL), D_MODEL),
        "norm_ffn2": gain(ks[13], (L, D_MODEL)),
        "w_ffn2_in": w(ks[14], (L, D_MODEL, 2 * D_FF), D_MODEL),
        "w_ffn2_out": w(ks[15], (L, D_FF, D_MODEL), D_FF),
        "norm_final": gain(ks[16], (D_MODEL,)),
    }


def reference(x, mem, norm_ffn1, w_ffn1_in, w_ffn1_out, norm_mix, w_in, w_out,
              norm_cross, norm_mem, w_cq, w_ckv, w_co, norm_ffn2, w_ffn2_in, w_ffn2_out,
              norm_final):
    for l in range(DEPTH):
        x = x + 0.5 * swiglu(rmsnorm(x, norm_ffn1[l]), w_ffn1_in[l], w_ffn1_out[l])
        x = x + hybrid_mixer(rmsnorm(x, norm_mix[l]), w_in[l], w_out[l])
        x = x + memory_cross_attention(rmsnorm(x, norm_cross[l]), rmsnorm(mem, norm_mem[l]),
                                       w_cq[l], w_ckv[l], w_co[l])
        x = x + 0.5 * swiglu(rmsnorm(x, norm_ffn2[l]), w_ffn2_in[l], w_ffn2_out[l])
    return rmsnorm(x, norm_final)
```

```cpp
#include <hip/hip_runtime.h>
#include <cstdio>
#include <cstdint>
#include <cmath>

#define DI __device__ __forceinline__

constexpr int D = 1024, NB_ALL = 8, SEQ = 8192, MEMLEN = 256, DFF = 2816, INC = 3072;
constexpr int NBATCH = 8;
constexpr int M = NBATCH * SEQ;
constexpr int MROWS = NBATCH * MEMLEN;
constexpr float EPS = 1e-6f;
constexpr float LOG2E = 1.4426950408889634f;

typedef unsigned short bf16_t;
typedef short bf16x8 __attribute__((ext_vector_type(8)));
typedef float f32x4 __attribute__((ext_vector_type(4)));
typedef float f32x2 __attribute__((ext_vector_type(2)));
typedef unsigned u32x4 __attribute__((ext_vector_type(4)));
typedef unsigned u32x2 __attribute__((ext_vector_type(2)));
#define LAS __attribute__((address_space(3)))
#define GAS __attribute__((address_space(1)))

DI int otid() { int t = threadIdx.x; asm volatile("" : "+v"(t)); return t; }
DI float bf2f(unsigned u16) { return __uint_as_float(u16 << 16); }
DI unsigned cvt_pk_bf16(float lo, float hi) { unsigned r; asm volatile("v_cvt_pk_bf16_f32 %0, %1, %2" : "=v"(r) : "v"(lo), "v"(hi)); return r; }
DI float fast_exp2(float x) { return __builtin_amdgcn_exp2f(x); }
DI float fast_rcp(float x) { return __builtin_amdgcn_rcpf(x); }
DI float silu_f(float x) { return x * fast_rcp(1.0f + fast_exp2(-x * LOG2E)); }


DI size_t hm_off(int secoff, int nheads, int hw, int b, int head, int t) { return (size_t)M * secoff + ((size_t)(b * nheads + head) * SEQ + t) * hw; }

namespace pg8 {
constexpr int BM = 256, BK = 64, HALF = 128, HTB = HALF * BK * 2, STAGE_BYTES = 8 * HTB, NXCD = 8, WGM = 8;
constexpr int EPI_SCR = STAGE_BYTES;
constexpr int EPI_RS = EPI_SCR + 4096, EPI_RS_MAX = 24;
__host__ __device__ __forceinline__ int lds_byte(int r, int c) { const int st = (r >> 4) * 2 + (c >> 5), rr = r & 15, cc = c & 31, ob = rr * 64 + cc * 2; return st * 1024 + (ob ^ (((ob >> 9) & 1) << 5)); }
__host__ __device__ __forceinline__ void stage_rc(int b, int& R, int& C) { const int st = b / 1024, sb = b % 1024, swz = sb ^ (((sb >> 9) & 1) << 5); R = (st >> 1) * 16 + swz / 64; C = (st & 1) * 32 + (swz % 64) / 2; }
__host__ __device__ __forceinline__ int perm32(int rho) { const int n = rho >> 4, i = rho & 15; return 8 * (i >> 2) + 4 * n + (i & 3); }

struct Unit { int pm, pn, z; };
struct Gemm { const bf16_t* A; const bf16_t* Bt; int lda, ldb, K; };

struct StaticOrder {
    int nM, nN, nwg, G, c, lda, ldb;
    DI void init(int M_, int N_, int G_, int c_, int lda_, int ldb_) { nM = M_ / BM; nN = N_ / BM; nwg = nM * nN; G = G_; c = c_; lda = lda_; ldb = ldb_; }
    DI bool next(int i, Unit& u) const {
        const long L = (long)i * G + c; if (L >= nwg) return false;
        int wgid = (int)L; { const int q = nwg / NXCD, r = nwg % NXCD, xcd = wgid % NXCD, off = wgid / NXCD; wgid = (xcd < r ? xcd * (q + 1) : r * (q + 1) + (xcd - r) * q) + off; }
        const int nig = WGM * nN, gid = wgid / nig, fm = gid * WGM, gsz = (nM - fm) < WGM ? (nM - fm) : WGM;
        u.pm = fm + ((wgid % nig) % gsz); u.pn = (wgid % nig) / gsz; u.z = 0; return true;
    }
    DI size_t a_off(const Unit& u) const { return (size_t)u.pm * BM * lda; }
    DI size_t b_off(const Unit& u) const { return (size_t)u.pn * BM * ldb; }
};

template <class Epi, class Sched, bool ALIGN_EPI>
DI void gemm_phase(LAS unsigned char* lds, const Gemm g, const Sched& S, const Epi& E) {
    const int tid = otid(), wid = __builtin_amdgcn_readfirstlane(tid >> 6), lane = tid & 63, wr = wid >> 2, wc = wid & 3, fr = lane & 15, fq = lane >> 4;
    const int nt = g.K / BK;
    unsigned voffA[2], voffB[2];
#pragma unroll
    for (int i = 0; i < 2; ++i) { int R, C; stage_rc(tid * 16 + i * 8192, R, C); const int Rb = Epi::PERM ? ((R & ~31) + perm32(R & 31)) : R;
        voffA[i] = (unsigned)(R * g.lda + C) * 2u; voffB[i] = (unsigned)(Rb * g.ldb + C) * 2u; }
    const size_t kstep = (size_t)(BK * 2);
    const size_t hstepA = (size_t)HALF * g.lda * 2, hstepB = (size_t)HALF * g.ldb * 2;
    const unsigned ldsw = (unsigned)wid * 1024u;
    const int aoff = lds_byte(wr * 64 + fr, fq * 8), boff = lds_byte(wc * 32 + fr, fq * 8);
#define PG8_SA(b, h) (((b) * 2 + (h)) * HTB)
#define PG8_SB(b, h) ((4 + (b) * 2 + (h)) * HTB)
#define PG8_STAGE(bufoff, gbase, voff) do { _Pragma("unroll") for (int _i = 0; _i < 2; ++_i) \
        __builtin_amdgcn_global_load_lds((const unsigned*)((const char*)(gbase) + (voff)[_i]), (LAS unsigned*)(lds + (bufoff) + ldsw + _i * 8192), 16, 0, 0); } while (0)
#define PG8_LDA(dst, b, h) do { _Pragma("unroll") for (int m = 0; m < 4; ++m) _Pragma("unroll") for (int k = 0; k < 2; ++k) dst[m][k] = *(const LAS bf16x8*)(lds + PG8_SA(b, h) + aoff + m * 2048 + k * 1024); } while (0)
#define PG8_LDB(dst, b, h) do { _Pragma("unroll") for (int n = 0; n < 2; ++n) _Pragma("unroll") for (int k = 0; k < 2; ++k) dst[n][k] = *(const LAS bf16x8*)(lds + PG8_SB(b, h) + boff + n * 2048 + k * 1024); } while (0)
#define PG8_MMA(ai, bj, At, Bt) do { __builtin_amdgcn_s_setprio(1); _Pragma("unroll") for (int m = 0; m < 4; ++m) _Pragma("unroll") for (int n = 0; n < 2; ++n) _Pragma("unroll") for (int k = 0; k < 2; ++k) \
        acc[ai][bj][m][n] = __builtin_amdgcn_mfma_f32_16x16x32_bf16(Bt[n][k], At[m][k], acc[ai][bj][m][n], 0, 0, 0); __builtin_amdgcn_s_setprio(0); } while (0)
#define PG8_WAIT_V(n) asm volatile("s_waitcnt vmcnt(" #n ")" ::: "memory")
#define PG8_WAIT_L(n) asm volatile("s_waitcnt lgkmcnt(" #n ")" ::: "memory")
#define PG8_BAR __builtin_amdgcn_s_barrier()
#define PG8_SCHED __builtin_amdgcn_sched_barrier(0)
    Unit cur, nxt; int ui = 0;
    if (!S.next(0, cur)) return;
    E.preload(S, lds + EPI_RS);
    f32x4 acc[2][2][4][2];
    E.init(acc, cur, wr, wc, fr, fq);
    bf16x8 At[4][2], B0[2][2], B1[2][2];
    const char* cA = (const char*)(g.A + S.a_off(cur)); const char* cB = (const char*)(g.Bt + S.b_off(cur));
    PG8_STAGE(PG8_SB(0, 0), cB, voffB); PG8_STAGE(PG8_SB(0, 1), cB + hstepB, voffB); PG8_STAGE(PG8_SA(0, 0), cA, voffA); PG8_STAGE(PG8_SA(0, 1), cA + hstepA, voffA);
    if (wr == 1) PG8_BAR;
    PG8_WAIT_V(2); PG8_BAR;
    PG8_STAGE(PG8_SB(1, 0), cB + kstep, voffB); PG8_STAGE(PG8_SA(1, 0), cA + kstep, voffA); PG8_STAGE(PG8_SB(1, 1), cB + hstepB + kstep, voffB);
    PG8_WAIT_V(6); PG8_BAR;
    for (;;) {
        const bool has_next = S.next(ui + 1, nxt);
        const char* nA = has_next ? (const char*)(g.A + S.a_off(nxt)) : cA; const char* nB = has_next ? (const char*)(g.Bt + S.b_off(nxt)) : cB;
        for (int t = 0; t < nt; t += 2) {
            const bool last = (t == nt - 2);
            const char* a1 = cA + (size_t)(t + 1) * kstep;
            const char* a2 = last ? nA : cA + (size_t)(t + 2) * kstep; const char* b2 = last ? nB : cB + (size_t)(t + 2) * kstep;
            const char* a3 = a2 + kstep; const char* b3 = b2 + kstep;
            PG8_LDB(B0, 0, 0); PG8_LDB(B1, 0, 1); PG8_SCHED; PG8_LDA(At, 0, 0); PG8_STAGE(PG8_SA(1, 1), a1 + hstepA, voffA);
            PG8_WAIT_V(8); PG8_WAIT_L(0); PG8_BAR; PG8_MMA(0, 0, At, B0); PG8_MMA(0, 1, At, B1); PG8_BAR; PG8_SCHED;
            PG8_LDA(At, 0, 1); PG8_STAGE(PG8_SB(0, 0), b2, voffB); PG8_STAGE(PG8_SB(0, 1), b2 + hstepB, voffB); PG8_STAGE(PG8_SA(0, 0), a2, voffA);
            PG8_WAIT_V(8); PG8_WAIT_L(0); PG8_BAR; PG8_MMA(1, 0, At, B0); PG8_MMA(1, 1, At, B1); PG8_BAR; PG8_SCHED;
            PG8_LDB(B0, 1, 0); PG8_LDB(B1, 1, 1); PG8_SCHED; PG8_LDA(At, 1, 0); PG8_STAGE(PG8_SA(0, 1), a2 + hstepA, voffA);
            PG8_WAIT_V(8); PG8_WAIT_L(0); PG8_BAR; PG8_MMA(0, 0, At, B0); PG8_MMA(0, 1, At, B1); PG8_BAR; PG8_SCHED;
            PG8_LDA(At, 1, 1); PG8_STAGE(PG8_SB(1, 0), b3, voffB); PG8_STAGE(PG8_SB(1, 1), b3 + hstepB, voffB); PG8_STAGE(PG8_SA(1, 0), a3, voffA);
            PG8_WAIT_V(8); PG8_WAIT_L(0); PG8_BAR; PG8_MMA(1, 0, At, B0); PG8_MMA(1, 1, At, B1); PG8_BAR; PG8_SCHED;
        }
        if constexpr (ALIGN_EPI) { if (wr == 0) PG8_BAR; }
        E(acc, cur, ui, wr, wc, fr, fq, lds + EPI_SCR);
        if (!has_next) break;
        E.init(acc, nxt, wr, wc, fr, fq);
        cur = nxt; cA = nA; cB = nB; ++ui;
        if constexpr (ALIGN_EPI) { if (wr == 1) PG8_BAR; }
    }
    PG8_WAIT_V(0);
    if constexpr (!ALIGN_EPI) { if (wr == 0) PG8_BAR; }
    PG8_BAR;
#undef PG8_SA
#undef PG8_SB
#undef PG8_STAGE
#undef PG8_LDA
#undef PG8_LDB
#undef PG8_MMA
#undef PG8_WAIT_V
#undef PG8_WAIT_L
#undef PG8_BAR
#undef PG8_SCHED
}

DI void zero_acc(f32x4 (&acc)[2][2][4][2]) {
#pragma unroll
    for (int a = 0; a < 2; ++a)
#pragma unroll
        for (int b = 0; b < 2; ++b)
#pragma unroll
            for (int m = 0; m < 4; ++m)
#pragma unroll
                for (int n = 0; n < 2; ++n) acc[a][b][m][n] = (f32x4){0.f, 0.f, 0.f, 0.f};
}
template <class Sched> DI void preload_rstd(const Sched& S, const float* ssq4, LAS unsigned char* tab) {
    const int t = otid(); Unit u;
    if (t < 256) for (int i = 0; i < EPI_RS_MAX && S.next(i, u); ++i) { const f32x4 p = *(const f32x4*)(ssq4 + (size_t)(u.pm * BM + t) * 4);
        ((LAS float*)tab)[i * 256 + t] = rsqrtf(((p[0] + p[1]) + (p[2] + p[3])) * (1.0f / 1024.0f) + EPS); }
}
DI void load_rstd(float (&rs)[2][4], LAS unsigned char* scr, int ui, int wr, int fr) {
    const LAS float* tab = (const LAS float*)(scr + 4096) + ui * 256 + wr * 64 + fr;
#pragma unroll
    for (int ai = 0; ai < 2; ++ai)
#pragma unroll
        for (int m = 0; m < 4; ++m) rs[ai][m] = tab[ai * HALF + m * 16];
}
DI u32x4 pack8(const f32x4 v0, const f32x4 v1) { u32x4 w; w.x = cvt_pk_bf16(v0[0], v0[1]); w.y = cvt_pk_bf16(v0[2], v0[3]); w.z = cvt_pk_bf16(v1[0], v1[1]); w.w = cvt_pk_bf16(v1[2], v1[3]); return w; }

template <bool SCALE> struct EpiSwiGLU {
    static constexpr bool PERM = true;
    bf16_t* O; const float* ssq4;
    template <class Sched> DI void preload(const Sched& S, LAS unsigned char* tab) const { if (SCALE) preload_rstd(S, ssq4, tab); }
    DI void init(f32x4 (&acc)[2][2][4][2], const Unit&, int, int, int, int) const { zero_acc(acc); }
    DI void operator()(const f32x4 (&acc)[2][2][4][2], const Unit& u, int ui, int wr, int wc, int fr_, int fq_, LAS unsigned char* scr) const {
        int l_ = fr_ + 16 * fq_; asm volatile("" : "+v"(l_)); const int fr = l_ & 15, fq = l_ >> 4;
        const int row0 = u.pm * BM + wr * 64 + fr, col0 = u.pn * 128 + wc * 32 + 8 * fq;
        float rs[2][4];
        if (SCALE) load_rstd(rs, scr, ui, wr, fr);
#pragma unroll
        for (int ai = 0; ai < 2; ++ai)
#pragma unroll
            for (int m = 0; m < 4; ++m) { const int row = row0 + ai * HALF + m * 16; const float r = SCALE ? rs[ai][m] : 1.0f;
                f32x4 o0, o1;
#pragma unroll
                for (int i = 0; i < 4; ++i) { o0[i] = silu_f(acc[ai][0][m][0][i] * r) * (acc[ai][1][m][0][i] * r); o1[i] = silu_f(acc[ai][0][m][1][i] * r) * (acc[ai][1][m][1][i] * r); }
                *(u32x4*)(O + (size_t)row * DFF + col0) = pack8(o0, o1); }
    }
};
template <int MODE> struct EpiResid {
    static constexpr bool PERM = true;
    const float* R; float* out; bf16_t* XB; float* ssq4;
    template <class Sched> DI void preload(const Sched&, LAS unsigned char*) const {}
    DI void init(f32x4 (&acc)[2][2][4][2], const Unit& u, int wr, int wc, int fr_, int fq_) const {
        int l_ = fr_ + 16 * fq_; asm volatile("" : "+v"(l_)); const int fr = l_ & 15, fq = l_ >> 4;
        const int row0 = u.pm * BM + wr * 64 + fr, col0 = u.pn * BM + wc * 32 + 8 * fq;
        if (MODE == 0) {
#pragma unroll
            for (int ai = 0; ai < 2; ++ai)
#pragma unroll
                for (int m = 0; m < 4; ++m)
#pragma unroll
                    for (int bj = 0; bj < 2; ++bj) { const float* p = R + (size_t)(row0 + ai * HALF + m * 16) * D + col0 + bj * HALF;
                        acc[ai][bj][m][0] = *(const f32x4*)p; acc[ai][bj][m][1] = *(const f32x4*)(p + 4); }
        } else {
            u32x4 w[2][4][2];
#pragma unroll
            for (int ai = 0; ai < 2; ++ai)
#pragma unroll
                for (int m = 0; m < 4; ++m)
#pragma unroll
                    for (int bj = 0; bj < 2; ++bj) w[ai][m][bj] = *(const u32x4*)(XB + (size_t)(row0 + ai * HALF + m * 16) * D + col0 + bj * HALF);
#pragma unroll
            for (int ai = 0; ai < 2; ++ai)
#pragma unroll
                for (int m = 0; m < 4; ++m)
#pragma unroll
                    for (int bj = 0; bj < 2; ++bj) { const u32x4 x = w[ai][m][bj];
                        acc[ai][bj][m][0] = (f32x4){bf2f(x[0] & 0xffffu), bf2f(x[0] >> 16), bf2f(x[1] & 0xffffu), bf2f(x[1] >> 16)};
                        acc[ai][bj][m][1] = (f32x4){bf2f(x[2] & 0xffffu), bf2f(x[2] >> 16), bf2f(x[3] & 0xffffu), bf2f(x[3] >> 16)}; }
        }
    }
    DI void operator()(const f32x4 (&acc)[2][2][4][2], const Unit& u, int ui, int wr, int wc, int fr_, int fq_, LAS unsigned char* scr) const {
        int l_ = fr_ + 16 * fq_; asm volatile("" : "+v"(l_)); const int fr = l_ & 15, fq = l_ >> 4;
        const int col0 = u.pn * BM + wc * 32 + 8 * fq;
        LAS float* S = (LAS float*)scr;
#pragma unroll
        for (int ai = 0; ai < 2; ++ai)
#pragma unroll
            for (int m = 0; m < 4; ++m) { const int rl = ai * HALF + wr * 64 + m * 16 + fr; const int row = u.pm * BM + rl; float ss = 0.f;
#pragma unroll
                for (int bj = 0; bj < 2; ++bj) { const size_t off = (size_t)row * D + col0 + bj * HALF;
                    const f32x4 v0 = acc[ai][bj][m][0], v1 = acc[ai][bj][m][1];
                    if (MODE == 2) { *(f32x4*)(out + off) = v0; *(f32x4*)(out + off + 4) = v1; }
                    else { *(u32x4*)(XB + off) = pack8(v0, v1);
                        ss += (v0[0] * v0[0] + v0[1] * v0[1]) + (v0[2] * v0[2] + v0[3] * v0[3]) + (v1[0] * v1[0] + v1[1] * v1[1]) + (v1[2] * v1[2] + v1[3] * v1[3]); } }
                if (MODE != 2) { ss += __shfl_xor(ss, 16); ss += __shfl_xor(ss, 32); if (fq == 0) S[rl * 4 + wc] = ss; } }
        if (MODE != 2) {
            asm volatile("s_waitcnt lgkmcnt(0)" ::: "memory"); __builtin_amdgcn_s_barrier(); asm volatile("" ::: "memory");
            const int t = otid();
            if (t < 256) { const f32x4 p = *(const LAS f32x4*)(S + t * 4); ssq4[(size_t)(u.pm * BM + t) * 4 + u.pn] = (p[0] + p[1]) + (p[2] + p[3]); }
        }
    }
};
template <bool SCALE> struct EpiPlain {
    static constexpr bool PERM = true;
    bf16_t* O; int ldc; const float* ssq4;
    template <class Sched> DI void preload(const Sched& S, LAS unsigned char* tab) const { if (SCALE) preload_rstd(S, ssq4, tab); }
    DI void init(f32x4 (&acc)[2][2][4][2], const Unit&, int, int, int, int) const { zero_acc(acc); }
    DI void operator()(const f32x4 (&acc)[2][2][4][2], const Unit& u, int ui, int wr, int wc, int fr_, int fq_, LAS unsigned char* scr) const {
        int l_ = fr_ + 16 * fq_; asm volatile("" : "+v"(l_)); const int fr = l_ & 15, fq = l_ >> 4;
        const int row0 = u.pm * BM + wr * 64 + fr, col0 = u.pn * BM + wc * 32 + 8 * fq;
        float rs[2][4];
        if (SCALE) load_rstd(rs, scr, ui, wr, fr);
#pragma unroll
        for (int ai = 0; ai < 2; ++ai)
#pragma unroll
            for (int m = 0; m < 4; ++m) { const int row = row0 + ai * HALF + m * 16; const float r = SCALE ? rs[ai][m] : 1.0f;
#pragma unroll
                for (int bj = 0; bj < 2; ++bj) *(u32x4*)(O + (size_t)row * ldc + col0 + bj * HALF) = pack8(acc[ai][bj][m][0] * r, acc[ai][bj][m][1] * r); }
    }
};
struct EpiInProj {
    static constexpr bool PERM = true;
    bf16_t* O; const float* ssq4; const float* cosA; const float* sinA; const float* cosR; const float* sinR;
    template <class Sched> DI void preload(const Sched& S, LAS unsigned char* tab) const { preload_rstd(S, ssq4, tab); }
    DI void init(f32x4 (&acc)[2][2][4][2], const Unit&, int, int, int, int) const { zero_acc(acc); }
    DI void operator()(const f32x4 (&acc)[2][2][4][2], const Unit& u, int ui, int wr, int wc, int fr_, int fq_, LAS unsigned char* scr) const {
        int l_ = fr_ + 16 * fq_; asm volatile("" : "+v"(l_)); const int fr = l_ & 15, fq = l_ >> 4;
        const int row0 = u.pm * BM + wr * 64 + fr, col0 = u.pn * BM + wc * 32 + 8 * fq;
        const int kind = (u.pn < 4) ? 1 : ((u.pn == 6 || u.pn == 7) ? 2 : 0);
        const bool second = (fq & 1) != 0;
        const bool active = (kind == 2) || (kind == 1 && (wc & 1) == 0 && fq < 2);
        const int b16 = 2 * (wc & 1) + (fq >> 1);
        float rs[2][4];
        load_rstd(rs, scr, ui, wr, fr);
        float irev[8];
        { const float l2t = (kind == 1) ? 18.931568569324174f   : 13.287712379549449f  ; const float inv_half = (kind == 1) ? 0.125f : 0.03125f; const int c0 = (kind == 1) ? 0 : 8 * b16;
#pragma unroll
          for (int i = 0; i < 8; ++i) irev[i] = fast_exp2(-l2t * (float)(c0 + i) * inv_half) * 0.15915494309189535f; }
#pragma unroll
        for (int g2 = 0; g2 < 8; ++g2) {
            const int ai = g2 >> 2, m = g2 & 3; const int row = row0 + ai * HALF + m * 16; const float r = rs[ai][m];
            f32x4 c0 = {0.f, 0.f, 0.f, 0.f}, c1 = c0, s0 = c0, s1 = c0;
            if (active) { const float tf = (float)(row & (SEQ - 1));
#pragma unroll
                for (int i = 0; i < 4; ++i) { const float ra = __builtin_amdgcn_fractf(tf * irev[i]), rb = __builtin_amdgcn_fractf(tf * irev[4 + i]);
                    c0[i] = __builtin_amdgcn_cosf(ra); s0[i] = __builtin_amdgcn_sinf(ra); c1[i] = __builtin_amdgcn_cosf(rb); s1[i] = __builtin_amdgcn_sinf(rb); } }
#pragma unroll
                for (int bj = 0; bj < 2; ++bj) { f32x4 v0 = acc[ai][bj][m][0] * r, v1 = acc[ai][bj][m][1] * r;
                    if (kind != 0) { f32x4 p0, p1;
#pragma unroll
                        for (int i = 0; i < 4; ++i) {
                            const auto x0 = __builtin_amdgcn_permlane16_swap(__float_as_uint(v0[i]), __float_as_uint(v0[i]), false, false);
                            const auto x1 = __builtin_amdgcn_permlane16_swap(__float_as_uint(v1[i]), __float_as_uint(v1[i]), false, false);
                            p0[i] = __uint_as_float(second ? x0[0] : x0[1]); p1[i] = __uint_as_float(second ? x1[0] : x1[1]); }
                        const f32x4 r0 = second ? (p0 * s0 + v0 * c0) : (v0 * c0 - p0 * s0);
                        const f32x4 r1 = second ? (p1 * s1 + v1 * c1) : (v1 * c1 - p1 * s1);
                        if (active) { v0 = r0; v1 = r1; } }
                    { const int ct = bj * HALF + wc * 32 + 8 * fq, b = row / SEQ, t = row & (SEQ - 1); size_t off;
                      if (u.pn < 6) { const int cs = (u.pn & 1) * 256 + ct; off = hm_off(512 * (u.pn >> 1), 8, 64, b, cs >> 6, t) + (cs & 63); }
                      else if (u.pn < 8) off = hm_off(1536 + 256 * (u.pn - 6), 4, 64, b, ct >> 6, t) + (ct & 63);
                      else { const int cs = (u.pn & 1) * 256 + ct; off = hm_off(2048 + 512 * ((u.pn - 8) >> 1), 4, 128, b, cs >> 7, t) + (cs & 127); }
                      *(u32x4*)(O + off) = pack8(v0, v1); } }
        }
    }
};
}

constexpr size_t MiB = 1u << 20;
constexpr size_t al(size_t x) { return (x + 255) & ~(size_t)255; }
constexpr size_t WS_CTL = 0, CTL_ZERO_BYTES = 32768;
constexpr size_t WS_W1IN = 1 * MiB;
constexpr size_t WS_W1OUT = WS_W1IN + (size_t)2 * DFF * D * 2;
constexpr size_t WS_WIN = WS_W1OUT + (size_t)D * DFF * 2;
constexpr size_t WS_WOUT = WS_WIN + (size_t)INC * D * 2;
constexpr size_t WS_WCQ = WS_WOUT + (size_t)D * D * 2;
constexpr size_t WS_WCKV = WS_WCQ + (size_t)D * D * 2;
constexpr size_t WS_WCO = WS_WCKV + (size_t)2 * D * D * 2;
constexpr size_t WS_W2IN = WS_WCO + (size_t)D * D * 2;
constexpr size_t WS_W2OUT = WS_W2IN + (size_t)2 * DFF * D * 2;
constexpr size_t WS_TAB = WS_W2OUT + (size_t)D * DFF * 2;
constexpr size_t WS_COSA = WS_TAB, WS_SINA = WS_COSA + (size_t)SEQ * 8 * 4, WS_COSR = WS_SINA + (size_t)SEQ * 8 * 4, WS_SINR = WS_COSR + (size_t)SEQ * 32 * 4;
constexpr size_t WS_MEMN = WS_SINR + (size_t)SEQ * 32 * 4;
constexpr size_t WS_KC = WS_MEMN + (size_t)MROWS * D * 2;
constexpr size_t WS_VT = WS_KC + (size_t)MROWS * D * 2;
constexpr size_t WS_SSQ = WS_VT + (size_t)MROWS * D * 2;
constexpr size_t WS_XB = al(WS_SSQ + (size_t)M * 16 * 4);
constexpr size_t WS_BIG = WS_XB + (size_t)M * D * 2;
constexpr size_t WS_OMIX = WS_BIG + (size_t)M * INC * 2;
constexpr size_t WS_ATT = WS_OMIX + (size_t)M * D * 2;
constexpr size_t WS_ATT_BYTES = (size_t)M * 512 * 2 * 3 + (size_t)M * 8 * 4 * 3;
constexpr size_t WS_RET = WS_ATT + WS_ATT_BYTES;
constexpr size_t WS_XRES = WS_RET + (size_t)NBATCH * 64 * 4 * 64 * 128 * 4;
constexpr size_t WS_OPT_END = WS_XRES;

constexpr int RING_OFF = 0, RING_BYTES = 131072;
constexpr int LDSCTL_OFF = 163840 - 256, MISC_OFF = LDSCTL_OFF;
constexpr int LDS_BYTES = 163840;
constexpr int NWAVES = 8;

#define XB_TMO      128
#define XB_XCNT(j)  (256  + 64 * (j))
#define XB_XSUB(j)  (1280 + 64 * (j))
#define XB_XGEN(j)  (2304 + 64 * (j))
#define XB_TOP      3328
#define XB_TOPGEN   3392
#define XCD_BAR_WORDS 3456
#define XB_SPIN_CAP (1u << 18)
DI unsigned xb_ld(unsigned* p)              { return __hip_atomic_load(p, __ATOMIC_RELAXED, __HIP_MEMORY_SCOPE_AGENT); }
DI unsigned xb_add(unsigned* p, unsigned v) { return __hip_atomic_fetch_add(p, v, __ATOMIC_RELAXED, __HIP_MEMORY_SCOPE_AGENT); }
DI unsigned xb_xcc_id() { return (unsigned)__builtin_amdgcn_s_getreg((3 << 11) | 20) & 0xFu; }
#define XB_SPIN(cond, bar) do { unsigned _sp = 0; while (cond) { __builtin_amdgcn_s_sleep(1); \
    if ((++_sp & 255u) == 0u) { if (xb_ld(&(bar)[XB_TMO])) break; if (_sp > XB_SPIN_CAP) { atomicAdd(&(bar)[XB_TMO], 1u); break; } } } } while (0)
struct XcdBarrier { unsigned* bar; unsigned x; volatile LAS unsigned* st; };
DI XcdBarrier xcd_barrier_post(unsigned* bar, volatile LAS unsigned* st) {
    XcdBarrier b; b.bar = bar; b.x = xb_xcc_id(); b.st = st;
    if (threadIdx.x == 0) (void)xb_add(&bar[XB_XCNT(b.x)], 1u);
    return b;
}
DI void xcd_barrier_complete(unsigned* bar, unsigned x, unsigned& nloc, unsigned& nx) {
    const unsigned G = gridDim.x * gridDim.y * gridDim.z;
    unsigned sum, cnt, mine, sp = 0u;
    for (;;) {
        sum = 0u; cnt = 0u; mine = 0u;
#pragma unroll
        for (unsigned j = 0; j < 16; ++j) { const unsigned c = xb_ld(&bar[XB_XCNT(j)]); sum += c; cnt += (c > 0u) ? 1u : 0u; mine = (j == x) ? c : mine; }
        if (sum == G) break;
        __builtin_amdgcn_s_sleep(1);
        if ((++sp & 255u) == 0u) { if (xb_ld(&bar[XB_TMO])) break; if (sp > XB_SPIN_CAP) { atomicAdd(&bar[XB_TMO], 1u); break; } }
    }
    nloc = mine > 0u ? mine : 1u; nx = cnt > 0u ? cnt : 1u;
}
DI void xcd_barrier(const XcdBarrier& b) {
    asm volatile("s_waitcnt vmcnt(0)" ::: "memory");
    __syncthreads();
    if (threadIdx.x == 0) {
        unsigned* bar = b.bar;
        __builtin_amdgcn_s_waitcnt(0);
        unsigned nloc = b.st[0], nx = b.st[1];
        if (nloc == 0u) { xcd_barrier_complete(bar, b.x, nloc, nx); b.st[0] = nloc; b.st[1] = nx; }
        const unsigned old = xb_add(&bar[XB_XSUB(b.x)], 1u);
        const unsigned gen = old / nloc;
        if (old + 1u == (gen + 1u) * nloc) {
            __builtin_amdgcn_fence(__ATOMIC_RELEASE, "agent");
            asm volatile("s_waitcnt vmcnt(0)" ::: "memory");
            const unsigned og = xb_add(&bar[XB_TOP], 1u);
            const unsigned tg = og / nx;
            if (og + 1u == (tg + 1u) * nx) xb_add(&bar[XB_TOPGEN], 1u);
            else XB_SPIN(xb_ld(&bar[XB_TOPGEN]) == tg, bar);
            __builtin_amdgcn_fence(__ATOMIC_ACQUIRE, "agent");
            xb_add(&bar[XB_XGEN(b.x)], 1u);
            asm volatile("s_waitcnt vmcnt(0)" ::: "memory");
        } else {
            XB_SPIN(xb_ld(&bar[XB_XGEN(b.x)]) == gen, bar);
            __builtin_amdgcn_fence(__ATOMIC_ACQUIRE, "agent");
            asm volatile("s_waitcnt vmcnt(0)" ::: "memory");
        }
    }
    __syncthreads();
}
constexpr int CW_BAR = 4096;

struct Args {
    const float* in[17]; float* out; unsigned char* ws; float* xres;
    int ph_lo, ph_hi;
};

DI float wave_sum(float v) {
#pragma unroll
    for (int o = 1; o < 64; o <<= 1) v += __shfl_xor(v, o);
    return v;
}
DI float wave_max(float v) {
#pragma unroll
    for (int o = 1; o < 64; o <<= 1) v = fmaxf(v, __shfl_xor(v, o));
    return v;
}

DI int wmap_row(int mat, int n) {
    if (mat == 0 || mat == 7) { const int u = n >= DFF, j = u ? n - DFF : n; return 256 * (j >> 7) + 128 * u + (j & 127); }
    if (mat == 2 && n >= 1536 && n < 2048) { const int c = n & 63, x2 = c >> 5, cc = c & 31; return (n - c) + 16 * (cc >> 3) + 8 * x2 + (cc & 7); }
    return n;
}
DI float wmap_scale(int mat, int n) {
    if (mat == 2) return (n < 512) ? 0.125f * LOG2E : ((n >= 1792 && n < 2048) ? 0.125f : 1.0f);
    if (mat == 4) return 0.0625f * LOG2E;
    if (mat == 1 || mat == 8) return 0.5f;
    return 1.0f;
}
DI void p0_transpose_item(const float* W, int K, int N, bf16_t* WT, int mat, const float* nw, LAS float* scr, int item, int lane) {
    const int nblk = N / 32, kb = item / nblk, nb = item % nblk, k0 = 64 * kb, n0 = 32 * nb;
    float wv[32];
#pragma unroll
    for (int i = 0; i < 32; ++i) wv[i] = W[(size_t)(k0 + 2 * i + (lane >> 5)) * N + n0 + (lane & 31)];
    const float s0 = nw ? nw[k0 + (lane & 31) * 2 + 0] : 1.0f, s1 = nw ? nw[k0 + (lane & 31) * 2 + 1] : 1.0f;
#pragma unroll
    for (int i = 0; i < 32; ++i) { const float sl = __shfl(s0, i), sh = __shfl(s1, i); const int kk = 2 * i + (lane >> 5); scr[kk * 33 + (lane & 31)] = wv[i] * ((lane >> 5) ? sh : sl); }
    asm volatile("s_waitcnt lgkmcnt(0)" ::: "memory");
    const int c = lane & 7;
#pragma unroll
    for (int j = 0; j < 4; ++j) { const int n = (lane >> 3) + 8 * j; const LAS float* s = scr + (8 * c) * 33 + n; const float sc = wmap_scale(mat, n0 + n);
        u32x4 o; o.x = cvt_pk_bf16(s[0 * 33] * sc, s[1 * 33] * sc); o.y = cvt_pk_bf16(s[2 * 33] * sc, s[3 * 33] * sc); o.z = cvt_pk_bf16(s[4 * 33] * sc, s[5 * 33] * sc); o.w = cvt_pk_bf16(s[6 * 33] * sc, s[7 * 33] * sc);
        *(u32x4*)(WT + (size_t)wmap_row(mat, n0 + n) * K + k0 + 8 * c) = o; }
    asm volatile("s_waitcnt lgkmcnt(0)" ::: "memory");
}
DI void rms_row_to_bf16(const float* xrow, const float* w, bf16_t* orow, int lane) {
    const f32x4* xr = (const f32x4*)xrow + lane;
    f32x4 v[4]; float s = 0.f;
#pragma unroll
    for (int j = 0; j < 4; ++j) { v[j] = xr[64 * j]; s += (v[j][0] * v[j][0] + v[j][1] * v[j][1]) + (v[j][2] * v[j][2] + v[j][3] * v[j][3]); }
    const float r = rsqrtf(wave_sum(s) * (1.f / D) + EPS);
    u32x2* o8 = (u32x2*)orow + lane;
#pragma unroll
    for (int j = 0; j < 4; ++j) { const f32x4 ww = ((const f32x4*)w)[lane + 64 * j]; u32x2 o; o.x = cvt_pk_bf16(v[j][0] * r * ww[0], v[j][1] * r * ww[1]); o.y = cvt_pk_bf16(v[j][2] * r * ww[2], v[j][3] * r * ww[3]); o8[64 * j] = o; }
}

DI void rms_row2_to_bf16(const float* xa, const float* xb, const float* w, bf16_t* oa, bf16_t* ob, int lane) {
    const f32x4* ra = (const f32x4*)xa + lane; const f32x4* rb = (const f32x4*)(xb ? xb : xa) + lane;
    f32x4 va[4], vb[4]; float sa = 0.f, sb = 0.f;
#pragma unroll
    for (int j = 0; j < 4; ++j) { va[j] = ra[64 * j]; vb[j] = rb[64 * j]; }
#pragma unroll
    for (int j = 0; j < 4; ++j) { sa += (va[j][0] * va[j][0] + va[j][1] * va[j][1]) + (va[j][2] * va[j][2] + va[j][3] * va[j][3]); sb += (vb[j][0] * vb[j][0] + vb[j][1] * vb[j][1]) + (vb[j][2] * vb[j][2] + vb[j][3] * vb[j][3]); }
    const float r0 = rsqrtf(wave_sum(sa) * (1.f / D) + EPS), r1 = rsqrtf(wave_sum(sb) * (1.f / D) + EPS);
    u32x2* pa = (u32x2*)oa + lane; u32x2* pb = (u32x2*)ob + lane;
#pragma unroll
    for (int j = 0; j < 4; ++j) { const f32x4 ww = ((const f32x4*)w)[lane + 64 * j];
        u32x2 o; o.x = cvt_pk_bf16(va[j][0] * r0 * ww[0], va[j][1] * r0 * ww[1]); o.y = cvt_pk_bf16(va[j][2] * r0 * ww[2], va[j][3] * r0 * ww[3]); pa[64 * j] = o;
        if (xb) { u32x2 p; p.x = cvt_pk_bf16(vb[j][0] * r1 * ww[0], vb[j][1] * r1 * ww[1]); p.y = cvt_pk_bf16(vb[j][2] * r1 * ww[2], vb[j][3] * r1 * ww[3]); pb[64 * j] = p; } }
}

namespace da {
typedef float f32x16 __attribute__((ext_vector_type(16)));
typedef short s16x4 __attribute__((ext_vector_type(4)));
typedef __bf16 bf16x2_t __attribute__((ext_vector_type(2)));
constexpr int K_OFF = 0, V_OFF = 49152, V_D0 = 24640, OST_OFF = V_OFF + V_D0 + 24576;
static_assert(OST_OFF + 8 * 4096 <= MISC_OFF, "attention LDS map");
DI int crow(int r, int hi) { return (r & 3) + 8 * (r >> 2) + 4 * hi; }
DI unsigned cvtpk(float lo, float hi) { f32x2 v = {lo, hi}; bf16x2_t b = __builtin_convertvector(v, bf16x2_t); return __builtin_bit_cast(unsigned, b); }
DI s16x4 vtr(LAS unsigned char* p) { return __builtin_bit_cast(s16x4, __builtin_amdgcn_ds_read_tr16_b64_v4i16((LAS s16x4*)p)); }
struct Dec { int b, h, g, d, r, blk; };
DI Dec decode(int uid) { Dec u; const int u32i = uid & 31, ghb = uid >> 5; u.g = ghb % 3; const int bh = ghb / 3; u.h = bh & 7; u.b = bh >> 3;
    u.d = (u.g == 0) ? 1 : ((u.g == 1) ? 4 : 16); const int nblk = 32 / u.d; u.blk = u32i % nblk; u.r = u32i / nblk; return u; }
struct Regs { u32x4 k[6], v[6], q[4]; };
DI void load_regs(Regs& R, const Dec& u, const bf16_t* proj, int tid) {
    const int lane = tid & 63, w = tid >> 6;
#pragma unroll
    for (int i = 0; i < 6; ++i) { const int id = tid + 512 * i, uk = id >> 3, c = id & 7; int sk = 256 * u.blk - 128 + uk; sk = sk < 0 ? 0 : sk;
        const size_t ro = hm_off(0, 8, 64, u.b, u.h, sk * u.d + u.r) + 8 * c;
        R.k[i] = *(const u32x4*)(proj + (size_t)M * 512 + ro); R.v[i] = *(const u32x4*)(proj + (size_t)M * 1024 + ro); }
    const int s = 256 * u.blk + 32 * w + (lane & 31);
    const bf16_t* qp = proj + hm_off(0, 8, 64, u.b, u.h, s * u.d + u.r) + 8 * (lane >> 5);
#pragma unroll
    for (int ks = 0; ks < 4; ++ks) R.q[ks] = *(const u32x4*)(qp + 16 * ks);
}
DI void write_lds(const Regs& R, const Dec& u, LAS unsigned char* lds, int tid) {
#pragma unroll
    for (int i = 0; i < 6; ++i) { const int id = tid + 512 * i, uk = id >> 3, c = id & 7; const bool valid = (u.blk > 0) || (uk >= 128);
        const u32x4 z = {0u, 0u, 0u, 0u};
        *(LAS u32x4*)(lds + K_OFF + 128 * uk + 16 * (c ^ ((uk >> 1) & 7))) = valid ? R.k[i] : z;
        *(LAS u32x4*)(lds + V_OFF + (c >> 2) * V_D0 + 64 * uk + 16 * (c & 3)) = valid ? R.v[i] : z; }
}
DI void qk_part(f32x16 (&S)[5], const Regs& R, LAS unsigned char* lds, int tid) {
    const int lane = tid & 63, w = __builtin_amdgcn_readfirstlane(tid >> 6), q = lane & 31, hi = lane >> 5;
#pragma unroll
    for (int j = 0; j < 5; ++j) {
        const int uk = 32 * (w + j) + q;
        f32x16 acc;
#pragma unroll
        for (int r = 0; r < 16; ++r) acc[r] = 0.f;
#pragma unroll
        for (int ks = 0; ks < 4; ++ks) { const bf16x8 kf = *(const LAS bf16x8*)(lds + K_OFF + 128 * uk + 16 * ((2 * ks + hi) ^ ((uk >> 1) & 7)));
            acc = __builtin_amdgcn_mfma_f32_32x32x16_bf16(kf, __builtin_bit_cast(bf16x8, R.q[ks]), acc, 0, 0, 0); }
        S[j] = acc;
    }
}
DI void softmax_part(f32x16 (&S)[5], u32x4 (&Pk)[5][2], float& m_out, float& l_out, const Dec& u, int tid) {
    const int lane = tid & 63, w = __builtin_amdgcn_readfirstlane(tid >> 6), q = lane & 31, hi = lane >> 5;
    float m = -1e30f;
#pragma unroll
    for (int r = 0; r < 16; ++r) { const int kk = crow(r, hi); if (kk < q) S[0][r] = -1e30f; if (kk > q) S[4][r] = -1e30f; }
    if (u.blk == 0) {
#pragma unroll
        for (int j = 0; j < 4; ++j) if (w + j < 4) {
#pragma unroll
            for (int r = 0; r < 16; ++r) S[j][r] = -1e30f; }
    }
#pragma unroll
    for (int j = 0; j < 5; ++j)
#pragma unroll
        for (int r = 0; r < 16; ++r) m = fmaxf(m, S[j][r]);
    m = fmaxf(m, __shfl_xor(m, 32));
    float l = 0.f;
#pragma unroll
    for (int j = 0; j < 5; ++j) {
#pragma unroll
        for (int r = 0; r < 16; ++r) { const float p = fast_exp2(S[j][r] - m); S[j][r] = p; l += p; }
#pragma unroll
        for (int s2 = 0; s2 < 2; ++s2) { u32x4 pw; pw.x = cvtpk(S[j][8 * s2 + 0], S[j][8 * s2 + 1]); pw.y = cvtpk(S[j][8 * s2 + 2], S[j][8 * s2 + 3]); pw.z = cvtpk(S[j][8 * s2 + 4], S[j][8 * s2 + 5]); pw.w = cvtpk(S[j][8 * s2 + 6], S[j][8 * s2 + 7]); Pk[j][s2] = pw; }
    }
    l += __shfl_xor(l, 32);
    m_out = m; l_out = l;
}
DI void pv_part(const u32x4 (&Pk)[5][2], float m, float l, const Dec& u, LAS unsigned char* lds, bf16_t* part, float* lsep, int tid) {
    const int lane = tid & 63, w = __builtin_amdgcn_readfirstlane(tid >> 6), q = lane & 31, hi = lane >> 5;
    f32x16 o[2];
#pragma unroll
    for (int r = 0; r < 16; ++r) { o[0][r] = 0.f; o[1][r] = 0.f; }
    const int vlane = ((lane >> 4) & 1) * 32 + (lane & 3) * 8 + (4 * hi + ((lane & 15) >> 2)) * 64;
#pragma unroll
    for (int j = 0; j < 5; ++j)
#pragma unroll
        for (int s2 = 0; s2 < 2; ++s2) {
            const bf16x8 pa = __builtin_bit_cast(bf16x8, Pk[j][s2]);
#pragma unroll
            for (int d0 = 0; d0 < 2; ++d0) { LAS unsigned char* vp = lds + V_OFF + d0 * V_D0 + (32 * (w + j) + 16 * s2) * 64 + vlane;
                const s16x4 lo = vtr(vp), hi4 = vtr(vp + 512);
                const bf16x8 vf = {lo[0], lo[1], lo[2], lo[3], hi4[0], hi4[1], hi4[2], hi4[3]};
                o[d0] = __builtin_amdgcn_mfma_f32_32x32x16_bf16(pa, vf, o[d0], 0, 0, 0); }
        }
    const float linv = fast_rcp(l);
    LAS bf16_t* stg = (LAS bf16_t*)(lds + OST_OFF + w * 4096);
#pragma unroll
    for (int r = 0; r < 16; ++r) { const int orow = crow(r, hi); const float li = __shfl(linv, orow);
#pragma unroll
        for (int d0 = 0; d0 < 2; ++d0) stg[orow * 64 + d0 * 32 + q] = (bf16_t)(cvtpk(o[d0][r] * li, 0.f) & 0xffffu); }
    asm volatile("s_waitcnt lgkmcnt(0)" ::: "memory");
    const int s0 = 256 * u.blk + 32 * w;
#pragma unroll
    for (int i = 0; i < 4; ++i) { const int row = i * 8 + (lane >> 3), ch = lane & 7; const u32x4 v = *(const LAS u32x4*)(stg + row * 64 + ch * 8);
        *(u32x4*)(part + (size_t)(u.b * SEQ + (s0 + row) * u.d + u.r) * 512 + u.h * 64 + ch * 8) = v; }
    if (hi == 0) lsep[(size_t)(u.b * SEQ + (s0 + q) * u.d + u.r) * 8 + u.h] = m + __log2f(l);
}
struct UnitMap { int x, j, GX, NP, per, n;
    DI void init(int x_, int j_, int GX_, int npairs) { x = x_; j = j_; GX = GX_; NP = npairs; per = (96 + GX - 1) / GX; n = NP * per; }
    DI int uid(int i) const { const int p = i / per, k = j * per + i % per; return (k < 96) ? (x * NP + p) * 96 + k : -1; } };
DI void phase(LAS unsigned char* lds, const bf16_t* proj, bf16_t* attp, float* lse, const UnitMap& U) {
    int i = 0; while (i < U.n && U.uid(i) < 0) ++i;
    if (i >= U.n) return;
    Regs R; Dec cur = decode(U.uid(i));
    load_regs(R, cur, proj, otid());
    while (i < U.n) {
        int in = i + 1; while (in < U.n && U.uid(in) < 0) ++in;
        write_lds(R, cur, lds, otid());
        Regs Qc;
#pragma unroll
        for (int k = 0; k < 4; ++k) Qc.q[k] = R.q[k];
        __syncthreads();
        Dec nxt = cur;
        if (in < U.n) { nxt = decode(U.uid(in)); load_regs(R, nxt, proj, otid()); }
        u32x4 Pk[5][2]; float m, l;
        {   f32x16 S[5];
            qk_part(S, Qc, lds, otid());
            softmax_part(S, Pk, m, l, cur, otid()); }
        pv_part(Pk, m, l, cur, lds, attp + (size_t)cur.g * M * 512, lse + (size_t)cur.g * M * 8, otid());
        __syncthreads();
        cur = nxt; i = in;
    }
}
DI void merge(const bf16_t* attp, const float* lse, bf16_t* omix, int gtid, int ngt) {
    for (int i = gtid; i < M * 64; i += ngt) {
        const int row = i >> 6, h = (i >> 3) & 7, c = i & 7;
        const float l0 = lse[(size_t)row * 8 + h], l1 = lse[(size_t)M * 8 + (size_t)row * 8 + h], l2 = lse[(size_t)2 * M * 8 + (size_t)row * 8 + h];
        const float mm = fmaxf(fmaxf(l0, l1), l2);
        float w0 = fast_exp2(l0 - mm), w1 = fast_exp2(l1 - mm), w2 = fast_exp2(l2 - mm);
        const float inv = fast_rcp(w0 + w1 + w2); w0 *= inv; w1 *= inv; w2 *= inv;
        const size_t off = (size_t)row * 512 + h * 64 + c * 8;
        const u32x4 a = *(const u32x4*)(attp + off), b = *(const u32x4*)(attp + (size_t)M * 512 + off), cc = *(const u32x4*)(attp + (size_t)2 * M * 512 + off);
        u32x4 o;
#pragma unroll
        for (int k = 0; k < 4; ++k) { const float lo = w0 * bf2f(a[k] & 0xffffu) + w1 * bf2f(b[k] & 0xffffu) + w2 * bf2f(cc[k] & 0xffffu);
            const float hi = w0 * bf2f(a[k] >> 16) + w1 * bf2f(b[k] >> 16) + w2 * bf2f(cc[k] >> 16); o[k] = cvt_pk_bf16(lo, hi); }
        *(u32x4*)(omix + (size_t)row * D + h * 64 + c * 8) = o;
    }
}
}


namespace xa {
using da::f32x16; using da::s16x4; using da::crow; using da::cvtpk; using da::vtr;
constexpr int KB = 0, VB = 65536, VB_STRIDE = 32832, V_D0 = 16384 + 64, OST = 32768;
static_assert(VB + 2 * VB_STRIDE <= MISC_OFF, "cross-attention LDS map");
struct St { u32x4 sr[2][4]; u32x4 q[4]; };
DI void dec(int uid, int& b, int& h, int& qblk) { qblk = uid & 31; h = (uid >> 5) & 3; b = uid >> 7; }
DI const bf16_t* q_ptr(int i, int u_lo, const bf16_t* qc, int tid) { int b, h, qblk; dec(u_lo + (i >> 3), b, h, qblk); const int lane = tid & 63, w = tid >> 6;
    return qc + (size_t)(b * SEQ + 256 * qblk + 32 * w + (lane & 31)) * D + h * 256 + 64 * (i & 7) + 8 * (lane >> 5); }
template <int PAR> DI void stage_load(St& T, int i, int total, int u_lo, const bf16_t* kvc, int tid) {
    if (i >= total) return;
    const int st = i & 7; int b, h, qblk; dec(u_lo + (i >> 3), b, h, qblk);
    const int coff = (st < 4) ? (h * 256 + 64 * st) : (1024 + h * 256 + 64 * (st - 4));
#pragma unroll
    for (int k = 0; k < 4; ++k) { const int id = tid + 512 * k, m = id >> 3, ch = id & 7; T.sr[PAR][k] = *(const u32x4*)(kvc + (size_t)(b * MEMLEN + m) * 2048 + coff + 8 * ch); }
}
template <int PAR> DI void stage_write(const St& T, int i, int total, LAS unsigned char* lds, int tid) {
    if (i >= total) return;
    const int st = i & 7;
    if (st < 4) {
#pragma unroll
        for (int k = 0; k < 4; ++k) { const int id = tid + 512 * k, m = id >> 3, ch = id & 7; *(LAS u32x4*)(lds + KB + (st & 1) * 32768 + 128 * m + 16 * (ch ^ ((m >> 1) & 7))) = T.sr[PAR][k]; }
    } else {
#pragma unroll
        for (int k = 0; k < 4; ++k) { const int id = tid + 512 * k, m = id >> 3, ch = id & 7; *(LAS u32x4*)(lds + VB + (st & 1) * VB_STRIDE + (ch >> 2) * V_D0 + 64 * m + 16 * (ch & 3)) = T.sr[PAR][k]; }
    }
}
template <int st> DI void k_stage(St& T, f32x16 (&S)[8], int i, int u_lo, LAS unsigned char* lds, const bf16_t* qc, int tid) {
    const int lane = tid & 63, q = lane & 31, hi = lane >> 5;
    LAS unsigned char* kb = lds + KB + (st & 1) * 32768;
    const bf16_t* qn = q_ptr(i + 1, u_lo, qc, tid);
#pragma unroll
    for (int ks = 0; ks < 4; ++ks) { const bf16x8 qf = __builtin_bit_cast(bf16x8, T.q[ks]);
#pragma unroll
        for (int kt = 0; kt < 8; ++kt) { const int uk = 32 * kt + q;
            const bf16x8 kf = *(const LAS bf16x8*)(kb + 128 * uk + 16 * ((2 * ks + hi) ^ ((uk >> 1) & 7)));
            S[kt] = __builtin_amdgcn_mfma_f32_32x32x16_bf16(kf, qf, S[kt], 0, 0, 0); }
        if (st < 3) T.q[ks] = *(const u32x4*)(qn + 16 * ks); }
}
DI void softmax(f32x16 (&S)[8], u32x4 (&Pk)[8][2], float& linv) {
    float m = -1e30f;
#pragma unroll
    for (int kt = 0; kt < 8; ++kt)
#pragma unroll
        for (int r = 0; r < 16; ++r) m = fmaxf(m, S[kt][r]);
    m = fmaxf(m, __shfl_xor(m, 32));
    float l = 0.f;
#pragma unroll
    for (int kt = 0; kt < 8; ++kt) {
#pragma unroll
        for (int r = 0; r < 16; ++r) { const float p = fast_exp2(S[kt][r] - m); S[kt][r] = p; l += p; }
#pragma unroll
        for (int s2 = 0; s2 < 2; ++s2) { u32x4 pw; pw.x = cvtpk(S[kt][8 * s2 + 0], S[kt][8 * s2 + 1]); pw.y = cvtpk(S[kt][8 * s2 + 2], S[kt][8 * s2 + 3]); pw.z = cvtpk(S[kt][8 * s2 + 4], S[kt][8 * s2 + 5]); pw.w = cvtpk(S[kt][8 * s2 + 6], S[kt][8 * s2 + 7]); Pk[kt][s2] = pw; }
    }
    l += __shfl_xor(l, 32);
    linv = fast_rcp(l);
}
template <int st> DI void v_stage(St& T, const u32x4 (&Pk)[8][2], float linv, int i, int total, int u_lo, LAS unsigned char* lds, const bf16_t* qc, bf16_t* oc, int tid) {
    const int lane = tid & 63, w = __builtin_amdgcn_readfirstlane(tid >> 6), q = lane & 31, hi = lane >> 5;
    const int vc = st - 4; int b, h, qblk; dec(u_lo + (i >> 3), b, h, qblk);
    if (st == 7 && i + 1 < total) { const bf16_t* qn = q_ptr(i + 1, u_lo, qc, tid);
#pragma unroll
        for (int ks = 0; ks < 4; ++ks) T.q[ks] = *(const u32x4*)(qn + 16 * ks); }
    LAS unsigned char* vb = lds + VB + (st & 1) * VB_STRIDE;
    const int vlane = ((lane >> 4) & 1) * 32 + (lane & 3) * 8 + (4 * hi + ((lane & 15) >> 2)) * 64;
    f32x16 o[2];
#pragma unroll
    for (int r = 0; r < 16; ++r) { o[0][r] = 0.f; o[1][r] = 0.f; }
#pragma unroll
    for (int kt = 0; kt < 8; ++kt)
#pragma unroll
        for (int s2 = 0; s2 < 2; ++s2) { const bf16x8 pa = __builtin_bit_cast(bf16x8, Pk[kt][s2]);
#pragma unroll
            for (int d0 = 0; d0 < 2; ++d0) { LAS unsigned char* vp = vb + d0 * V_D0 + (32 * kt + 16 * s2) * 64 + vlane;
                const s16x4 lo = vtr(vp), hi4 = vtr(vp + 512);
                const bf16x8 vf = {lo[0], lo[1], lo[2], lo[3], hi4[0], hi4[1], hi4[2], hi4[3]};
                o[d0] = __builtin_amdgcn_mfma_f32_32x32x16_bf16(pa, vf, o[d0], 0, 0, 0); } }
    LAS bf16_t* stg = (LAS bf16_t*)(lds + OST + w * 4096);
#pragma unroll
    for (int r = 0; r < 16; ++r) { const int orow = crow(r, hi); const float li = __shfl(linv, orow);
#pragma unroll
        for (int d0 = 0; d0 < 2; ++d0) stg[orow * 64 + d0 * 32 + q] = (bf16_t)(cvtpk(o[d0][r] * li, 0.f) & 0xffffu); }
    asm volatile("s_waitcnt lgkmcnt(0)" ::: "memory");
#pragma unroll
    for (int k = 0; k < 4; ++k) { const int row = k * 8 + (lane >> 3), ch = lane & 7; const u32x4 v = *(const LAS u32x4*)(stg + row * 64 + ch * 8);
        *(u32x4*)(oc + (size_t)(b * SEQ + 256 * qblk + 32 * w + row) * D + h * 256 + 64 * vc + ch * 8) = v; }
}
DI void phase(LAS unsigned char* lds, const bf16_t* qc, const bf16_t* kvc, bf16_t* oc, int u_lo, int u_hi, int) {
    if (u_lo >= u_hi) return;
    const int total = 8 * (u_hi - u_lo);
    St T;
    { const bf16_t* q0 = q_ptr(0, u_lo, qc, otid());
#pragma unroll
      for (int ks = 0; ks < 4; ++ks) T.q[ks] = *(const u32x4*)(q0 + 16 * ks); }
    stage_load<0>(T, 0, total, u_lo, kvc, otid()); stage_write<0>(T, 0, total, lds, otid()); stage_load<1>(T, 1, total, u_lo, kvc, otid()); stage_load<0>(T, 2, total, u_lo, kvc, otid());
    __syncthreads();
    for (int i0 = 0; i0 < total; i0 += 8) {
        u32x4 Pk[8][2]; float linv;
        {   f32x16 S[8];
#pragma unroll
            for (int kt = 0; kt < 8; ++kt)
#pragma unroll
                for (int r = 0; r < 16; ++r) S[kt][r] = 0.f;
#define XA_NEXT(i, P1) do { stage_write<P1>(T, (i) + 1, total, lds, otid()); stage_load<P1>(T, (i) + 3, total, u_lo, kvc, otid()); __syncthreads(); } while (0)
            k_stage<0>(T, S, i0 + 0, u_lo, lds, qc, otid()); XA_NEXT(i0 + 0, 1);
            k_stage<1>(T, S, i0 + 1, u_lo, lds, qc, otid()); XA_NEXT(i0 + 1, 0);
            k_stage<2>(T, S, i0 + 2, u_lo, lds, qc, otid()); XA_NEXT(i0 + 2, 1);
            k_stage<3>(T, S, i0 + 3, u_lo, lds, qc, otid()); XA_NEXT(i0 + 3, 0);
            softmax(S, Pk, linv);
        }
        v_stage<4>(T, Pk, linv, i0 + 4, total, u_lo, lds, qc, oc, otid()); XA_NEXT(i0 + 4, 1);
        v_stage<5>(T, Pk, linv, i0 + 5, total, u_lo, lds, qc, oc, otid()); XA_NEXT(i0 + 5, 0);
        v_stage<6>(T, Pk, linv, i0 + 6, total, u_lo, lds, qc, oc, otid()); XA_NEXT(i0 + 6, 1);
        v_stage<7>(T, Pk, linv, i0 + 7, total, u_lo, lds, qc, oc, otid()); XA_NEXT(i0 + 7, 0);
#undef XA_NEXT
    }
}
}


namespace rt {
using da::f32x16; using da::s16x4; using da::crow; using da::cvtpk; using da::vtr;
constexpr int VS = 8256, RS = 4160;
constexpr int KV_K = 0, KV_V = 2 * VS;
constexpr int O_K = 0, O_V = 16384, O_R = O_V + 4 * VS, O_END = O_R + 4 * RS, O_ST = O_END, O_LD = 132;
static_assert(O_ST + 128 * O_LD * 4 <= MISC_OFF, "retention LDS map");
DI float log2_gamma(int h) { return __log2f(1.0f - exp2f(-5.0f - (float)h)); }
DI void dec(int uid, int& b, int& h, int& n) { n = uid & 63; h = (uid >> 6) & 3; b = uid >> 8; }
DI size_t ret_off(int b, int n, int h) { return ((size_t)(b * 64 + n) * 4 + h) * 8192; }
DI bf16x8 tr_nat(LAS unsigned char* tile, int ks, int lane) { const int hi = lane >> 5;
    LAS unsigned char* p = tile + (16 * ks + 8 * hi + ((lane & 15) >> 2)) * 64 + ((lane >> 4) & 1) * 32 + (lane & 3) * 8;
    const s16x4 lo = vtr(p), h4 = vtr(p + 256); return (bf16x8){lo[0], lo[1], lo[2], lo[3], h4[0], h4[1], h4[2], h4[3]}; }
DI bf16x8 tr_perm(LAS unsigned char* tile, int rowbase, int lane) { const int hi = lane >> 5;
    LAS unsigned char* p = tile + (rowbase + 4 * hi + ((lane & 15) >> 2)) * 64 + ((lane >> 4) & 1) * 32 + (lane & 3) * 8;
    const s16x4 lo = vtr(p), h4 = vtr(p + 512); return (bf16x8){lo[0], lo[1], lo[2], lo[3], h4[0], h4[1], h4[2], h4[3]}; }
struct KvRegs { u32x4 k[2], v[4]; };
DI void kv_load(KvRegs& G, int uid, const bf16_t* proj, int tid) {
    int b, h, n; dec(uid, b, h, n);
    const bf16_t* kb = proj + hm_off(1792, 4, 64, b, h, 128 * n); const bf16_t* vb = proj + hm_off(2048, 4, 128, b, h, 128 * n);
#pragma unroll
    for (int i = 0; i < 2; ++i) G.k[i] = *(const u32x4*)(kb + 8 * (tid + 512 * i));
#pragma unroll
    for (int i = 0; i < 4; ++i) G.v[i] = *(const u32x4*)(vb + 8 * (tid + 512 * i));
}
DI void kv_phase(LAS unsigned char* lds, const bf16_t* proj, float* ret, int u_lo, int u_hi) {
    if (u_lo >= u_hi) return;
    KvRegs G; kv_load(G, u_lo, proj, otid());
    for (int uid = u_lo; uid < u_hi; ++uid) {
        const int tid = otid(), lane = tid & 63, w = __builtin_amdgcn_readfirstlane(tid >> 6);
        int b, h, n; dec(uid, b, h, n);
        const float lg = log2_gamma(h);
#pragma unroll
        for (int i = 0; i < 2; ++i) { const int id = tid + 512 * i, tok = id >> 3, ch = id & 7; const float dk = fast_exp2(lg * (float)(127 - tok)); u32x4 o;
#pragma unroll
            for (int k = 0; k < 4; ++k) o[k] = cvt_pk_bf16(bf2f(G.k[i][k] & 0xffffu) * dk, bf2f(G.k[i][k] >> 16) * dk);
            *(LAS u32x4*)(lds + KV_K + (ch >> 2) * VS + tok * 64 + (ch & 3) * 16) = o; }
#pragma unroll
        for (int i = 0; i < 4; ++i) { const int id = tid + 512 * i, tok = id >> 4, ch = id & 15; *(LAS u32x4*)(lds + KV_V + (ch >> 2) * VS + tok * 64 + (ch & 3) * 16) = G.v[i]; }
        __syncthreads();
        if (uid + 1 < u_hi) kv_load(G, uid + 1, proj, otid());
        const int dt = w >> 2, et = w & 3;
        f32x16 acc;
#pragma unroll
        for (int r = 0; r < 16; ++r) acc[r] = 0.f;
#pragma unroll
        for (int ks = 0; ks < 8; ++ks) { const bf16x8 a = tr_nat(lds + KV_K + dt * VS, ks, lane), bb = tr_nat(lds + KV_V + et * VS, ks, lane);
            acc = __builtin_amdgcn_mfma_f32_32x32x16_bf16(a, bb, acc, 0, 0, 0); }
        float* o = ret + ret_off(b, n, h) + (size_t)(32 * dt) * 128 + 32 * et + (lane & 31);
#pragma unroll
        for (int r = 0; r < 16; ++r) o[(size_t)crow(r, lane >> 5) * 128] = acc[r];
        __syncthreads();
    }
}
DI void scan(float* ret, int gtid, int ngt) {
    for (int e = gtid; e < NBATCH * 4 * 8192; e += ngt) {
        const int de = e & 8191, h = (e >> 13) & 3, b = e >> 15;
        const float cd = fast_exp2(128.0f * log2_gamma(h));
        float R = 0.f;
        for (int n0 = 0; n0 < 64; n0 += 8) { float t[8];
#pragma unroll
            for (int k = 0; k < 8; ++k) t[k] = ret[ret_off(b, n0 + k, h) + de];
#pragma unroll
            for (int k = 0; k < 8; ++k) { ret[ret_off(b, n0 + k, h) + de] = R; R = cd * R + t[k]; } }
    }
}
struct ORegs { u32x4 k[2], v[4], q[4]; f32x4 r[4]; };
DI void out_load(ORegs& G, int uid, const bf16_t* proj, const float* ret, int tid) {
    int b, h, n; dec(uid, b, h, n);
    const int lane = tid & 63, w = tid >> 6;
    const bf16_t* kb = proj + hm_off(1792, 4, 64, b, h, 128 * n); const bf16_t* vb = proj + hm_off(2048, 4, 128, b, h, 128 * n); const bf16_t* qb = proj + hm_off(1536, 4, 64, b, h, 128 * n);
#pragma unroll
    for (int i = 0; i < 2; ++i) G.k[i] = *(const u32x4*)(kb + 8 * (tid + 512 * i));
#pragma unroll
    for (int i = 0; i < 4; ++i) G.v[i] = *(const u32x4*)(vb + 8 * (tid + 512 * i));
    const float* rp = ret + ret_off(b, n, h);
#pragma unroll
    for (int i = 0; i < 4; ++i) G.r[i] = *(const f32x4*)(rp + 4 * (tid + 512 * i));
    const bf16_t* qp = qb + (size_t)(32 * (w >> 1) + (lane & 31)) * 64 + 8 * (lane >> 5);
#pragma unroll
    for (int ks = 0; ks < 4; ++ks) G.q[ks] = *(const u32x4*)(qp + 16 * ks);
}
DI void out_write(const ORegs& G, int uid, LAS unsigned char* lds, int tid) {
    const int h = (uid >> 6) & 3; const float gam = 1.0f - exp2f(-5.0f - (float)h);
#pragma unroll
    for (int i = 0; i < 2; ++i) { const int id = tid + 512 * i, tok = id >> 3, ch = id & 7; *(LAS u32x4*)(lds + O_K + 128 * tok + 16 * (ch ^ ((tok >> 1) & 7))) = G.k[i]; }
#pragma unroll
    for (int i = 0; i < 4; ++i) { const int id = tid + 512 * i, tok = id >> 4, ch = id & 15; *(LAS u32x4*)(lds + O_V + (ch >> 2) * VS + tok * 64 + (ch & 3) * 16) = G.v[i]; }
#pragma unroll
    for (int i = 0; i < 4; ++i) { const int id = tid + 512 * i, d = id >> 5, e = 4 * (id & 31); u32x2 o; o.x = cvt_pk_bf16(G.r[i][0] * gam, G.r[i][1] * gam); o.y = cvt_pk_bf16(G.r[i][2] * gam, G.r[i][3] * gam);
        *(LAS u32x2*)(lds + O_R + (e >> 5) * RS + d * 64 + (e & 31) * 2) = o; }
}
DI void out_phase(LAS unsigned char* lds, const bf16_t* proj, const float* ret, bf16_t* omix, int u_lo, int u_hi, int) {
    if (u_lo >= u_hi) return;
    ORegs G; out_load(G, u_lo, proj, ret, otid());
    for (int uid = u_lo; uid < u_hi; ++uid) {
        const int tid = otid(), lane = tid & 63, w = __builtin_amdgcn_readfirstlane(tid >> 6), q = lane & 31, hi = lane >> 5;
        const int qt = w >> 1, eh = w & 1;
        int b, h, n; dec(uid, b, h, n);
        const float lg = log2_gamma(h);
        const size_t row0 = (size_t)b * SEQ + 128 * n;
        out_write(G, uid, lds, tid);
        bf16x8 qr[4];
#pragma unroll
        for (int ks = 0; ks < 4; ++ks) qr[ks] = __builtin_bit_cast(bf16x8, G.q[ks]);
        __syncthreads();
        if (uid + 1 < u_hi) out_load(G, uid + 1, proj, ret, otid());
        f32x16 o[2];
#pragma unroll
        for (int r = 0; r < 16; ++r) { o[0][r] = 0.f; o[1][r] = 0.f; }
#pragma unroll
        for (int ks = 0; ks < 4; ++ks)
#pragma unroll
            for (int t = 0; t < 2; ++t) { const bf16x8 rf = tr_nat(lds + O_R + (2 * eh + t) * RS, ks, lane); o[t] = __builtin_amdgcn_mfma_f32_32x32x16_bf16(qr[ks], rf, o[t], 0, 0, 0); }
#pragma unroll
        for (int kt = 0; kt < 4; ++kt) if (kt <= qt) {
            const int uk = 32 * kt + q;
            f32x16 s;
#pragma unroll
            for (int r = 0; r < 16; ++r) s[r] = 0.f;
#pragma unroll
            for (int ks = 0; ks < 4; ++ks) { const bf16x8 kf = *(const LAS bf16x8*)(lds + O_K + 128 * uk + 16 * ((2 * ks + hi) ^ ((uk >> 1) & 7)));
                s = __builtin_amdgcn_mfma_f32_32x32x16_bf16(kf, qr[ks], s, 0, 0, 0); }
#pragma unroll
            for (int r = 0; r < 16; ++r) { const int kk = 32 * kt + crow(r, hi), qq = 32 * qt + q; s[r] = (kk <= qq) ? s[r] * fast_exp2(-lg * (float)kk) : 0.f; }
#pragma unroll
            for (int s2 = 0; s2 < 2; ++s2) { u32x4 pw; pw.x = cvtpk(s[8 * s2 + 0], s[8 * s2 + 1]); pw.y = cvtpk(s[8 * s2 + 2], s[8 * s2 + 3]); pw.z = cvtpk(s[8 * s2 + 4], s[8 * s2 + 5]); pw.w = cvtpk(s[8 * s2 + 6], s[8 * s2 + 7]);
                const bf16x8 pa = __builtin_bit_cast(bf16x8, pw);
#pragma unroll
                for (int t = 0; t < 2; ++t) { const bf16x8 vf = tr_perm(lds + O_V + (2 * eh + t) * VS, 32 * kt + 16 * s2, lane); o[t] = __builtin_amdgcn_mfma_f32_32x32x16_bf16(pa, vf, o[t], 0, 0, 0); } }
        }
        unsigned gq[16];
        { const bf16_t* gb = proj + hm_off(2560, 4, 128, b, h, 128 * n);
#pragma unroll
          for (int k = 0; k < 16; ++k) gq[k] = *(const unsigned*)(gb + (size_t)(16 * w + k) * 128 + 2 * lane); }
        LAS float* st = (LAS float*)(lds + O_ST);
#pragma unroll
        for (int r = 0; r < 16; ++r) { const int qq = 32 * qt + crow(r, hi); const float a = fast_exp2(lg * (float)qq);
#pragma unroll
            for (int t = 0; t < 2; ++t) st[qq * O_LD + 32 * (2 * eh + t) + q] = o[t][r] * a; }
        __syncthreads();
        float rsn;
        { const LAS f32x4* rp = (const LAS f32x4*)(st + (16 * w + (lane >> 2)) * O_LD + 32 * (lane & 3)); float ss = 0.f;
#pragma unroll
          for (int i = 0; i < 8; ++i) { const f32x4 x = rp[i]; ss += (x[0] * x[0] + x[1] * x[1]) + (x[2] * x[2] + x[3] * x[3]); }
          ss += __shfl_xor(ss, 1); ss += __shfl_xor(ss, 2);
          rsn = rsqrtf(ss * (1.0f / 128.0f) + EPS); }
#pragma unroll
        for (int k = 0; k < 16; ++k) { const int rr = 16 * w + k;
            const f32x2 v = *(const LAS f32x2*)(st + rr * O_LD + 2 * lane);
            const float rs = __shfl(rsn, 4 * k);
            const float g0 = bf2f(gq[k] & 0xffffu), g1 = bf2f(gq[k] >> 16);
            *(unsigned*)(omix + (row0 + rr) * D + 512 + h * 128 + 2 * lane) = cvt_pk_bf16(silu_f(g0) * v[0] * rs, silu_f(g1) * v[1] * rs); }
    }
}
}

constexpr int NPH = 14;
__global__ void __launch_bounds__(NWAVES * 64, 2) mk_fwd(Args args) {
    extern __shared__ __attribute__((aligned(16))) unsigned char lds_raw[];
    LAS unsigned char* lds = (LAS unsigned char*)lds_raw;
    volatile LAS unsigned* MISC = (volatile LAS unsigned*)(lds + MISC_OFF);
    const int wave = __builtin_amdgcn_readfirstlane((int)threadIdx.x >> 6);
#define tid (otid())
#define lane (otid() & 63)
    const int G = gridDim.x; const int bx = blockIdx.x;
    const int vcu = (G % 8 == 0) ? (bx % 8) * (G / 8) + bx / 8 : bx;
    const int gw = vcu * NWAVES + wave, NGW = G * NWAVES;
    unsigned char* ws = args.ws;
    unsigned* ctl = (unsigned*)(ws + WS_CTL);
    for (int u = tid; u < (LDS_BYTES - LDSCTL_OFF) / 4; u += NWAVES * 64) ((LAS unsigned*)(lds + LDSCTL_OFF))[u] = 0u;
    __syncthreads();
    XcdBarrier bar = xcd_barrier_post(ctl + CW_BAR, MISC + 8);
    const int lo = args.ph_lo, hi = args.ph_hi;
#define IN(k) (lo <= (k) && (k) < hi)
#define SEAM(k) do { if (IN(k) && IN((k) + 1)) xcd_barrier(bar); } while (0)

#define XIN ((const float*)args.in[0])
#define MEMIN ((const float*)args.in[1])
#define W1in ((bf16_t*)(ws + WS_W1IN))
#define W1out ((bf16_t*)(ws + WS_W1OUT))
#define Win ((bf16_t*)(ws + WS_WIN))
#define Wout ((bf16_t*)(ws + WS_WOUT))
#define Wcq ((bf16_t*)(ws + WS_WCQ))
#define Wckv ((bf16_t*)(ws + WS_WCKV))
#define Wco ((bf16_t*)(ws + WS_WCO))
#define W2in ((bf16_t*)(ws + WS_W2IN))
#define W2out ((bf16_t*)(ws + WS_W2OUT))
#define cosA ((float*)(ws + WS_COSA))
#define sinA ((float*)(ws + WS_SINA))
#define cosR ((float*)(ws + WS_COSR))
#define sinR ((float*)(ws + WS_SINR))
#define MEMN ((bf16_t*)(ws + WS_MEMN))
#define KVC ((bf16_t*)(ws + WS_KC))
#define SSQ ((float*)(ws + WS_SSQ))
#define XB ((bf16_t*)(ws + WS_XB))
#define BIG ((bf16_t*)(ws + WS_BIG))
#define OMIX ((bf16_t*)(ws + WS_OMIX))
#define QC ((bf16_t*)(ws + WS_ATT))
#define ATTP ((bf16_t*)(ws + WS_ATT))
#define LSE ((float*)(ws + WS_ATT + (size_t)M * 512 * 2 * 3))
#define RETB ((float*)(ws + WS_RET))
#define xres (args.xres)
    if (IN(0)) {
        LAS float* scr = (LAS float*)(lds + RING_OFF + wave * 16384);
        constexpr int I0 = (D / 64) * (2 * DFF / 32), I1 = (DFF / 64) * (D / 32), I2 = (D / 64) * (INC / 32), I3 = (D / 64) * (D / 32), I5 = (D / 64) * (2 * D / 32);
        constexpr int NITEMS = 2 * I0 + 2 * I1 + I2 + 3 * I3 + I5;
        for (int it = gw; it < NITEMS; it += NGW) {
            int r = it;
            if (r < I0) { p0_transpose_item(args.in[3], D, 2 * DFF, W1in, 0, nullptr, scr, r, lane); continue; } r -= I0;
            if (r < I1) { p0_transpose_item(args.in[4], DFF, D, W1out, 1, nullptr, scr, r, lane); continue; } r -= I1;
            if (r < I2) { p0_transpose_item(args.in[6], D, INC, Win, 2, args.in[5], scr, r, lane); continue; } r -= I2;
            if (r < I3) { p0_transpose_item(args.in[7], D, D, Wout, 3, nullptr, scr, r, lane); continue; } r -= I3;
            if (r < I3) { p0_transpose_item(args.in[10], D, D, Wcq, 4, args.in[8], scr, r, lane); continue; } r -= I3;
            if (r < I5) { p0_transpose_item(args.in[11], D, 2 * D, Wckv, 5, nullptr, scr, r, lane); continue; } r -= I5;
            if (r < I3) { p0_transpose_item(args.in[12], D, D, Wco, 6, nullptr, scr, r, lane); continue; } r -= I3;
            if (r < I0) { p0_transpose_item(args.in[14], D, 2 * DFF, W2in, 7, args.in[13], scr, r, lane); continue; } r -= I0;
            p0_transpose_item(args.in[15], DFF, D, W2out, 8, nullptr, scr, r, lane);
        }
        for (int m = gw; m < M; m += 2 * NGW) rms_row2_to_bf16(XIN + (size_t)m * D, (m + NGW < M) ? XIN + (size_t)(m + NGW) * D : nullptr, args.in[2], XB + (size_t)m * D, XB + (size_t)(m + NGW) * D, lane);
        for (int m = gw; m < MROWS; m += NGW) rms_row_to_bf16(MEMIN + (size_t)m * D, args.in[9], MEMN + (size_t)m * D, lane);
    }
    SEAM(0);
    if (IN(1)) {
        pg8::Gemm g{XB, W1in, D, D, D}; pg8::StaticOrder S; S.init(M, 2 * DFF, G, bx, D, D);
        pg8::EpiSwiGLU<false> E{BIG, nullptr};
        pg8::gemm_phase<pg8::EpiSwiGLU<false>, pg8::StaticOrder, true>(lds + RING_OFF, g, S, E);
    }
    SEAM(1);
    if (IN(2)) {
        pg8::Gemm g{BIG, W1out, DFF, DFF, DFF}; pg8::StaticOrder S; S.init(M, D, G, bx, DFF, DFF);
        pg8::EpiResid<0> E{XIN, nullptr, XB, SSQ};
        pg8::gemm_phase<pg8::EpiResid<0>, pg8::StaticOrder, true>(lds + RING_OFF, g, S, E);
    }
    SEAM(2);
    if (IN(3)) {
        pg8::Gemm g{XB, Win, D, D, D}; pg8::StaticOrder S; S.init(M, INC, G, bx, D, D);
        pg8::EpiInProj E{BIG, SSQ, cosA, sinA, cosR, sinR};
        pg8::gemm_phase<pg8::EpiInProj, pg8::StaticOrder, true>(lds + RING_OFF, g, S, E);
    }
    SEAM(3);
    if (IN(4)) {
        const int nkv = (MROWS / 256) * 8;
        { pg8::Gemm g{MEMN, Wckv, D, D, D}; pg8::StaticOrder S; S.init(MROWS, 2 * D, G, vcu, D, D);
          pg8::EpiPlain<false> E{KVC, 2 * D, nullptr};
          pg8::gemm_phase<pg8::EpiPlain<false>, pg8::StaticOrder, true>(lds + RING_OFF, g, S, E); }
        { da::UnitMap U;
          if (G % 8 == 0) U.init(vcu / (G / 8), vcu % (G / 8), G / 8, NBATCH);
          else U.init(0, vcu, G, NBATCH * 8);
          da::phase(lds, BIG, ATTP, LSE, U); }
        { const int nunits = NBATCH * 4 * 64; const int per = (nunits + G - 1) / G; const int u_lo = vcu * per, u_hi = (u_lo + per < nunits) ? u_lo + per : nunits;
          rt::kv_phase(lds, BIG, RETB, u_lo, u_hi); }
    }
    SEAM(4);
    if (IN(5)) { rt::scan(RETB, vcu * NWAVES * 64 + tid, G * NWAVES * 64); da::merge(ATTP, LSE, OMIX, vcu * NWAVES * 64 + tid, G * NWAVES * 64); }
    SEAM(5);
    if (IN(6)) { const int nunits = NBATCH * 4 * 64; const int per = (nunits + G - 1) / G; const int u_lo = vcu * per, u_hi = (u_lo + per < nunits) ? u_lo + per : nunits;
        rt::out_phase(lds, BIG, RETB, OMIX, u_lo, u_hi, tid); }
    SEAM(6);
    if (IN(7)) {
        pg8::Gemm g{OMIX, Wout, D, D, D}; pg8::StaticOrder S; S.init(M, D, G, bx, D, D);
        pg8::EpiResid<1> E{nullptr, nullptr, XB, SSQ};
        pg8::gemm_phase<pg8::EpiResid<1>, pg8::StaticOrder, true>(lds + RING_OFF, g, S, E);
    }
    SEAM(7);
    if (IN(8)) {
        { pg8::Gemm g{XB, Wcq, D, D, D}; pg8::StaticOrder S; S.init(M, D, G, bx, D, D);
          pg8::EpiPlain<true> E{QC, D, SSQ};
          pg8::gemm_phase<pg8::EpiPlain<true>, pg8::StaticOrder, true>(lds + RING_OFF, g, S, E); }
    }
    SEAM(8);
    if (IN(9)) { const int nunits = NBATCH * 4 * 32; const int per = (nunits + G - 1) / G; const int u_lo = vcu * per, u_hi = (u_lo + per < nunits) ? u_lo + per : nunits;
        xa::phase(lds, QC, KVC, OMIX, u_lo, u_hi, tid); }
    SEAM(9);
    if (IN(10)) {
        pg8::Gemm g{OMIX, Wco, D, D, D}; pg8::StaticOrder S; S.init(M, D, G, bx, D, D);
        pg8::EpiResid<1> E{nullptr, nullptr, XB, SSQ};
        pg8::gemm_phase<pg8::EpiResid<1>, pg8::StaticOrder, true>(lds + RING_OFF, g, S, E);
    }
    SEAM(10);
    if (IN(11)) {
        pg8::Gemm g{XB, W2in, D, D, D}; pg8::StaticOrder S; S.init(M, 2 * DFF, G, bx, D, D);
        pg8::EpiSwiGLU<true> E{BIG, SSQ};
        pg8::gemm_phase<pg8::EpiSwiGLU<true>, pg8::StaticOrder, true>(lds + RING_OFF, g, S, E);
    }
    SEAM(11);
    if (IN(12)) {
        pg8::Gemm g{BIG, W2out, DFF, DFF, DFF}; pg8::StaticOrder S; S.init(M, D, G, bx, DFF, DFF);
        pg8::EpiResid<1> E{nullptr, nullptr, XB, SSQ};
        pg8::gemm_phase<pg8::EpiResid<1>, pg8::StaticOrder, true>(lds + RING_OFF, g, S, E);
    }
    SEAM(12);
    if (IN(13)) {
        const float* wf = args.in[16];
        for (int m = gw; m < M; m += NGW) {
            const f32x4 p = *(const f32x4*)(SSQ + (size_t)m * 4);
            const float r = rsqrtf(((p[0] + p[1]) + (p[2] + p[3])) * (1.f / D) + EPS);
            const u32x4* xr = (const u32x4*)(XB + (size_t)m * D) + lane;
            f32x4* orow = (f32x4*)(xres + (size_t)m * D) + 2 * lane;
#pragma unroll
            for (int j = 0; j < 2; ++j) { const u32x4 w = xr[64 * j]; const f32x4 w0 = ((const f32x4*)wf)[128 * j + 2 * lane], w1 = ((const f32x4*)wf)[128 * j + 2 * lane + 1];
                f32x4 o0 = {bf2f(w[0] & 0xffffu), bf2f(w[0] >> 16), bf2f(w[1] & 0xffffu), bf2f(w[1] >> 16)}, o1 = {bf2f(w[2] & 0xffffu), bf2f(w[2] >> 16), bf2f(w[3] & 0xffffu), bf2f(w[3] >> 16)};
                orow[128 * j] = o0 * r * w0; orow[128 * j + 1] = o1 * r * w1; }
        }
    }
#undef IN
#undef SEAM
#undef tid
#undef lane
#undef XIN
#undef MEMIN
#undef W1in
#undef W1out
#undef Win
#undef Wout
#undef Wcq
#undef Wckv
#undef Wco
#undef W2in
#undef W2out
#undef cosA
#undef sinA
#undef cosR
#undef sinR
#undef MEMN
#undef KVC
#undef SSQ
#undef XB
#undef BIG
#undef OMIX
#undef QC
#undef ATTP
#undef LSE
#undef RETB
#undef xres
}


extern "C" void kernel_launch(void* const* d_in, const int* in_sizes, int n_in, void* d_out, int out_size, void* d_ws, size_t ws_size, hipStream_t stream) {
    static int grid = 0;
    if (grid == 0) {
        int dev = 0, cus = 0, per_cu = 0;
        if (n_in != 17 || ws_size < WS_OPT_END) { fprintf(stderr, "kernel_launch: unexpected inputs (n_in %d, ws %zu < %zu)\n", n_in, ws_size, (size_t)WS_OPT_END); grid = -1; return; }
        if (hipGetDevice(&dev) != hipSuccess || hipDeviceGetAttribute(&cus, hipDeviceAttributeMultiprocessorCount, dev) != hipSuccess) { grid = -1; return; }
        if (hipFuncSetAttribute((const void*)mk_fwd, hipFuncAttributeMaxDynamicSharedMemorySize, LDS_BYTES) != hipSuccess) { fprintf(stderr, "kernel_launch: hipFuncSetAttribute failed\n"); grid = -1; return; }
        if (hipOccupancyMaxActiveBlocksPerMultiprocessor(&per_cu, (const void*)mk_fwd, NWAVES * 64, LDS_BYTES) != hipSuccess || per_cu < 1) { fprintf(stderr, "kernel_launch: occupancy query says %d blocks per CU\n", per_cu); (void)hipGetLastError(); grid = -1; return; }
        grid = cus;
    }
    if (grid < 0) return;
    (void)hipMemsetAsync((char*)d_ws + WS_CTL, 0, CTL_ZERO_BYTES, stream);
    Args a{};
    for (int i = 0; i < 17; ++i) a.in[i] = (const float*)d_in[i];
    a.out = (float*)d_out; a.ws = (unsigned char*)d_ws;
    a.xres = (float*)d_out; a.ph_lo = 0; a.ph_hi = NPH;
    hipLaunchKernelGGL(mk_fwd, dim3(grid), dim3(NWAVES * 64), LDS_BYTES, stream, a);
}
```

```cpp
#include <hip/hip_runtime.h>
#include <cstdio>
#include <cstdint>
#include <cmath>

#define DI __device__ __forceinline__

constexpr int D = 1024, NB_ALL = 8, SEQ = 8192, MEMLEN = 256, DFF = 2816, INC = 3072;
constexpr int NBATCH = 8;
constexpr int M = NBATCH * SEQ;
constexpr int MROWS = NBATCH * MEMLEN;
constexpr float EPS = 1e-6f;
constexpr float LOG2E = 1.4426950408889634f;

typedef unsigned short bf16_t;
typedef short bf16x8 __attribute__((ext_vector_type(8)));
typedef float f32x4 __attribute__((ext_vector_type(4)));
typedef float f32x2 __attribute__((ext_vector_type(2)));
typedef unsigned u32x4 __attribute__((ext_vector_type(4)));
typedef unsigned u32x2 __attribute__((ext_vector_type(2)));
#define LAS __attribute__((address_space(3)))
#define GAS __attribute__((address_space(1)))

DI int otid() { int t = threadIdx.x; asm volatile("" : "+v"(t)); return t; }
DI float bf2f(unsigned u16) { return __uint_as_float(u16 << 16); }
DI unsigned cvt_pk_bf16(float lo, float hi) { unsigned r; asm volatile("v_cvt_pk_bf16_f32 %0, %1, %2" : "=v"(r) : "v"(lo), "v"(hi)); return r; }
DI float fast_exp2(float x) { return __builtin_amdgcn_exp2f(x); }
DI float fast_rcp(float x) { return __builtin_amdgcn_rcpf(x); }
DI float silu_f(float x) { return x * fast_rcp(1.0f + fast_exp2(-x * LOG2E)); }


DI size_t hm_off(int secoff, int nheads, int hw, int b, int head, int t) { return (size_t)M * secoff + ((size_t)(b * nheads + head) * SEQ + t) * hw; }

namespace pg8 {
constexpr int BM = 256, BK = 64, HALF = 128, HTB = HALF * BK * 2, STAGE_BYTES = 8 * HTB, NXCD = 8, WGM = 8;
constexpr int EPI_SCR = STAGE_BYTES;
constexpr int EPI_RS = EPI_SCR + 4096, EPI_RS_MAX = 24;
__host__ __device__ __forceinline__ int lds_byte(int r, int c) { const int st = (r >> 4) * 2 + (c >> 5), rr = r & 15, cc = c & 31, ob = rr * 64 + cc * 2; return st * 1024 + (ob ^ (((ob >> 9) & 1) << 5)); }
__host__ __device__ __forceinline__ void stage_rc(int b, int& R, int& C) { const int st = b / 1024, sb = b % 1024, swz = sb ^ (((sb >> 9) & 1) << 5); R = (st >> 1) * 16 + swz / 64; C = (st & 1) * 32 + (swz % 64) / 2; }
__host__ __device__ __forceinline__ int perm32(int rho) { const int n = rho >> 4, i = rho & 15; return 8 * (i >> 2) + 4 * n + (i & 3); }

struct Unit { int pm, pn, z; };
struct Gemm { const bf16_t* A; const bf16_t* Bt; int lda, ldb, K; };

struct StaticOrder {
    int nM, nN, nwg, G, c, lda, ldb;
    DI void init(int M_, int N_, int G_, int c_, int lda_, int ldb_) { nM = M_ / BM; nN = N_ / BM; nwg = nM * nN; G = G_; c = c_; lda = lda_; ldb = ldb_; }
    DI bool next(int i, Unit& u) const {
        const long L = (long)i * G + c; if (L >= nwg) return false;
        int wgid = (int)L; { const int q = nwg / NXCD, r = nwg % NXCD, xcd = wgid % NXCD, off = wgid / NXCD; wgid = (xcd < r ? xcd * (q + 1) : r * (q + 1) + (xcd - r) * q) + off; }
        const int nig = WGM * nN, gid = wgid / nig, fm = gid * WGM, gsz = (nM - fm) < WGM ? (nM - fm) : WGM;
        u.pm = fm + ((wgid % nig) % gsz); u.pn = (wgid % nig) / gsz; u.z = 0; return true;
    }
    DI size_t a_off(const Unit& u) const { return (size_t)u.pm * BM * lda; }
    DI size_t b_off(const Unit& u) const { return (size_t)u.pn * BM * ldb; }
};

template <class Epi, class Sched, bool ALIGN_EPI>
DI void gemm_phase(LAS unsigned char* lds, const Gemm g, const Sched& S, const Epi& E) {
    const int tid = otid(), wid = __builtin_amdgcn_readfirstlane(tid >> 6), lane = tid & 63, wr = wid >> 2, wc = wid & 3, fr = lane & 15, fq = lane >> 4;
    const int nt = g.K / BK;
    unsigned voffA[2], voffB[2];
#pragma unroll
    for (int i = 0; i < 2; ++i) { int R, C; stage_rc(tid * 16 + i * 8192, R, C); const int Rb = Epi::PERM ? ((R & ~31) + perm32(R & 31)) : R;
        voffA[i] = (unsigned)(R * g.lda + C) * 2u; voffB[i] = (unsigned)(Rb * g.ldb + C) * 2u; }
    const size_t kstep = (size_t)(BK * 2);
    const size_t hstepA = (size_t)HALF * g.lda * 2, hstepB = (size_t)HALF * g.ldb * 2;
    const unsigned ldsw = (unsigned)wid * 1024u;
    const int aoff = lds_byte(wr * 64 + fr, fq * 8), boff = lds_byte(wc * 32 + fr, fq * 8);
#define PG8_SA(b, h) (((b) * 2 + (h)) * HTB)
#define PG8_SB(b, h) ((4 + (b) * 2 + (h)) * HTB)
#define PG8_STAGE(bufoff, gbase, voff) do { _Pragma("unroll") for (int _i = 0; _i < 2; ++_i) \
        __builtin_amdgcn_global_load_lds((const unsigned*)((const char*)(gbase) + (voff)[_i]), (LAS unsigned*)(lds + (bufoff) + ldsw + _i * 8192), 16, 0, 0); } while (0)
#define PG8_LDA(dst, b, h) do { _Pragma("unroll") for (int m = 0; m < 4; ++m) _Pragma("unroll") for (int k = 0; k < 2; ++k) dst[m][k] = *(const LAS bf16x8*)(lds + PG8_SA(b, h) + aoff + m * 2048 + k * 1024); } while (0)
#define PG8_LDB(dst, b, h) do { _Pragma("unroll") for (int n = 0; n < 2; ++n) _Pragma("unroll") for (int k = 0; k < 2; ++k) dst[n][k] = *(const LAS bf16x8*)(lds + PG8_SB(b, h) + boff + n * 2048 + k * 1024); } while (0)
#define PG8_MMA(ai, bj, At, Bt) do { __builtin_amdgcn_s_setprio(1); _Pragma("unroll") for (int m = 0; m < 4; ++m) _Pragma("unroll") for (int n = 0; n < 2; ++n) _Pragma("unroll") for (int k = 0; k < 2; ++k) \
        acc[ai][bj][m][n] = __builtin_amdgcn_mfma_f32_16x16x32_bf16(Bt[n][k], At[m][k], acc[ai][bj][m][n], 0, 0, 0); __builtin_amdgcn_s_setprio(0); } while (0)
#define PG8_WAIT_V(n) asm volatile("s_waitcnt vmcnt(" #n ")" ::: "memory")
#define PG8_WAIT_L(n) asm volatile("s_waitcnt lgkmcnt(" #n ")" ::: "memory")
#define PG8_BAR __builtin_amdgcn_s_barrier()
#define PG8_SCHED __builtin_amdgcn_sched_barrier(0)
    Unit cur, nxt; int ui = 0;
    if (!S.next(0, cur)) return;
    E.preload(S, lds + EPI_RS);
    f32x4 acc[2][2][4][2];
    E.init(acc, cur, wr, wc, fr, fq);
    bf16x8 At[4][2], B0[2][2], B1[2][2];
    const char* cA = (const char*)(g.A + S.a_off(cur)); const char* cB = (const char*)(g.Bt + S.b_off(cur));
    PG8_STAGE(PG8_SB(0, 0), cB, voffB); PG8_STAGE(PG8_SB(0, 1), cB + hstepB, voffB); PG8_STAGE(PG8_SA(0, 0), cA, voffA); PG8_STAGE(PG8_SA(0, 1), cA + hstepA, voffA);
    if (wr == 1) PG8_BAR;
    PG8_WAIT_V(2); PG8_BAR;
    PG8_STAGE(PG8_SB(1, 0), cB + kstep, voffB); PG8_STAGE(PG8_SA(1, 0), cA + kstep, voffA); PG8_STAGE(PG8_SB(1, 1), cB + hstepB + kstep, voffB);
    PG8_WAIT_V(6); PG8_BAR;
    for (;;) {
        const bool has_next = S.next(ui + 1, nxt);
        const char* nA = has_next ? (const char*)(g.A + S.a_off(nxt)) : cA; const char* nB = has_next ? (const char*)(g.Bt + S.b_off(nxt)) : cB;
        for (int t = 0; t < nt; t += 2) {
            const bool last = (t == nt - 2);
            const char* a1 = cA + (size_t)(t + 1) * kstep;
            const char* a2 = last ? nA : cA + (size_t)(t + 2) * kstep; const char* b2 = last ? nB : cB + (size_t)(t + 2) * kstep;
            const char* a3 = a2 + kstep; const char* b3 = b2 + kstep;
            PG8_LDB(B0, 0, 0); PG8_LDB(B1, 0, 1); PG8_SCHED; PG8_LDA(At, 0, 0); PG8_STAGE(PG8_SA(1, 1), a1 + hstepA, voffA);
            PG8_WAIT_V(8); PG8_WAIT_L(0); PG8_BAR; PG8_MMA(0, 0, At, B0); PG8_MMA(0, 1, At, B1); PG8_BAR; PG8_SCHED;
            PG8_LDA(At, 0, 1); PG8_STAGE(PG8_SB(0, 0), b2, voffB); PG8_STAGE(PG8_SB(0, 1), b2 + hstepB, voffB); PG8_STAGE(PG8_SA(0, 0), a2, voffA);
            PG8_WAIT_V(8); PG8_WAIT_L(0); PG8_BAR; PG8_MMA(1, 0, At, B0); PG8_MMA(1, 1, At, B1); PG8_BAR; PG8_SCHED;
            PG8_LDB(B0, 1, 0); PG8_LDB(B1, 1, 1); PG8_SCHED; PG8_LDA(At, 1, 0); PG8_STAGE(PG8_SA(0, 1), a2 + hstepA, voffA);
            PG8_WAIT_V(8); PG8_WAIT_L(0); PG8_BAR; PG8_MMA(0, 0, At, B0); PG8_MMA(0, 1, At, B1); PG8_BAR; PG8_SCHED;
            PG8_LDA(At, 1, 1); PG8_STAGE(PG8_SB(1, 0), b3, voffB); PG8_STAGE(PG8_SB(1, 1), b3 + hstepB, voffB); PG8_STAGE(PG8_SA(1, 0), a3, voffA);
            PG8_WAIT_V(8); PG8_WAIT_L(0); PG8_BAR; PG8_MMA(1, 0, At, B0); PG8_MMA(1, 1, At, B1); PG8_BAR; PG8_SCHED;
        }
        if constexpr (ALIGN_EPI) { if (wr == 0) PG8_BAR; }
        E(acc, cur, ui, wr, wc, fr, fq, lds + EPI_SCR);
        if (!has_next) break;
        E.init(acc, nxt, wr, wc, fr, fq);
        cur = nxt; cA = nA; cB = nB; ++ui;
        if constexpr (ALIGN_EPI) { if (wr == 1) PG8_BAR; }
    }
    PG8_WAIT_V(0);
    if constexpr (!ALIGN_EPI) { if (wr == 0) PG8_BAR; }
    PG8_BAR;
#undef PG8_SA
#undef PG8_SB
#undef PG8_STAGE
#undef PG8_LDA
#undef PG8_LDB
#undef PG8_MMA
#undef PG8_WAIT_V
#undef PG8_WAIT_L
#undef PG8_BAR
#undef PG8_SCHED
}

DI void zero_acc(f32x4 (&acc)[2][2][4][2]) {
#pragma unroll
    for (int a = 0; a < 2; ++a)
#pragma unroll
        for (int b = 0; b < 2; ++b)
#pragma unroll
            for (int m = 0; m < 4; ++m)
#pragma unroll
                for (int n = 0; n < 2; ++n) acc[a][b][m][n] = (f32x4){0.f, 0.f, 0.f, 0.f};
}
template <class Sched> DI void preload_rstd(const Sched& S, const float* ssq4, LAS unsigned char* tab) {
    const int t = otid(); Unit u;
    if (t < 256) for (int i = 0; i < EPI_RS_MAX && S.next(i, u); ++i) { const f32x4 p = *(const f32x4*)(ssq4 + (size_t)(u.pm * BM + t) * 4);
        ((LAS float*)tab)[i * 256 + t] = rsqrtf(((p[0] + p[1]) + (p[2] + p[3])) * (1.0f / 1024.0f) + EPS); }
}
DI void load_rstd(float (&rs)[2][4], LAS unsigned char* scr, int ui, int wr, int fr) {
    const LAS float* tab = (const LAS float*)(scr + 4096) + ui * 256 + wr * 64 + fr;
#pragma unroll
    for (int ai = 0; ai < 2; ++ai)
#pragma unroll
        for (int m = 0; m < 4; ++m) rs[ai][m] = tab[ai * HALF + m * 16];
}
DI u32x4 pack8(const f32x4 v0, const f32x4 v1) { u32x4 w; w.x = cvt_pk_bf16(v0[0], v0[1]); w.y = cvt_pk_bf16(v0[2], v0[3]); w.z = cvt_pk_bf16(v1[0], v1[1]); w.w = cvt_pk_bf16(v1[2], v1[3]); return w; }

template <bool SCALE> struct EpiSwiGLU {
    static constexpr bool PERM = true;
    bf16_t* O; const float* ssq4;
    template <class Sched> DI void preload(const Sched& S, LAS unsigned char* tab) const { if (SCALE) preload_rstd(S, ssq4, tab); }
    DI void init(f32x4 (&acc)[2][2][4][2], const Unit&, int, int, int, int) const { zero_acc(acc); }
    DI void operator()(const f32x4 (&acc)[2][2][4][2], const Unit& u, int ui, int wr, int wc, int fr_, int fq_, LAS unsigned char* scr) const {
        int l_ = fr_ + 16 * fq_; asm volatile("" : "+v"(l_)); const int fr = l_ & 15, fq = l_ >> 4;
        const int row0 = u.pm * BM + wr * 64 + fr, col0 = u.pn * 128 + wc * 32 + 8 * fq;
        float rs[2][4];
        if (SCALE) load_rstd(rs, scr, ui, wr, fr);
#pragma unroll
        for (int ai = 0; ai < 2; ++ai)
#pragma unroll
            for (int m = 0; m < 4; ++m) { const int row = row0 + ai * HALF + m * 16; const float r = SCALE ? rs[ai][m] : 1.0f;
                f32x4 o0, o1;
#pragma unroll
                for (int i = 0; i < 4; ++i) { o0[i] = silu_f(acc[ai][0][m][0][i] * r) * (acc[ai][1][m][0][i] * r); o1[i] = silu_f(acc[ai][0][m][1][i] * r) * (acc[ai][1][m][1][i] * r); }
                *(u32x4*)(O + (size_t)row * DFF + col0) = pack8(o0, o1); }
    }
};
template <int MODE> struct EpiResid {
    static constexpr bool PERM = true;
    const float* R; float* out; bf16_t* XB; float* ssq4;
    template <class Sched> DI void preload(const Sched&, LAS unsigned char*) const {}
    DI void init(f32x4 (&acc)[2][2][4][2], const Unit& u, int wr, int wc, int fr_, int fq_) const {
        int l_ = fr_ + 16 * fq_; asm volatile("" : "+v"(l_)); const int fr = l_ & 15, fq = l_ >> 4;
        const int row0 = u.pm * BM + wr * 64 + fr, col0 = u.pn * BM + wc * 32 + 8 * fq;
        if (MODE == 0) {
#pragma unroll
            for (int ai = 0; ai < 2; ++ai)
#pragma unroll
                for (int m = 0; m < 4; ++m)
#pragma unroll
                    for (int bj = 0; bj < 2; ++bj) { const float* p = R + (size_t)(row0 + ai * HALF + m * 16) * D + col0 + bj * HALF;
                        acc[ai][bj][m][0] = *(const f32x4*)p; acc[ai][bj][m][1] = *(const f32x4*)(p + 4); }
        } else {
            u32x4 w[2][4][2];
#pragma unroll
            for (int ai = 0; ai < 2; ++ai)
#pragma unroll
                for (int m = 0; m < 4; ++m)
#pragma unroll
                    for (int bj = 0; bj < 2; ++bj) w[ai][m][bj] = *(const u32x4*)(XB + (size_t)(row0 + ai * HALF + m * 16) * D + col0 + bj * HALF);
#pragma unroll
            for (int ai = 0; ai < 2; ++ai)
#pragma unroll
                for (int m = 0; m < 4; ++m)
#pragma unroll
                    for (int bj = 0; bj < 2; ++bj) { const u32x4 x = w[ai][m][bj];
                        acc[ai][bj][m][0] = (f32x4){bf2f(x[0] & 0xffffu), bf2f(x[0] >> 16), bf2f(x[1] & 0xffffu), bf2f(x[1] >> 16)};
                        acc[ai][bj][m][1] = (f32x4){bf2f(x[2] & 0xffffu), bf2f(x[2] >> 16), bf2f(x[3] & 0xffffu), bf2f(x[3] >> 16)}; }
        }
    }
    DI void operator()(const f32x4 (&acc)[2][2][4][2], const Unit& u, int ui, int wr, int wc, int fr_, int fq_, LAS unsigned char* scr) const {
        int l_ = fr_ + 16 * fq_; asm volatile("" : "+v"(l_)); const int fr = l_ & 15, fq = l_ >> 4;
        const int col0 = u.pn * BM + wc * 32 + 8 * fq;
        LAS float* S = (LAS float*)scr;
#pragma unroll
        for (int ai = 0; ai < 2; ++ai)
#pragma unroll
            for (int m = 0; m < 4; ++m) { const int rl = ai * HALF + wr * 64 + m * 16 + fr; const int row = u.pm * BM + rl; float ss = 0.f;
#pragma unroll
                for (int bj = 0; bj < 2; ++bj) { const size_t off = (size_t)row * D + col0 + bj * HALF;
                    const f32x4 v0 = acc[ai][bj][m][0], v1 = acc[ai][bj][m][1];
                    if (MODE == 2) { *(f32x4*)(out + off) = v0; *(f32x4*)(out + off + 4) = v1; }
                    else { *(u32x4*)(XB + off) = pack8(v0, v1);
                        ss += (v0[0] * v0[0] + v0[1] * v0[1]) + (v0[2] * v0[2] + v0[3] * v0[3]) + (v1[0] * v1[0] + v1[1] * v1[1]) + (v1[2] * v1[2] + v1[3] * v1[3]); } }
                if (MODE != 2) { ss += __shfl_xor(ss, 16); ss += __shfl_xor(ss, 32); if (fq == 0) S[rl * 4 + wc] = ss; } }
        if (MODE != 2) {
            asm volatile("s_waitcnt lgkmcnt(0)" ::: "memory"); __builtin_amdgcn_s_barrier(); asm volatile("" ::: "memory");
            const int t = otid();
            if (t < 256) { const f32x4 p = *(const LAS f32x4*)(S + t * 4); ssq4[(size_t)(u.pm * BM + t) * 4 + u.pn] = (p[0] + p[1]) + (p[2] + p[3]); }
        }
    }
};
template <bool SCALE> struct EpiPlain {
    static constexpr bool PERM = true;
    bf16_t* O; int ldc; const float* ssq4;
    template <class Sched> DI void preload(const Sched& S, LAS unsigned char* tab) const { if (SCALE) preload_rstd(S, ssq4, tab); }
    DI void init(f32x4 (&acc)[2][2][4][2], const Unit&, int, int, int, int) const { zero_acc(acc); }
    DI void operator()(const f32x4 (&acc)[2][2][4][2], const Unit& u, int ui, int wr, int wc, int fr_, int fq_, LAS unsigned char* scr) const {
        int l_ = fr_ + 16 * fq_; asm volatile("" : "+v"(l_)); const int fr = l_ & 15, fq = l_ >> 4;
        const int row0 = u.pm * BM + wr * 64 + fr, col0 = u.pn * BM + wc * 32 + 8 * fq;
        float rs[2][4];
        if (SCALE) load_rstd(rs, scr, ui, wr, fr);
#pragma unroll
        for (int ai = 0; ai < 2; ++ai)
#pragma unroll
            for (int m = 0; m < 4; ++m) { const int row = row0 + ai * HALF + m * 16; const float r = SCALE ? rs[ai][m] : 1.0f;
#pragma unroll
                for (int bj = 0; bj < 2; ++bj) *(u32x4*)(O + (size_t)row * ldc + col0 + bj * HALF) = pack8(acc[ai][bj][m][0] * r, acc[ai][bj][m][1] * r); }
    }
};
struct EpiInProj {
    static constexpr bool PERM = true;
    bf16_t* O; const float* ssq4; const float* cosA; const float* sinA; const float* cosR; const float* sinR;
    template <class Sched> DI void preload(const Sched& S, LAS unsigned char* tab) const { preload_rstd(S, ssq4, tab); }
    DI void init(f32x4 (&acc)[2][2][4][2], const Unit&, int, int, int, int) const { zero_acc(acc); }
    DI void operator()(const f32x4 (&acc)[2][2][4][2], const Unit& u, int ui, int wr, int wc, int fr_, int fq_, LAS unsigned char* scr) const {
        int l_ = fr_ + 16 * fq_; asm volatile("" : "+v"(l_)); const int fr = l_ & 15, fq = l_ >> 4;
        const int row0 = u.pm * BM + wr * 64 + fr, col0 = u.pn * BM + wc * 32 + 8 * fq;
        const int kind = (u.pn < 4) ? 1 : ((u.pn == 6 || u.pn == 7) ? 2 : 0);
        const bool second = (fq & 1) != 0;
        const bool active = (kind == 2) || (kind == 1 && (wc & 1) == 0 && fq < 2);
        const int b16 = 2 * (wc & 1) + (fq >> 1);
        float rs[2][4];
        load_rstd(rs, scr, ui, wr, fr);
        float irev[8];
        { const float l2t = (kind == 1) ? 18.931568569324174f   : 13.287712379549449f  ; const float inv_half = (kind == 1) ? 0.125f : 0.03125f; const int c0 = (kind == 1) ? 0 : 8 * b16;
#pragma unroll
          for (int i = 0; i < 8; ++i) irev[i] = fast_exp2(-l2t * (float)(c0 + i) * inv_half) * 0.15915494309189535f; }
#pragma unroll
        for (int g2 = 0; g2 < 8; ++g2) {
            const int ai = g2 >> 2, m = g2 & 3; const int row = row0 + ai * HALF + m * 16; const float r = rs[ai][m];
            f32x4 c0 = {0.f, 0.f, 0.f, 0.f}, c1 = c0, s0 = c0, s1 = c0;
            if (active) { const float tf = (float)(row & (SEQ - 1));
#pragma unroll
                for (int i = 0; i < 4; ++i) { const float ra = __builtin_amdgcn_fractf(tf * irev[i]), rb = __builtin_amdgcn_fractf(tf * irev[4 + i]);
                    c0[i] = __builtin_amdgcn_cosf(ra); s0[i] = __builtin_amdgcn_sinf(ra); c1[i] = __builtin_amdgcn_cosf(rb); s1[i] = __builtin_amdgcn_sinf(rb); } }
#pragma unroll
                for (int bj = 0; bj < 2; ++bj) { f32x4 v0 = acc[ai][bj][m][0] * r, v1 = acc[ai][bj][m][1] * r;
                    if (kind != 0) { f32x4 p0, p1;
#pragma unroll
                        for (int i = 0; i < 4; ++i) {
                            const auto x0 = __builtin_amdgcn_permlane16_swap(__float_as_uint(v0[i]), __float_as_uint(v0[i]), false, false);
                            const auto x1 = __builtin_amdgcn_permlane16_swap(__float_as_uint(v1[i]), __float_as_uint(v1[i]), false, false);
                            p0[i] = __uint_as_float(second ? x0[0] : x0[1]); p1[i] = __uint_as_float(second ? x1[0] : x1[1]); }
                        const f32x4 r0 = second ? (p0 * s0 + v0 * c0) : (v0 * c0 - p0 * s0);
                        const f32x4 r1 = second ? (p1 * s1 + v1 * c1) : (v1 * c1 - p1 * s1);
                        if (active) { v0 = r0; v1 = r1; } }
                    { const int ct = bj * HALF + wc * 32 + 8 * fq, b = row / SEQ, t = row & (SEQ - 1); size_t off;
                      if (u.pn < 6) { const int cs = (u.pn & 1) * 256 + ct; off = hm_off(512 * (u.pn >> 1), 8, 64, b, cs >> 6, t) + (cs & 63); }
                      else if (u.pn < 8) off = hm_off(1536 + 256 * (u.pn - 6), 4, 64, b, ct >> 6, t) + (ct & 63);
                      else { const int cs = (u.pn & 1) * 256 + ct; off = hm_off(2048 + 512 * ((u.pn - 8) >> 1), 4, 128, b, cs >> 7, t) + (cs & 127); }
                      *(u32x4*)(O + off) = pack8(v0, v1); } }
        }
    }
};
}

constexpr size_t MiB = 1u << 20;
constexpr size_t al(size_t x) { return (x + 255) & ~(size_t)255; }
constexpr size_t WS_CTL = 0, CTL_ZERO_BYTES = 32768;
constexpr size_t WS_W1IN = 1 * MiB;
constexpr size_t WS_W1OUT = WS_W1IN + (size_t)2 * DFF * D * 2;
constexpr size_t WS_WIN = WS_W1OUT + (size_t)D * DFF * 2;
constexpr size_t WS_WOUT = WS_WIN + (size_t)INC * D * 2;
constexpr size_t WS_WCQ = WS_WOUT + (size_t)D * D * 2;
constexpr size_t WS_WCKV = WS_WCQ + (size_t)D * D * 2;
constexpr size_t WS_WCO = WS_WCKV + (size_t)2 * D * D * 2;
constexpr size_t WS_W2IN = WS_WCO + (size_t)D * D * 2;
constexpr size_t WS_W2OUT = WS_W2IN + (size_t)2 * DFF * D * 2;
constexpr size_t WS_TAB = WS_W2OUT + (size_t)D * DFF * 2;
constexpr size_t WS_COSA = WS_TAB, WS_SINA = WS_COSA + (size_t)SEQ * 8 * 4, WS_COSR = WS_SINA + (size_t)SEQ * 8 * 4, WS_SINR = WS_COSR + (size_t)SEQ * 32 * 4;
constexpr size_t WS_MEMN = WS_SINR + (size_t)SEQ * 32 * 4;
constexpr size_t WS_KC = WS_MEMN + (size_t)MROWS * D * 2;
constexpr size_t WS_VT = WS_KC + (size_t)MROWS * D * 2;
constexpr size_t WS_SSQ = WS_VT + (size_t)MROWS * D * 2;
constexpr size_t WS_XB = al(WS_SSQ + (size_t)M * 16 * 4);
constexpr size_t WS_BIG = WS_XB + (size_t)M * D * 2;
constexpr size_t WS_OMIX = WS_BIG + (size_t)M * INC * 2;
constexpr size_t WS_ATT = WS_OMIX + (size_t)M * D * 2;
constexpr size_t WS_ATT_BYTES = (size_t)M * 512 * 2 * 3 + (size_t)M * 8 * 4 * 3;
constexpr size_t WS_RET = WS_ATT + WS_ATT_BYTES;
constexpr size_t WS_XRES = WS_RET + (size_t)NBATCH * 64 * 4 * 64 * 128 * 4;
constexpr size_t WS_OPT_END = WS_XRES;

constexpr int RING_OFF = 0, RING_BYTES = 131072;
constexpr int LDSCTL_OFF = 163840 - 256, MISC_OFF = LDSCTL_OFF;
constexpr int LDS_BYTES = 163840;
constexpr int NWAVES = 8;

#define XB_TMO      128
#define XB_XCNT(j)  (256  + 64 * (j))
#define XB_XSUB(j)  (1280 + 64 * (j))
#define XB_XGEN(j)  (2304 + 64 * (j))
#define XB_TOP      3328
#define XB_TOPGEN   3392
#define XCD_BAR_WORDS 3456
#define XB_SPIN_CAP (1u << 18)
DI unsigned xb_ld(unsigned* p)              { return __hip_atomic_load(p, __ATOMIC_RELAXED, __HIP_MEMORY_SCOPE_AGENT); }
DI unsigned xb_add(unsigned* p, unsigned v) { return __hip_atomic_fetch_add(p, v, __ATOMIC_RELAXED, __HIP_MEMORY_SCOPE_AGENT); }
DI unsigned xb_xcc_id() { return (unsigned)__builtin_amdgcn_s_getreg((3 << 11) | 20) & 0xFu; }
#define XB_SPIN(cond, bar) do { unsigned _sp = 0; while (cond) { __builtin_amdgcn_s_sleep(1); \
    if ((++_sp & 255u) == 0u) { if (xb_ld(&(bar)[XB_TMO])) break; if (_sp > XB_SPIN_CAP) { atomicAdd(&(bar)[XB_TMO], 1u); break; } } } } while (0)
struct XcdBarrier { unsigned* bar; unsigned x; volatile LAS unsigned* st; };
DI XcdBarrier xcd_barrier_post(unsigned* bar, volatile LAS unsigned* st) {
    XcdBarrier b; b.bar = bar; b.x = xb_xcc_id(); b.st = st;
    if (threadIdx.x == 0) (void)xb_add(&bar[XB_XCNT(b.x)], 1u);
    return b;
}
DI void xcd_barrier_complete(unsigned* bar, unsigned x, unsigned& nloc, unsigned& nx) {
    const unsigned G = gridDim.x * gridDim.y * gridDim.z;
    unsigned sum, cnt, mine, sp = 0u;
    for (;;) {
        sum = 0u; cnt = 0u; mine = 0u;
#pragma unroll
        for (unsigned j = 0; j < 16; ++j) { const unsigned c = xb_ld(&bar[XB_XCNT(j)]); sum += c; cnt += (c > 0u) ? 1u : 0u; mine = (j == x) ? c : mine; }
        if (sum == G) break;
        __builtin_amdgcn_s_sleep(1);
        if ((++sp & 255u) == 0u) { if (xb_ld(&bar[XB_TMO])) break; if (sp > XB_SPIN_CAP) { atomicAdd(&bar[XB_TMO], 1u); break; } }
    }
    nloc = mine > 0u ? mine : 1u; nx = cnt > 0u ? cnt : 1u;
}
DI void xcd_barrier(const XcdBarrier& b) {
    asm volatile("s_waitcnt vmcnt(0)" ::: "memory");
    __syncthreads();
    if (threadIdx.x == 0) {
        unsigned* bar = b.bar;
        __builtin_amdgcn_s_waitcnt(0);
        unsigned nloc = b.st[0], nx = b.st[1];
        if (nloc == 0u) { xcd_barrier_complete(bar, b.x, nloc, nx); b.st[0] = nloc; b.st[1] = nx; }
        const unsigned old = xb_add(&bar[XB_XSUB(b.x)], 1u);
        const unsigned gen = old / nloc;
        if (old + 1u == (gen + 1u) * nloc) {
            __builtin_amdgcn_fence(__ATOMIC_RELEASE, "agent");
            asm volatile("s_waitcnt vmcnt(0)" ::: "memory");
            const unsigned og = xb_add(&bar[XB_TOP], 1u);
            const unsigned tg = og / nx;
            if (og + 1u == (tg + 1u) * nx) xb_add(&bar[XB_TOPGEN], 1u);
            else XB_SPIN(xb_ld(&bar[XB_TOPGEN]) == tg, bar);
            __builtin_amdgcn_fence(__ATOMIC_ACQUIRE, "agent");
            xb_add(&bar[XB_XGEN(b.x)], 1u);
            asm volatile("s_waitcnt vmcnt(0)" ::: "memory");
        } else {
            XB_SPIN(xb_ld(&bar[XB_XGEN(b.x)]) == gen, bar);
            __builtin_amdgcn_fence(__ATOMIC_ACQUIRE, "agent");
            asm volatile("s_waitcnt vmcnt(0)" ::: "memory");
        }
    }
    __syncthreads();
}
constexpr int CW_BAR = 4096;

struct Args {
    const float* in[17]; float* out; unsigned char* ws; float* xres;
    int ph_lo, ph_hi;
};

DI float wave_sum(float v) {
#pragma unroll
    for (int o = 1; o < 64; o <<= 1) v += __shfl_xor(v, o);
    return v;
}
DI float wave_max(float v) {
#pragma unroll
    for (int o = 1; o < 64; o <<= 1) v = fmaxf(v, __shfl_xor(v, o));
    return v;
}

DI int wmap_row(int mat, int n) {
    if (mat == 0 || mat == 7) { const int u = n >= DFF, j = u ? n - DFF : n; return 256 * (j >> 7) + 128 * u + (j & 127); }
    if (mat == 2 && n >= 1536 && n < 2048) { const int c = n & 63, x2 = c >> 5, cc = c & 31; return (n - c) + 16 * (cc >> 3) + 8 * x2 + (cc & 7); }
    return n;
}
DI float wmap_scale(int mat, int n) {
    if (mat == 2) return (n < 512) ? 0.125f * LOG2E : ((n >= 1792 && n < 2048) ? 0.125f : 1.0f);
    if (mat == 4) return 0.0625f * LOG2E;
    if (mat == 1 || mat == 8) return 0.5f;
    return 1.0f;
}
DI void p0_transpose_item(const float* W, int K, int N, bf16_t* WT, int mat, const float* nw, LAS float* scr, int item, int lane) {
    const int nblk = N / 32, kb = item / nblk, nb = item % nblk, k0 = 64 * kb, n0 = 32 * nb;
    float wv[32];
#pragma unroll
    for (int i = 0; i < 32; ++i) wv[i] = W[(size_t)(k0 + 2 * i + (lane >> 5)) * N + n0 + (lane & 31)];
    const float s0 = nw ? nw[k0 + (lane & 31) * 2 + 0] : 1.0f, s1 = nw ? nw[k0 + (lane & 31) * 2 + 1] : 1.0f;
#pragma unroll
    for (int i = 0; i < 32; ++i) { const float sl = __shfl(s0, i), sh = __shfl(s1, i); const int kk = 2 * i + (lane >> 5); scr[kk * 33 + (lane & 31)] = wv[i] * ((lane >> 5) ? sh : sl); }
    asm volatile("s_waitcnt lgkmcnt(0)" ::: "memory");
    const int c = lane & 7;
#pragma unroll
    for (int j = 0; j < 4; ++j) { const int n = (lane >> 3) + 8 * j; const LAS float* s = scr + (8 * c) * 33 + n; const float sc = wmap_scale(mat, n0 + n);
        u32x4 o; o.x = cvt_pk_bf16(s[0 * 33] * sc, s[1 * 33] * sc); o.y = cvt_pk_bf16(s[2 * 33] * sc, s[3 * 33] * sc); o.z = cvt_pk_bf16(s[4 * 33] * sc, s[5 * 33] * sc); o.w = cvt_pk_bf16(s[6 * 33] * sc, s[7 * 33] * sc);
        *(u32x4*)(WT + (size_t)wmap_row(mat, n0 + n) * K + k0 + 8 * c) = o; }
    asm volatile("s_waitcnt lgkmcnt(0)" ::: "memory");
}
DI void rms_row_to_bf16(const float* xrow, const float* w, bf16_t* orow, int lane) {
    const f32x4* xr = (const f32x4*)xrow + lane;
    f32x4 v[4]; float s = 0.f;
#pragma unroll
    for (int j = 0; j < 4; ++j) { v[j] = xr[64 * j]; s += (v[j][0] * v[j][0] + v[j][1] * v[j][1]) + (v[j][2] * v[j][2] + v[j][3] * v[j][3]); }
    const float r = rsqrtf(wave_sum(s) * (1.f / D) + EPS);
    u32x2* o8 = (u32x2*)orow + lane;
#pragma unroll
    for (int j = 0; j < 4; ++j) { const f32x4 ww = ((const f32x4*)w)[lane + 64 * j]; u32x2 o; o.x = cvt_pk_bf16(v[j][0] * r * ww[0], v[j][1] * r * ww[1]); o.y = cvt_pk_bf16(v[j][2] * r * ww[2], v[j][3] * r * ww[3]); o8[64 * j] = o; }
}

DI void rms_row2_to_bf16(const float* xa, const float* xb, const float* w, bf16_t* oa, bf16_t* ob, int lane) {
    const f32x4* ra = (const f32x4*)xa + lane; const f32x4* rb = (const f32x4*)(xb ? xb : xa) + lane;
    f32x4 va[4], vb[4]; float sa = 0.f, sb = 0.f;
#pragma unroll
    for (int j = 0; j < 4; ++j) { va[j] = ra[64 * j]; vb[j] = rb[64 * j]; }
#pragma unroll
    for (int j = 0; j < 4; ++j) { sa += (va[j][0] * va[j][0] + va[j][1] * va[j][1]) + (va[j][2] * va[j][2] + va[j][3] * va[j][3]); sb += (vb[j][0] * vb[j][0] + vb[j][1] * vb[j][1]) + (vb[j][2] * vb[j][2] + vb[j][3] * vb[j][3]); }
    const float r0 = rsqrtf(wave_sum(sa) * (1.f / D) + EPS), r1 = rsqrtf(wave_sum(sb) * (1.f / D) + EPS);
    u32x2* pa = (u32x2*)oa + lane; u32x2* pb = (u32x2*)ob + lane;
#pragma unroll
    for (int j = 0; j < 4; ++j) { const f32x4 ww = ((const f32x4*)w)[lane + 64 * j];
        u32x2 o; o.x = cvt_pk_bf16(va[j][0] * r0 * ww[0], va[j][1] * r0 * ww[1]); o.y = cvt_pk_bf16(va[j][2] * r0 * ww[2], va[j][3] * r0 * ww[3]); pa[64 * j] = o;
        if (xb) { u32x2 p; p.x = cvt_pk_bf16(vb[j][0] * r1 * ww[0], vb[j][1] * r1 * ww[1]); p.y = cvt_pk_bf16(vb[j][2] * r1 * ww[2], vb[j][3] * r1 * ww[3]); pb[64 * j] = p; } }
}

namespace da {
typedef float f32x16 __attribute__((ext_vector_type(16)));
typedef short s16x4 __attribute__((ext_vector_type(4)));
typedef __bf16 bf16x2_t __attribute__((ext_vector_type(2)));
constexpr int K_OFF = 0, V_OFF = 49152, V_D0 = 24640, OST_OFF = V_OFF + V_D0 + 24576;
static_assert(OST_OFF + 8 * 4096 <= MISC_OFF, "attention LDS map");
DI int crow(int r, int hi) { return (r & 3) + 8 * (r >> 2) + 4 * hi; }
DI unsigned cvtpk(float lo, float hi) { f32x2 v = {lo, hi}; bf16x2_t b = __builtin_convertvector(v, bf16x2_t); return __builtin_bit_cast(unsigned, b); }
DI s16x4 vtr(LAS unsigned char* p) { return __builtin_bit_cast(s16x4, __builtin_amdgcn_ds_read_tr16_b64_v4i16((LAS s16x4*)p)); }
struct Dec { int b, h, g, d, r, blk; };
DI Dec decode(int uid) { Dec u; const int u32i = uid & 31, ghb = uid >> 5; u.g = ghb % 3; const int bh = ghb / 3; u.h = bh & 7; u.b = bh >> 3;
    u.d = (u.g == 0) ? 1 : ((u.g == 1) ? 4 : 16); const int nblk = 32 / u.d; u.blk = u32i % nblk; u.r = u32i / nblk; return u; }
struct Regs { u32x4 k[6], v[6], q[4]; };
DI void load_regs(Regs& R, const Dec& u, const bf16_t* proj, int tid) {
    const int lane = tid & 63, w = tid >> 6;
#pragma unroll
    for (int i = 0; i < 6; ++i) { const int id = tid + 512 * i, uk = id >> 3, c = id & 7; int sk = 256 * u.blk - 128 + uk; sk = sk < 0 ? 0 : sk;
        const size_t ro = hm_off(0, 8, 64, u.b, u.h, sk * u.d + u.r) + 8 * c;
        R.k[i] = *(const u32x4*)(proj + (size_t)M * 512 + ro); R.v[i] = *(const u32x4*)(proj + (size_t)M * 1024 + ro); }
    const int s = 256 * u.blk + 32 * w + (lane & 31);
    const bf16_t* qp = proj + hm_off(0, 8, 64, u.b, u.h, s * u.d + u.r) + 8 * (lane >> 5);
#pragma unroll
    for (int ks = 0; ks < 4; ++ks) R.q[ks] = *(const u32x4*)(qp + 16 * ks);
}
DI void write_lds(const Regs& R, const Dec& u, LAS unsigned char* lds, int tid) {
#pragma unroll
    for (int i = 0; i < 6; ++i) { const int id = tid + 512 * i, uk = id >> 3, c = id & 7; const bool valid = (u.blk > 0) || (uk >= 128);
        const u32x4 z = {0u, 0u, 0u, 0u};
        *(LAS u32x4*)(lds + K_OFF + 128 * uk + 16 * (c ^ ((uk >> 1) & 7))) = valid ? R.k[i] : z;
        *(LAS u32x4*)(lds + V_OFF + (c >> 2) * V_D0 + 64 * uk + 16 * (c & 3)) = valid ? R.v[i] : z; }
}
DI void qk_part(f32x16 (&S)[5], const Regs& R, LAS unsigned char* lds, int tid) {
    const int lane = tid & 63, w = __builtin_amdgcn_readfirstlane(tid >> 6), q = lane & 31, hi = lane >> 5;
#pragma unroll
    for (int j = 0; j < 5; ++j) {
        const int uk = 32 * (w + j) + q;
        f32x16 acc;
#pragma unroll
        for (int r = 0; r < 16; ++r) acc[r] = 0.f;
#pragma unroll
        for (int ks = 0; ks < 4; ++ks) { const bf16x8 kf = *(const LAS bf16x8*)(lds + K_OFF + 128 * uk + 16 * ((2 * ks + hi) ^ ((uk >> 1) & 7)));
            acc = __builtin_amdgcn_mfma_f32_32x32x16_bf16(kf, __builtin_bit_cast(bf16x8, R.q[ks]), acc, 0, 0, 0); }
        S[j] = acc;
    }
}
DI void softmax_part(f32x16 (&S)[5], u32x4 (&Pk)[5][2], float& m_out, float& l_out, const Dec& u, int tid) {
    const int lane = tid & 63, w = __builtin_amdgcn_readfirstlane(tid >> 6), q = lane & 31, hi = lane >> 5;
    float m = -1e30f;
#pragma unroll
    for (int r = 0; r < 16; ++r) { const int kk = crow(r, hi); if (kk < q) S[0][r] = -1e30f; if (kk > q) S[4][r] = -1e30f; }
    if (u.blk == 0) {
#pragma unroll
        for (int j = 0; j < 4; ++j) if (w + j < 4) {
#pragma unroll
            for (int r = 0; r < 16; ++r) S[j][r] = -1e30f; }
    }
#pragma unroll
    for (int j = 0; j < 5; ++j)
#pragma unroll
        for (int r = 0; r < 16; ++r) m = fmaxf(m, S[j][r]);
    m = fmaxf(m, __shfl_xor(m, 32));
    float l = 0.f;
#pragma unroll
    for (int j = 0; j < 5; ++j) {
#pragma unroll
        for (int r = 0; r < 16; ++r) { const float p = fast_exp2(S[j][r] - m); S[j][r] = p; l += p; }
#pragma unroll
        for (int s2 = 0; s2 < 2; ++s2) { u32x4 pw; pw.x = cvtpk(S[j][8 * s2 + 0], S[j][8 * s2 + 1]); pw.y = cvtpk(S[j][8 * s2 + 2], S[j][8 * s2 + 3]); pw.z = cvtpk(S[j][8 * s2 + 4], S[j][8 * s2 + 5]); pw.w = cvtpk(S[j][8 * s2 + 6], S[j][8 * s2 + 7]); Pk[j][s2] = pw; }
    }
    l += __shfl_xor(l, 32);
    m_out = m; l_out = l;
}
DI void pv_part(const u32x4 (&Pk)[5][2], float m, float l, const Dec& u, LAS unsigned char* lds, bf16_t* part, float* lsep, int tid) {
    const int lane = tid & 63, w = __builtin_amdgcn_readfirstlane(tid >> 6), q = lane & 31, hi = lane >> 5;
    f32x16 o[2];
#pragma unroll
    for (int r = 0; r < 16; ++r) { o[0][r] = 0.f; o[1][r] = 0.f; }
    const int vlane = ((lane >> 4) & 1) * 32 + (lane & 3) * 8 + (4 * hi + ((lane & 15) >> 2)) * 64;
#pragma unroll
    for (int j = 0; j < 5; ++j)
#pragma unroll
        for (int s2 = 0; s2 < 2; ++s2) {
            const bf16x8 pa = __builtin_bit_cast(bf16x8, Pk[j][s2]);
#pragma unroll
            for (int d0 = 0; d0 < 2; ++d0) { LAS unsigned char* vp = lds + V_OFF + d0 * V_D0 + (32 * (w + j) + 16 * s2) * 64 + vlane;
                const s16x4 lo = vtr(vp), hi4 = vtr(vp + 512);
                const bf16x8 vf = {lo[0], lo[1], lo[2], lo[3], hi4[0], hi4[1], hi4[2], hi4[3]};
                o[d0] = __builtin_amdgcn_mfma_f32_32x32x16_bf16(pa, vf, o[d0], 0, 0, 0); }
        }
    const float linv = fast_rcp(l);
    LAS bf16_t* stg = (LAS bf16_t*)(lds + OST_OFF + w * 4096);
#pragma unroll
    for (int r = 0; r < 16; ++r) { const int orow = crow(r, hi); const float li = __shfl(linv, orow);
#pragma unroll
        for (int d0 = 0; d0 < 2; ++d0) stg[orow * 64 + d0 * 32 + q] = (bf16_t)(cvtpk(o[d0][r] * li, 0.f) & 0xffffu); }
    asm volatile("s_waitcnt lgkmcnt(0)" ::: "memory");
    const int s0 = 256 * u.blk + 32 * w;
#pragma unroll
    for (int i = 0; i < 4; ++i) { const int row = i * 8 + (lane >> 3), ch = lane & 7; const u32x4 v = *(const LAS u32x4*)(stg + row * 64 + ch * 8);
        *(u32x4*)(part + (size_t)(u.b * SEQ + (s0 + row) * u.d + u.r) * 512 + u.h * 64 + ch * 8) = v; }
    if (hi == 0) lsep[(size_t)(u.b * SEQ + (s0 + q) * u.d + u.r) * 8 + u.h] = m + __log2f(l);
}
struct UnitMap { int x, j, GX, NP, per, n, nk;
    DI void init(int x_, int j_, int GX_, int npairs, int nk_) { x = x_; j = j_; GX = GX_; NP = npairs; nk = (nk_ > 0 && GX_ == 32 && nk_ == 8) ? nk_ : 0; per = nk ? 4 : (96 + GX - 1) / GX; n = NP * per; }
    DI int uid(int i) const { const int p = i / per, s = i % per; int k;
        if (nk) { if (s < 3) k = (p == 0 && j < nk) ? 96 : 3 * j + s; else k = (p == 0 && j >= nk) ? j - nk : 96; }
        else k = j * per + s;
        return (k < 96) ? (x * NP + p) * 96 + k : -1; } };
DI void phase(LAS unsigned char* lds, const bf16_t* proj, bf16_t* attp, float* lse, const UnitMap& U) {
    int i = 0; while (i < U.n && U.uid(i) < 0) ++i;
    if (i >= U.n) return;
    Regs R; Dec cur = decode(U.uid(i));
    load_regs(R, cur, proj, otid());
    while (i < U.n) {
        int in = i + 1; while (in < U.n && U.uid(in) < 0) ++in;
        write_lds(R, cur, lds, otid());
        Regs Qc;
#pragma unroll
        for (int k = 0; k < 4; ++k) Qc.q[k] = R.q[k];
        __syncthreads();
        Dec nxt = cur;
        if (in < U.n) { nxt = decode(U.uid(in)); load_regs(R, nxt, proj, otid()); }
        u32x4 Pk[5][2]; float m, l;
        {   f32x16 S[5];
            qk_part(S, Qc, lds, otid());
            softmax_part(S, Pk, m, l, cur, otid()); }
        pv_part(Pk, m, l, cur, lds, attp + (size_t)cur.g * M * 512, lse + (size_t)cur.g * M * 8, otid());
        __syncthreads();
        cur = nxt; i = in;
    }
}
DI void merge(const bf16_t* attp, const float* lse, bf16_t* omix, int gtid, int ngt) {
    for (int i = gtid; i < M * 64; i += ngt) {
        const int row = i >> 6, h = (i >> 3) & 7, c = i & 7;
        const float l0 = lse[(size_t)row * 8 + h], l1 = lse[(size_t)M * 8 + (size_t)row * 8 + h], l2 = lse[(size_t)2 * M * 8 + (size_t)row * 8 + h];
        const float mm = fmaxf(fmaxf(l0, l1), l2);
        float w0 = fast_exp2(l0 - mm), w1 = fast_exp2(l1 - mm), w2 = fast_exp2(l2 - mm);
        const float inv = fast_rcp(w0 + w1 + w2); w0 *= inv; w1 *= inv; w2 *= inv;
        const size_t off = (size_t)row * 512 + h * 64 + c * 8;
        const u32x4 a = *(const u32x4*)(attp + off), b = *(const u32x4*)(attp + (size_t)M * 512 + off), cc = *(const u32x4*)(attp + (size_t)2 * M * 512 + off);
        u32x4 o;
#pragma unroll
        for (int k = 0; k < 4; ++k) { const float lo = w0 * bf2f(a[k] & 0xffffu) + w1 * bf2f(b[k] & 0xffffu) + w2 * bf2f(cc[k] & 0xffffu);
            const float hi = w0 * bf2f(a[k] >> 16) + w1 * bf2f(b[k] >> 16) + w2 * bf2f(cc[k] >> 16); o[k] = cvt_pk_bf16(lo, hi); }
        *(u32x4*)(omix + (size_t)row * D + h * 64 + c * 8) = o;
    }
}
}


namespace xa {
using da::f32x16; using da::s16x4; using da::crow; using da::cvtpk; using da::vtr;
constexpr int KB = 0, VB = 65536, VB_STRIDE = 32832, V_D0 = 16384 + 64, OST = 32768;
static_assert(VB + 2 * VB_STRIDE <= MISC_OFF, "cross-attention LDS map");
struct St { u32x4 sr[2][4]; u32x4 q[4]; };
DI void dec(int uid, int& b, int& h, int& qblk) { qblk = uid & 31; h = (uid >> 5) & 3; b = uid >> 7; }
DI const bf16_t* q_ptr(int i, int u_lo, const bf16_t* qc, int tid) { int b, h, qblk; dec(u_lo + (i >> 3), b, h, qblk); const int lane = tid & 63, w = tid >> 6;
    return qc + (size_t)(b * SEQ + 256 * qblk + 32 * w + (lane & 31)) * D + h * 256 + 64 * (i & 7) + 8 * (lane >> 5); }
template <int PAR> DI void stage_load(St& T, int i, int total, int u_lo, const bf16_t* kvc, int tid) {
    if (i >= total) return;
    const int st = i & 7; int b, h, qblk; dec(u_lo + (i >> 3), b, h, qblk);
    const int coff = (st < 4) ? (h * 256 + 64 * st) : (1024 + h * 256 + 64 * (st - 4));
#pragma unroll
    for (int k = 0; k < 4; ++k) { const int id = tid + 512 * k, m = id >> 3, ch = id & 7; T.sr[PAR][k] = *(const u32x4*)(kvc + (size_t)(b * MEMLEN + m) * 2048 + coff + 8 * ch); }
}
template <int PAR> DI void stage_write(const St& T, int i, int total, LAS unsigned char* lds, int tid) {
    if (i >= total) return;
    const int st = i & 7;
    if (st < 4) {
#pragma unroll
        for (int k = 0; k < 4; ++k) { const int id = tid + 512 * k, m = id >> 3, ch = id & 7; *(LAS u32x4*)(lds + KB + (st & 1) * 32768 + 128 * m + 16 * (ch ^ ((m >> 1) & 7))) = T.sr[PAR][k]; }
    } else {
#pragma unroll
        for (int k = 0; k < 4; ++k) { const int id = tid + 512 * k, m = id >> 3, ch = id & 7; *(LAS u32x4*)(lds + VB + (st & 1) * VB_STRIDE + (ch >> 2) * V_D0 + 64 * m + 16 * (ch & 3)) = T.sr[PAR][k]; }
    }
}
template <int st> DI void k_stage(St& T, f32x16 (&S)[8], int i, int u_lo, LAS unsigned char* lds, const bf16_t* qc, int tid) {
    const int lane = tid & 63, q = lane & 31, hi = lane >> 5;
    LAS unsigned char* kb = lds + KB + (st & 1) * 32768;
    const bf16_t* qn = q_ptr(i + 1, u_lo, qc, tid);
#pragma unroll
    for (int ks = 0; ks < 4; ++ks) { const bf16x8 qf = __builtin_bit_cast(bf16x8, T.q[ks]);
#pragma unroll
        for (int kt = 0; kt < 8; ++kt) { const int uk = 32 * kt + q;
            const bf16x8 kf = *(const LAS bf16x8*)(kb + 128 * uk + 16 * ((2 * ks + hi) ^ ((uk >> 1) & 7)));
            S[kt] = __builtin_amdgcn_mfma_f32_32x32x16_bf16(kf, qf, S[kt], 0, 0, 0); }
        if (st < 3) T.q[ks] = *(const u32x4*)(qn + 16 * ks); }
}
DI void softmax(f32x16 (&S)[8], u32x4 (&Pk)[8][2], float& linv) {
    float m = -1e30f;
#pragma unroll
    for (int kt = 0; kt < 8; ++kt)
#pragma unroll
        for (int r = 0; r < 16; ++r) m = fmaxf(m, S[kt][r]);
    m = fmaxf(m, __shfl_xor(m, 32));
    float l = 0.f;
#pragma unroll
    for (int kt = 0; kt < 8; ++kt) {
#pragma unroll
        for (int r = 0; r < 16; ++r) { const float p = fast_exp2(S[kt][r] - m); S[kt][r] = p; l += p; }
#pragma unroll
        for (int s2 = 0; s2 < 2; ++s2) { u32x4 pw; pw.x = cvtpk(S[kt][8 * s2 + 0], S[kt][8 * s2 + 1]); pw.y = cvtpk(S[kt][8 * s2 + 2], S[kt][8 * s2 + 3]); pw.z = cvtpk(S[kt][8 * s2 + 4], S[kt][8 * s2 + 5]); pw.w = cvtpk(S[kt][8 * s2 + 6], S[kt][8 * s2 + 7]); Pk[kt][s2] = pw; }
    }
    l += __shfl_xor(l, 32);
    linv = fast_rcp(l);
}
template <int st> DI void v_stage(St& T, const u32x4 (&Pk)[8][2], float linv, int i, int total, int u_lo, LAS unsigned char* lds, const bf16_t* qc, bf16_t* oc, int tid) {
    const int lane = tid & 63, w = __builtin_amdgcn_readfirstlane(tid >> 6), q = lane & 31, hi = lane >> 5;
    const int vc = st - 4; int b, h, qblk; dec(u_lo + (i >> 3), b, h, qblk);
    if (st == 7 && i + 1 < total) { const bf16_t* qn = q_ptr(i + 1, u_lo, qc, tid);
#pragma unroll
        for (int ks = 0; ks < 4; ++ks) T.q[ks] = *(const u32x4*)(qn + 16 * ks); }
    LAS unsigned char* vb = lds + VB + (st & 1) * VB_STRIDE;
    const int vlane = ((lane >> 4) & 1) * 32 + (lane & 3) * 8 + (4 * hi + ((lane & 15) >> 2)) * 64;
    f32x16 o[2];
#pragma unroll
    for (int r = 0; r < 16; ++r) { o[0][r] = 0.f; o[1][r] = 0.f; }
#pragma unroll
    for (int kt = 0; kt < 8; ++kt)
#pragma unroll
        for (int s2 = 0; s2 < 2; ++s2) { const bf16x8 pa = __builtin_bit_cast(bf16x8, Pk[kt][s2]);
#pragma unroll
            for (int d0 = 0; d0 < 2; ++d0) { LAS unsigned char* vp = vb + d0 * V_D0 + (32 * kt + 16 * s2) * 64 + vlane;
                const s16x4 lo = vtr(vp), hi4 = vtr(vp + 512);
                const bf16x8 vf = {lo[0], lo[1], lo[2], lo[3], hi4[0], hi4[1], hi4[2], hi4[3]};
                o[d0] = __builtin_amdgcn_mfma_f32_32x32x16_bf16(pa, vf, o[d0], 0, 0, 0); } }
    LAS bf16_t* stg = (LAS bf16_t*)(lds + OST + w * 4096);
#pragma unroll
    for (int r = 0; r < 16; ++r) { const int orow = crow(r, hi); const float li = __shfl(linv, orow);
#pragma unroll
        for (int d0 = 0; d0 < 2; ++d0) stg[orow * 64 + d0 * 32 + q] = (bf16_t)(cvtpk(o[d0][r] * li, 0.f) & 0xffffu); }
    asm volatile("s_waitcnt lgkmcnt(0)" ::: "memory");
#pragma unroll
    for (int k = 0; k < 4; ++k) { const int row = k * 8 + (lane >> 3), ch = lane & 7; const u32x4 v = *(const LAS u32x4*)(stg + row * 64 + ch * 8);
        *(u32x4*)(oc + (size_t)(b * SEQ + 256 * qblk + 32 * w + row) * D + h * 256 + 64 * vc + ch * 8) = v; }
}
DI void phase(LAS unsigned char* lds, const bf16_t* qc, const bf16_t* kvc, bf16_t* oc, int u_lo, int u_hi, int) {
    if (u_lo >= u_hi) return;
    const int total = 8 * (u_hi - u_lo);
    St T;
    { const bf16_t* q0 = q_ptr(0, u_lo, qc, otid());
#pragma unroll
      for (int ks = 0; ks < 4; ++ks) T.q[ks] = *(const u32x4*)(q0 + 16 * ks); }
    stage_load<0>(T, 0, total, u_lo, kvc, otid()); stage_write<0>(T, 0, total, lds, otid()); stage_load<1>(T, 1, total, u_lo, kvc, otid()); stage_load<0>(T, 2, total, u_lo, kvc, otid());
    __syncthreads();
    for (int i0 = 0; i0 < total; i0 += 8) {
        u32x4 Pk[8][2]; float linv;
        {   f32x16 S[8];
#pragma unroll
            for (int kt = 0; kt < 8; ++kt)
#pragma unroll
                for (int r = 0; r < 16; ++r) S[kt][r] = 0.f;
#define XA_NEXT(i, P1) do { stage_write<P1>(T, (i) + 1, total, lds, otid()); stage_load<P1>(T, (i) + 3, total, u_lo, kvc, otid()); __syncthreads(); } while (0)
            k_stage<0>(T, S, i0 + 0, u_lo, lds, qc, otid()); XA_NEXT(i0 + 0, 1);
            k_stage<1>(T, S, i0 + 1, u_lo, lds, qc, otid()); XA_NEXT(i0 + 1, 0);
            k_stage<2>(T, S, i0 + 2, u_lo, lds, qc, otid()); XA_NEXT(i0 + 2, 1);
            k_stage<3>(T, S, i0 + 3, u_lo, lds, qc, otid()); XA_NEXT(i0 + 3, 0);
            softmax(S, Pk, linv);
        }
        v_stage<4>(T, Pk, linv, i0 + 4, total, u_lo, lds, qc, oc, otid()); XA_NEXT(i0 + 4, 1);
        v_stage<5>(T, Pk, linv, i0 + 5, total, u_lo, lds, qc, oc, otid()); XA_NEXT(i0 + 5, 0);
        v_stage<6>(T, Pk, linv, i0 + 6, total, u_lo, lds, qc, oc, otid()); XA_NEXT(i0 + 6, 1);
        v_stage<7>(T, Pk, linv, i0 + 7, total, u_lo, lds, qc, oc, otid()); XA_NEXT(i0 + 7, 0);
#undef XA_NEXT
    }
}
}


namespace rt {
using da::f32x16; using da::s16x4; using da::crow; using da::cvtpk; using da::vtr;
constexpr int VS = 8256, RS = 4160;
constexpr int KV_K = 0, KV_V = 2 * VS;
constexpr int O_K = 0, O_V = 16384, O_R = O_V + 4 * VS, O_END = O_R + 4 * RS, O_ST = O_END, O_LD = 132;
static_assert(O_ST + 128 * O_LD * 4 <= MISC_OFF, "retention LDS map");
DI float log2_gamma(int h) { return __log2f(1.0f - exp2f(-5.0f - (float)h)); }
DI void dec(int uid, int& b, int& h, int& n) { n = uid & 63; h = (uid >> 6) & 3; b = uid >> 8; }
DI size_t ret_off(int b, int n, int h) { return ((size_t)(b * 64 + n) * 4 + h) * 8192; }
DI bf16x8 tr_nat(LAS unsigned char* tile, int ks, int lane) { const int hi = lane >> 5;
    LAS unsigned char* p = tile + (16 * ks + 8 * hi + ((lane & 15) >> 2)) * 64 + ((lane >> 4) & 1) * 32 + (lane & 3) * 8;
    const s16x4 lo = vtr(p), h4 = vtr(p + 256); return (bf16x8){lo[0], lo[1], lo[2], lo[3], h4[0], h4[1], h4[2], h4[3]}; }
DI bf16x8 tr_perm(LAS unsigned char* tile, int rowbase, int lane) { const int hi = lane >> 5;
    LAS unsigned char* p = tile + (rowbase + 4 * hi + ((lane & 15) >> 2)) * 64 + ((lane >> 4) & 1) * 32 + (lane & 3) * 8;
    const s16x4 lo = vtr(p), h4 = vtr(p + 512); return (bf16x8){lo[0], lo[1], lo[2], lo[3], h4[0], h4[1], h4[2], h4[3]}; }
struct KvRegs { u32x4 k[2], v[4]; };
DI void kv_load(KvRegs& G, int uid, const bf16_t* proj, int tid) {
    int b, h, n; dec(uid, b, h, n);
    const bf16_t* kb = proj + hm_off(1792, 4, 64, b, h, 128 * n); const bf16_t* vb = proj + hm_off(2048, 4, 128, b, h, 128 * n);
#pragma unroll
    for (int i = 0; i < 2; ++i) G.k[i] = *(const u32x4*)(kb + 8 * (tid + 512 * i));
#pragma unroll
    for (int i = 0; i < 4; ++i) G.v[i] = *(const u32x4*)(vb + 8 * (tid + 512 * i));
}
DI void kv_phase(LAS unsigned char* lds, const bf16_t* proj, float* ret, int u_lo, int u_hi) {
    if (u_lo >= u_hi) return;
    KvRegs G; kv_load(G, u_lo, proj, otid());
    for (int uid = u_lo; uid < u_hi; ++uid) {
        const int tid = otid(), lane = tid & 63, w = __builtin_amdgcn_readfirstlane(tid >> 6);
        int b, h, n; dec(uid, b, h, n);
        const float lg = log2_gamma(h);
#pragma unroll
        for (int i = 0; i < 2; ++i) { const int id = tid + 512 * i, tok = id >> 3, ch = id & 7; const float dk = fast_exp2(lg * (float)(127 - tok)); u32x4 o;
#pragma unroll
            for (int k = 0; k < 4; ++k) o[k] = cvt_pk_bf16(bf2f(G.k[i][k] & 0xffffu) * dk, bf2f(G.k[i][k] >> 16) * dk);
            *(LAS u32x4*)(lds + KV_K + (ch >> 2) * VS + tok * 64 + (ch & 3) * 16) = o; }
#pragma unroll
        for (int i = 0; i < 4; ++i) { const int id = tid + 512 * i, tok = id >> 4, ch = id & 15; *(LAS u32x4*)(lds + KV_V + (ch >> 2) * VS + tok * 64 + (ch & 3) * 16) = G.v[i]; }
        __syncthreads();
        if (uid + 1 < u_hi) kv_load(G, uid + 1, proj, otid());
        const int dt = w >> 2, et = w & 3;
        f32x16 acc;
#pragma unroll
        for (int r = 0; r < 16; ++r) acc[r] = 0.f;
#pragma unroll
        for (int ks = 0; ks < 8; ++ks) { const bf16x8 a = tr_nat(lds + KV_K + dt * VS, ks, lane), bb = tr_nat(lds + KV_V + et * VS, ks, lane);
            acc = __builtin_amdgcn_mfma_f32_32x32x16_bf16(a, bb, acc, 0, 0, 0); }
        float* o = ret + ret_off(b, n, h) + (size_t)(32 * dt) * 128 + 32 * et + (lane & 31);
#pragma unroll
        for (int r = 0; r < 16; ++r) o[(size_t)crow(r, lane >> 5) * 128] = acc[r];
        __syncthreads();
    }
}
DI void scan(float* ret, int gtid, int ngt) {
    for (int e = gtid; e < NBATCH * 4 * 8192; e += ngt) {
        const int de = e & 8191, h = (e >> 13) & 3, b = e >> 15;
        const float cd = fast_exp2(128.0f * log2_gamma(h));
        float R = 0.f;
        for (int n0 = 0; n0 < 64; n0 += 8) { float t[8];
#pragma unroll
            for (int k = 0; k < 8; ++k) t[k] = ret[ret_off(b, n0 + k, h) + de];
#pragma unroll
            for (int k = 0; k < 8; ++k) { ret[ret_off(b, n0 + k, h) + de] = R; R = cd * R + t[k]; } }
    }
}
struct ORegs { u32x4 k[2], v[4], q[4]; f32x4 r[4]; };
DI void out_load(ORegs& G, int uid, const bf16_t* proj, const float* ret, int tid) {
    int b, h, n; dec(uid, b, h, n);
    const int lane = tid & 63, w = tid >> 6;
    const bf16_t* kb = proj + hm_off(1792, 4, 64, b, h, 128 * n); const bf16_t* vb = proj + hm_off(2048, 4, 128, b, h, 128 * n); const bf16_t* qb = proj + hm_off(1536, 4, 64, b, h, 128 * n);
#pragma unroll
    for (int i = 0; i < 2; ++i) G.k[i] = *(const u32x4*)(kb + 8 * (tid + 512 * i));
#pragma unroll
    for (int i = 0; i < 4; ++i) G.v[i] = *(const u32x4*)(vb + 8 * (tid + 512 * i));
    const float* rp = ret + ret_off(b, n, h);
#pragma unroll
    for (int i = 0; i < 4; ++i) G.r[i] = *(const f32x4*)(rp + 4 * (tid + 512 * i));
    const bf16_t* qp = qb + (size_t)(32 * (w >> 1) + (lane & 31)) * 64 + 8 * (lane >> 5);
#pragma unroll
    for (int ks = 0; ks < 4; ++ks) G.q[ks] = *(const u32x4*)(qp + 16 * ks);
}
DI void out_write(const ORegs& G, int uid, LAS unsigned char* lds, int tid) {
    const int h = (uid >> 6) & 3; const float gam = 1.0f - exp2f(-5.0f - (float)h);
#pragma unroll
    for (int i = 0; i < 2; ++i) { const int id = tid + 512 * i, tok = id >> 3, ch = id & 7; *(LAS u32x4*)(lds + O_K + 128 * tok + 16 * (ch ^ ((tok >> 1) & 7))) = G.k[i]; }
#pragma unroll
    for (int i = 0; i < 4; ++i) { const int id = tid + 512 * i, tok = id >> 4, ch = id & 15; *(LAS u32x4*)(lds + O_V + (ch >> 2) * VS + tok * 64 + (ch & 3) * 16) = G.v[i]; }
#pragma unroll
    for (int i = 0; i < 4; ++i) { const int id = tid + 512 * i, d = id >> 5, e = 4 * (id & 31); u32x2 o; o.x = cvt_pk_bf16(G.r[i][0] * gam, G.r[i][1] * gam); o.y = cvt_pk_bf16(G.r[i][2] * gam, G.r[i][3] * gam);
        *(LAS u32x2*)(lds + O_R + (e >> 5) * RS + d * 64 + (e & 31) * 2) = o; }
}
DI void out_phase(LAS unsigned char* lds, const bf16_t* proj, const float* ret, bf16_t* omix, int u_lo, int u_hi, int) {
    if (u_lo >= u_hi) return;
    ORegs G; out_load(G, u_lo, proj, ret, otid());
    for (int uid = u_lo; uid < u_hi; ++uid) {
        const int tid = otid(), lane = tid & 63, w = __builtin_amdgcn_readfirstlane(tid >> 6), q = lane & 31, hi = lane >> 5;
        const int qt = w >> 1, eh = w & 1;
        int b, h, n; dec(uid, b, h, n);
        const float lg = log2_gamma(h);
        const size_t row0 = (size_t)b * SEQ + 128 * n;
        out_write(G, uid, lds, tid);
        bf16x8 qr[4];
#pragma unroll
        for (int ks = 0; ks < 4; ++ks) qr[ks] = __builtin_bit_cast(bf16x8, G.q[ks]);
        __syncthreads();
        if (uid + 1 < u_hi) out_load(G, uid + 1, proj, ret, otid());
        f32x16 o[2];
#pragma unroll
        for (int r = 0; r < 16; ++r) { o[0][r] = 0.f; o[1][r] = 0.f; }
#pragma unroll
        for (int ks = 0; ks < 4; ++ks)
#pragma unroll
            for (int t = 0; t < 2; ++t) { const bf16x8 rf = tr_nat(lds + O_R + (2 * eh + t) * RS, ks, lane); o[t] = __builtin_amdgcn_mfma_f32_32x32x16_bf16(qr[ks], rf, o[t], 0, 0, 0); }
#pragma unroll
        for (int kt = 0; kt < 4; ++kt) if (kt <= qt) {
            const int uk = 32 * kt + q;
            f32x16 s;
#pragma unroll
            for (int r = 0; r < 16; ++r) s[r] = 0.f;
#pragma unroll
            for (int ks = 0; ks < 4; ++ks) { const bf16x8 kf = *(const LAS bf16x8*)(lds + O_K + 128 * uk + 16 * ((2 * ks + hi) ^ ((uk >> 1) & 7)));
                s = __builtin_amdgcn_mfma_f32_32x32x16_bf16(kf, qr[ks], s, 0, 0, 0); }
#pragma unroll
            for (int r = 0; r < 16; ++r) { const int kk = 32 * kt + crow(r, hi), qq = 32 * qt + q; s[r] = (kk <= qq) ? s[r] * fast_exp2(-lg * (float)kk) : 0.f; }
#pragma unroll
            for (int s2 = 0; s2 < 2; ++s2) { u32x4 pw; pw.x = cvtpk(s[8 * s2 + 0], s[8 * s2 + 1]); pw.y = cvtpk(s[8 * s2 + 2], s[8 * s2 + 3]); pw.z = cvtpk(s[8 * s2 + 4], s[8 * s2 + 5]); pw.w = cvtpk(s[8 * s2 + 6], s[8 * s2 + 7]);
                const bf16x8 pa = __builtin_bit_cast(bf16x8, pw);
#pragma unroll
                for (int t = 0; t < 2; ++t) { const bf16x8 vf = tr_perm(lds + O_V + (2 * eh + t) * VS, 32 * kt + 16 * s2, lane); o[t] = __builtin_amdgcn_mfma_f32_32x32x16_bf16(pa, vf, o[t], 0, 0, 0); } }
        }
        unsigned gq[16];
        { const bf16_t* gb = proj + hm_off(2560, 4, 128, b, h, 128 * n);
#pragma unroll
          for (int k = 0; k < 16; ++k) gq[k] = *(const unsigned*)(gb + (size_t)(16 * w + k) * 128 + 2 * lane); }
        LAS float* st = (LAS float*)(lds + O_ST);
#pragma unroll
        for (int r = 0; r < 16; ++r) { const int qq = 32 * qt + crow(r, hi); const float a = fast_exp2(lg * (float)qq);
#pragma unroll
            for (int t = 0; t < 2; ++t) st[qq * O_LD + 32 * (2 * eh + t) + q] = o[t][r] * a; }
        __syncthreads();
        float rsn;
        { const LAS f32x4* rp = (const LAS f32x4*)(st + (16 * w + (lane >> 2)) * O_LD + 32 * (lane & 3)); float ss = 0.f;
#pragma unroll
          for (int i = 0; i < 8; ++i) { const f32x4 x = rp[i]; ss += (x[0] * x[0] + x[1] * x[1]) + (x[2] * x[2] + x[3] * x[3]); }
          ss += __shfl_xor(ss, 1); ss += __shfl_xor(ss, 2);
          rsn = rsqrtf(ss * (1.0f / 128.0f) + EPS); }
#pragma unroll
        for (int k = 0; k < 16; ++k) { const int rr = 16 * w + k;
            const f32x2 v = *(const LAS f32x2*)(st + rr * O_LD + 2 * lane);
            const float rs = __shfl(rsn, 4 * k);
            const float g0 = bf2f(gq[k] & 0xffffu), g1 = bf2f(gq[k] >> 16);
            *(unsigned*)(omix + (row0 + rr) * D + 512 + h * 128 + 2 * lane) = cvt_pk_bf16(silu_f(g0) * v[0] * rs, silu_f(g1) * v[1] * rs); }
    }
}
}

constexpr int NPH = 14;
__global__ void __launch_bounds__(NWAVES * 64, 2) mk_fwd(Args args) {
    extern __shared__ __attribute__((aligned(16))) unsigned char lds_raw[];
    LAS unsigned char* lds = (LAS unsigned char*)lds_raw;
    volatile LAS unsigned* MISC = (volatile LAS unsigned*)(lds + MISC_OFF);
    const int wave = __builtin_amdgcn_readfirstlane((int)threadIdx.x >> 6);
#define tid (otid())
#define lane (otid() & 63)
    const int G = gridDim.x; const int bx = blockIdx.x;
    const int vcu = (G % 8 == 0) ? (bx % 8) * (G / 8) + bx / 8 : bx;
    const int gw = vcu * NWAVES + wave, NGW = G * NWAVES;
    unsigned char* ws = args.ws;
    unsigned* ctl = (unsigned*)(ws + WS_CTL);
    for (int u = tid; u < (LDS_BYTES - LDSCTL_OFF) / 4; u += NWAVES * 64) ((LAS unsigned*)(lds + LDSCTL_OFF))[u] = 0u;
    __syncthreads();
    XcdBarrier bar = xcd_barrier_post(ctl + CW_BAR, MISC + 8);
    const int lo = args.ph_lo, hi = args.ph_hi;
#define IN(k) (lo <= (k) && (k) < hi)
#define SEAM(k) do { if (IN(k) && IN((k) + 1)) xcd_barrier(bar); } while (0)

#define XIN ((const float*)args.in[0])
#define MEMIN ((const float*)args.in[1])
#define W1in ((bf16_t*)(ws + WS_W1IN))
#define W1out ((bf16_t*)(ws + WS_W1OUT))
#define Win ((bf16_t*)(ws + WS_WIN))
#define Wout ((bf16_t*)(ws + WS_WOUT))
#define Wcq ((bf16_t*)(ws + WS_WCQ))
#define Wckv ((bf16_t*)(ws + WS_WCKV))
#define Wco ((bf16_t*)(ws + WS_WCO))
#define W2in ((bf16_t*)(ws + WS_W2IN))
#define W2out ((bf16_t*)(ws + WS_W2OUT))
#define cosA ((float*)(ws + WS_COSA))
#define sinA ((float*)(ws + WS_SINA))
#define cosR ((float*)(ws + WS_COSR))
#define sinR ((float*)(ws + WS_SINR))
#define MEMN ((bf16_t*)(ws + WS_MEMN))
#define KVC ((bf16_t*)(ws + WS_KC))
#define SSQ ((float*)(ws + WS_SSQ))
#define XB ((bf16_t*)(ws + WS_XB))
#define BIG ((bf16_t*)(ws + WS_BIG))
#define OMIX ((bf16_t*)(ws + WS_OMIX))
#define QC ((bf16_t*)(ws + WS_ATT))
#define ATTP ((bf16_t*)(ws + WS_ATT))
#define LSE ((float*)(ws + WS_ATT + (size_t)M * 512 * 2 * 3))
#define RETB ((float*)(ws + WS_RET))
#define xres (args.xres)
    if (IN(0)) {
        LAS float* scr = (LAS float*)(lds + RING_OFF + wave * 16384);
        constexpr int I0 = (D / 64) * (2 * DFF / 32), I1 = (DFF / 64) * (D / 32), I2 = (D / 64) * (INC / 32), I3 = (D / 64) * (D / 32), I5 = (D / 64) * (2 * D / 32);
        constexpr int NITEMS = 2 * I0 + 2 * I1 + I2 + 3 * I3 + I5;
        for (int it = gw; it < NITEMS; it += NGW) {
            int r = it;
            if (r < I0) { p0_transpose_item(args.in[3], D, 2 * DFF, W1in, 0, nullptr, scr, r, lane); continue; } r -= I0;
            if (r < I1) { p0_transpose_item(args.in[4], DFF, D, W1out, 1, nullptr, scr, r, lane); continue; } r -= I1;
            if (r < I2) { p0_transpose_item(args.in[6], D, INC, Win, 2, args.in[5], scr, r, lane); continue; } r -= I2;
            if (r < I3) { p0_transpose_item(args.in[7], D, D, Wout, 3, nullptr, scr, r, lane); continue; } r -= I3;
            if (r < I3) { p0_transpose_item(args.in[10], D, D, Wcq, 4, args.in[8], scr, r, lane); continue; } r -= I3;
            if (r < I5) { p0_transpose_item(args.in[11], D, 2 * D, Wckv, 5, nullptr, scr, r, lane); continue; } r -= I5;
            if (r < I3) { p0_transpose_item(args.in[12], D, D, Wco, 6, nullptr, scr, r, lane); continue; } r -= I3;
            if (r < I0) { p0_transpose_item(args.in[14], D, 2 * DFF, W2in, 7, args.in[13], scr, r, lane); continue; } r -= I0;
            p0_transpose_item(args.in[15], DFF, D, W2out, 8, nullptr, scr, r, lane);
        }
        for (int m = gw; m < M; m += 2 * NGW) rms_row2_to_bf16(XIN + (size_t)m * D, (m + NGW < M) ? XIN + (size_t)(m + NGW) * D : nullptr, args.in[2], XB + (size_t)m * D, XB + (size_t)(m + NGW) * D, lane);
        for (int m = gw; m < MROWS; m += NGW) rms_row_to_bf16(MEMIN + (size_t)m * D, args.in[9], MEMN + (size_t)m * D, lane);
    }
    SEAM(0);
    if (IN(1)) {
        pg8::Gemm g{XB, W1in, D, D, D}; pg8::StaticOrder S; S.init(M, 2 * DFF, G, bx, D, D);
        pg8::EpiSwiGLU<false> E{BIG, nullptr};
        pg8::gemm_phase<pg8::EpiSwiGLU<false>, pg8::StaticOrder, true>(lds + RING_OFF, g, S, E);
    }
    SEAM(1);
    if (IN(2)) {
        pg8::Gemm g{BIG, W1out, DFF, DFF, DFF}; pg8::StaticOrder S; S.init(M, D, G, bx, DFF, DFF);
        pg8::EpiResid<0> E{XIN, nullptr, XB, SSQ};
        pg8::gemm_phase<pg8::EpiResid<0>, pg8::StaticOrder, true>(lds + RING_OFF, g, S, E);
    }
    SEAM(2);
    if (IN(3)) {
        pg8::Gemm g{XB, Win, D, D, D}; pg8::StaticOrder S; S.init(M, INC, G, bx, D, D);
        pg8::EpiInProj E{BIG, SSQ, cosA, sinA, cosR, sinR};
        pg8::gemm_phase<pg8::EpiInProj, pg8::StaticOrder, true>(lds + RING_OFF, g, S, E);
    }
    SEAM(3);
    if (IN(4)) {
        const int nkv = (MROWS / 256) * 8;
        const bool xg = (G % 8 == 0);
        const int gx = xg ? vcu / (G / 8) : 0, gj = xg ? vcu % (G / 8) : vcu, GXn = xg ? G / 8 : G;
        const bool spread = xg && GXn == 32 && nkv == 64;
        { pg8::Gemm g{MEMN, Wckv, D, D, D}; pg8::StaticOrder S; S.init(MROWS, 2 * D, G, spread ? (gj < 8 ? gx * 8 + gj : G) : vcu, D, D);
          pg8::EpiPlain<false> E{KVC, 2 * D, nullptr};
          pg8::gemm_phase<pg8::EpiPlain<false>, pg8::StaticOrder, true>(lds + RING_OFF, g, S, E); }
        { da::UnitMap U;
          if (xg) U.init(gx, gj, GXn, NBATCH, spread ? 8 : 0);
          else U.init(0, vcu, G, NBATCH * 8, 0);
          da::phase(lds, BIG, ATTP, LSE, U); }
        { const int nunits = NBATCH * 4 * 64; const int per = (nunits + G - 1) / G; const int u_lo = vcu * per, u_hi = (u_lo + per < nunits) ? u_lo + per : nunits;
          rt::kv_phase(lds, BIG, RETB, u_lo, u_hi); }
    }
    SEAM(4);
    if (IN(5)) { rt::scan(RETB, vcu * NWAVES * 64 + tid, G * NWAVES * 64); da::merge(ATTP, LSE, OMIX, vcu * NWAVES * 64 + tid, G * NWAVES * 64); }
    SEAM(5);
    if (IN(6)) { const int nunits = NBATCH * 4 * 64; const int per = (nunits + G - 1) / G; const int u_lo = vcu * per, u_hi = (u_lo + per < nunits) ? u_lo + per : nunits;
        rt::out_phase(lds, BIG, RETB, OMIX, u_lo, u_hi, tid); }
    SEAM(6);
    if (IN(7)) {
        pg8::Gemm g{OMIX, Wout, D, D, D}; pg8::StaticOrder S; S.init(M, D, G, bx, D, D);
        pg8::EpiResid<1> E{nullptr, nullptr, XB, SSQ};
        pg8::gemm_phase<pg8::EpiResid<1>, pg8::StaticOrder, true>(lds + RING_OFF, g, S, E);
    }
    SEAM(7);
    if (IN(8)) {
        { pg8::Gemm g{XB, Wcq, D, D, D}; pg8::StaticOrder S; S.init(M, D, G, bx, D, D);
          pg8::EpiPlain<true> E{QC, D, SSQ};
          pg8::gemm_phase<pg8::EpiPlain<true>, pg8::StaticOrder, true>(lds + RING_OFF, g, S, E); }
    }
    SEAM(8);
    if (IN(9)) { const int nunits = NBATCH * 4 * 32; const int per = (nunits + G - 1) / G; const int u_lo = vcu * per, u_hi = (u_lo + per < nunits) ? u_lo + per : nunits;
        xa::phase(lds, QC, KVC, OMIX, u_lo, u_hi, tid); }
    SEAM(9);
    if (IN(10)) {
        pg8::Gemm g{OMIX, Wco, D, D, D}; pg8::StaticOrder S; S.init(M, D, G, bx, D, D);
        pg8::EpiResid<1> E{nullptr, nullptr, XB, SSQ};
        pg8::gemm_phase<pg8::EpiResid<1>, pg8::StaticOrder, true>(lds + RING_OFF, g, S, E);
    }
    SEAM(10);
    if (IN(11)) {
        pg8::Gemm g{XB, W2in, D, D, D}; pg8::StaticOrder S; S.init(M, 2 * DFF, G, bx, D, D);
        pg8::EpiSwiGLU<true> E{BIG, SSQ};
        pg8::gemm_phase<pg8::EpiSwiGLU<true>, pg8::StaticOrder, true>(lds + RING_OFF, g, S, E);
    }
    SEAM(11);
    if (IN(12)) {
        pg8::Gemm g{BIG, W2out, DFF, DFF, DFF}; pg8::StaticOrder S; S.init(M, D, G, bx, DFF, DFF);
        pg8::EpiResid<1> E{nullptr, nullptr, XB, SSQ};
        pg8::gemm_phase<pg8::EpiResid<1>, pg8::StaticOrder, true>(lds + RING_OFF, g, S, E);
    }
    SEAM(12);
    if (IN(13)) {
        const float* wf = args.in[16];
        for (int m = gw; m < M; m += NGW) {
            const f32x4 p = *(const f32x4*)(SSQ + (size_t)m * 4);
            const float r = rsqrtf(((p[0] + p[1]) + (p[2] + p[3])) * (1.f / D) + EPS);
            const u32x4* xr = (const u32x4*)(XB + (size_t)m * D) + lane;
            f32x4* orow = (f32x4*)(xres + (size_t)m * D) + 2 * lane;
#pragma unroll
            for (int j = 0; j < 2; ++j) { const u32x4 w = xr[64 * j]; const f32x4 w0 = ((const f32x4*)wf)[128 * j + 2 * lane], w1 = ((const f32x4*)wf)[128 * j + 2 * lane + 1];
                f32x4 o0 = {bf2f(w[0] & 0xffffu), bf2f(w[0] >> 16), bf2f(w[1] & 0xffffu), bf2f(w[1] >> 16)}, o1 = {bf2f(w[2] & 0xffffu), bf2f(w[2] >> 16), bf2f(w[3] & 0xffffu), bf2f(w[3] >> 16)};
                orow[128 * j] = o0 * r * w0; orow[128 * j + 1] = o1 * r * w1; }
        }
    }
#undef IN
#undef SEAM
#undef tid
#undef lane
#undef XIN
#undef MEMIN
#undef W1in
#undef W1out
#undef Win
#undef Wout
#undef Wcq
#undef Wckv
#undef Wco
#undef W2in
#undef W2out
#undef cosA
#undef sinA
#undef cosR
#undef sinR
#undef MEMN
#undef KVC
#undef SSQ
#undef XB
#undef BIG
#undef OMIX
#undef QC
#undef ATTP
#undef LSE
#undef RETB
#undef xres
}


extern "C" void kernel_launch(void* const* d_in, const int* in_sizes, int n_in, void* d_out, int out_size, void* d_ws, size_t ws_size, hipStream_t stream) {
    static int grid = 0;
    if (grid == 0) {
        int dev = 0, cus = 0, per_cu = 0;
        if (n_in != 17 || ws_size < WS_OPT_END) { fprintf(stderr, "kernel_launch: unexpected inputs (n_in %d, ws %zu < %zu)\n", n_in, ws_size, (size_t)WS_OPT_END); grid = -1; return; }
        if (hipGetDevice(&dev) != hipSuccess || hipDeviceGetAttribute(&cus, hipDeviceAttributeMultiprocessorCount, dev) != hipSuccess) { grid = -1; return; }
        if (hipFuncSetAttribute((const void*)mk_fwd, hipFuncAttributeMaxDynamicSharedMemorySize, LDS_BYTES) != hipSuccess) { fprintf(stderr, "kernel_launch: hipFuncSetAttribute failed\n"); grid = -1; return; }
        if (hipOccupancyMaxActiveBlocksPerMultiprocessor(&per_cu, (const void*)mk_fwd, NWAVES * 64, LDS_BYTES) != hipSuccess || per_cu < 1) { fprintf(stderr, "kernel_launch: occupancy query says %d blocks per CU\n", per_cu); (void)hipGetLastError(); grid = -1; return; }
        grid = cus;
    }
    if (grid < 0) return;
    (void)hipMemsetAsync((char*)d_ws + WS_CTL, 0, CTL_ZERO_BYTES, stream);
    Args a{};
    for (int i = 0; i < 17; ++i) a.in[i] = (const float*)d_in[i];
    a.out = (float*)d_out; a.ws = (unsigned char*)d_ws;
    a.xres = (float*)d_out; a.ph_lo = 0; a.ph_hi = NPH;
    hipLaunchKernelGGL(mk_fwd, dim3(grid), dim3(NWAVES * 64), LDS_BYTES, stream, a);
}
```

```cpp
#include <hip/hip_runtime.h>
#include <cstdio>
#include <cstdint>
#include <cmath>

#define DBG 0
#define DI __device__ __forceinline__

constexpr int D = 1024, NB_ALL = 8, SEQ = 8192, MEMLEN = 256, DFF = 2816, INC = 3072;
constexpr int NBATCH = DBG ? 1 : 8;
constexpr int M = NBATCH * SEQ;
constexpr int MROWS = NBATCH * MEMLEN;
constexpr float EPS = 1e-6f;
constexpr float LOG2E = 1.4426950408889634f;

typedef unsigned short bf16_t;
typedef short bf16x8 __attribute__((ext_vector_type(8)));
typedef float f32x4 __attribute__((ext_vector_type(4)));
typedef float f32x2 __attribute__((ext_vector_type(2)));
typedef unsigned u32x4 __attribute__((ext_vector_type(4)));
typedef unsigned u32x2 __attribute__((ext_vector_type(2)));
#define LAS __attribute__((address_space(3)))
#define GAS __attribute__((address_space(1)))

DI int otid() { int t = threadIdx.x; asm volatile("" : "+v"(t)); return t; }
DI float bf2f(unsigned u16) { return __uint_as_float(u16 << 16); }
DI unsigned cvt_pk_bf16(float lo, float hi) { unsigned r; asm volatile("v_cvt_pk_bf16_f32 %0, %1, %2" : "=v"(r) : "v"(lo), "v"(hi)); return r; }
DI float fast_exp2(float x) { return __builtin_amdgcn_exp2f(x); }
DI float fast_rcp(float x) { return __builtin_amdgcn_rcpf(x); }
DI float silu_f(float x) { return x * fast_rcp(1.0f + fast_exp2(-x * LOG2E)); }


DI size_t hm_off(int secoff, int nheads, int hw, int b, int head, int t) { return (size_t)b * SEQ * INC + (size_t)SEQ * secoff + ((size_t)head * SEQ + t) * hw; }

namespace pg8 {
constexpr int BM = 256, BK = 64, HALF = 128, HTB = HALF * BK * 2, STAGE_BYTES = 8 * HTB, NXCD = 8, WGM = 8;
constexpr int EPI_SCR = STAGE_BYTES;
constexpr int EPI_RS = EPI_SCR + 4096, EPI_RS_MAX = 24;
__host__ __device__ __forceinline__ int lds_byte(int r, int c) { const int st = (r >> 4) * 2 + (c >> 5), rr = r & 15, cc = c & 31, ob = rr * 64 + cc * 2; return st * 1024 + (ob ^ (((ob >> 9) & 1) << 5)); }
__host__ __device__ __forceinline__ void stage_rc(int b, int& R, int& C) { const int st = b / 1024, sb = b % 1024, swz = sb ^ (((sb >> 9) & 1) << 5); R = (st >> 1) * 16 + swz / 64; C = (st & 1) * 32 + (swz % 64) / 2; }
__host__ __device__ __forceinline__ int perm32(int rho) { const int n = rho >> 4, i = rho & 15; return 8 * (i >> 2) + 4 * n + (i & 3); }

struct Unit { int pm, pn, z; };
struct Gemm { const bf16_t* A; const bf16_t* Bt; int lda, ldb, K; };

struct StaticOrder {
    int nM, nN, nwg, G, c, lda, ldb, flat;
    DI void init(int M_, int N_, int G_, int c_, int lda_, int ldb_) { nM = M_ / BM; nN = N_ / BM; nwg = nM * nN; G = G_; c = c_; lda = lda_; ldb = ldb_; flat = 0; }
    DI bool next(int i, Unit& u) const {
        const long L = (long)i * G + c; if (L >= nwg) return false;
        int wgid = (int)L; if (!flat) { const int q = nwg / NXCD, r = nwg % NXCD, xcd = wgid % NXCD, off = wgid / NXCD; wgid = (xcd < r ? xcd * (q + 1) : r * (q + 1) + (xcd - r) * q) + off; }
        const int nig = WGM * nN, gid = wgid / nig, fm = gid * WGM, gsz = (nM - fm) < WGM ? (nM - fm) : WGM;
        u.pm = fm + ((wgid % nig) % gsz); u.pn = (wgid % nig) / gsz; u.z = 0; return true;
    }
    DI size_t a_off(const Unit& u) const { return (size_t)u.pm * BM * lda; }
    DI size_t b_off(const Unit& u) const { return (size_t)u.pn * BM * ldb; }
};

template <class Epi, class Sched, bool ALIGN_EPI>
DI void gemm_phase(LAS unsigned char* lds, const Gemm g, const Sched& S, const Epi& E) {
    const int tid = otid(), wid = __builtin_amdgcn_readfirstlane(tid >> 6), lane = tid & 63, wr = wid >> 2, wc = wid & 3, fr = lane & 15, fq = lane >> 4;
    const int nt = g.K / BK;
    unsigned voffA[2], voffB[2];
#pragma unroll
    for (int i = 0; i < 2; ++i) { int R, C; stage_rc(tid * 16 + i * 8192, R, C); const int Rb = Epi::PERM ? ((R & ~31) + perm32(R & 31)) : R;
        voffA[i] = (unsigned)(R * g.lda + C) * 2u; voffB[i] = (unsigned)(Rb * g.ldb + C) * 2u; }
    const size_t kstep = (size_t)(BK * 2);
    const size_t hstepA = (size_t)HALF * g.lda * 2, hstepB = (size_t)HALF * g.ldb * 2;
    const unsigned ldsw = (unsigned)wid * 1024u;
    const int aoff = lds_byte(wr * 64 + fr, fq * 8), boff = lds_byte(wc * 32 + fr, fq * 8);
#define PG8_SA(b, h) (((b) * 2 + (h)) * HTB)
#define PG8_SB(b, h) ((4 + (b) * 2 + (h)) * HTB)
#define PG8_STAGE(bufoff, gbase, voff) do { _Pragma("unroll") for (int _i = 0; _i < 2; ++_i) \
        __builtin_amdgcn_global_load_lds((const unsigned*)((const char*)(gbase) + (voff)[_i]), (LAS unsigned*)(lds + (bufoff) + ldsw + _i * 8192), 16, 0, 0); } while (0)
#define PG8_LDA(dst, b, h) do { _Pragma("unroll") for (int m = 0; m < 4; ++m) _Pragma("unroll") for (int k = 0; k < 2; ++k) dst[m][k] = *(const LAS bf16x8*)(lds + PG8_SA(b, h) + aoff + m * 2048 + k * 1024); } while (0)
#define PG8_LDB(dst, b, h) do { _Pragma("unroll") for (int n = 0; n < 2; ++n) _Pragma("unroll") for (int k = 0; k < 2; ++k) dst[n][k] = *(const LAS bf16x8*)(lds + PG8_SB(b, h) + boff + n * 2048 + k * 1024); } while (0)
#define PG8_MMA(ai, bj, At, Bt) do { __builtin_amdgcn_s_setprio(1); _Pragma("unroll") for (int m = 0; m < 4; ++m) _Pragma("unroll") for (int n = 0; n < 2; ++n) _Pragma("unroll") for (int k = 0; k < 2; ++k) \
        acc[ai][bj][m][n] = __builtin_amdgcn_mfma_f32_16x16x32_bf16(Bt[n][k], At[m][k], acc[ai][bj][m][n], 0, 0, 0); __builtin_amdgcn_s_setprio(0); } while (0)
#define PG8_WAIT_V(n) asm volatile("s_waitcnt vmcnt(" #n ")" ::: "memory")
#define PG8_WAIT_L(n) asm volatile("s_waitcnt lgkmcnt(" #n ")" ::: "memory")
#define PG8_BAR __builtin_amdgcn_s_barrier()
#define PG8_SCHED __builtin_amdgcn_sched_barrier(0)
    Unit cur, nxt; int ui = 0;
    if (!S.next(0, cur)) return;
    E.preload(S, lds + EPI_RS);
    f32x4 acc[2][2][4][2];
    E.init(acc, cur, wr, wc, fr, fq);
    bf16x8 At[4][2], B0[2][2], B1[2][2];
    const char* cA = (const char*)(g.A + S.a_off(cur)); const char* cB = (const char*)(g.Bt + S.b_off(cur));
    PG8_STAGE(PG8_SB(0, 0), cB, voffB); PG8_STAGE(PG8_SB(0, 1), cB + hstepB, voffB); PG8_STAGE(PG8_SA(0, 0), cA, voffA); PG8_STAGE(PG8_SA(0, 1), cA + hstepA, voffA);
    if (wr == 1) PG8_BAR;
    PG8_WAIT_V(2); PG8_BAR;
    PG8_STAGE(PG8_SB(1, 0), cB + kstep, voffB); PG8_STAGE(PG8_SA(1, 0), cA + kstep, voffA); PG8_STAGE(PG8_SB(1, 1), cB + hstepB + kstep, voffB);
    PG8_WAIT_V(6); PG8_BAR;
    for (;;) {
        const bool has_next = S.next(ui + 1, nxt);
        const char* nA = has_next ? (const char*)(g.A + S.a_off(nxt)) : cA; const char* nB = has_next ? (const char*)(g.Bt + S.b_off(nxt)) : cB;
        for (int t = 0; t < nt; t += 2) {
            const bool last = (t == nt - 2);
            const char* a1 = cA + (size_t)(t + 1) * kstep;
            const char* a2 = last ? nA : cA + (size_t)(t + 2) * kstep; const char* b2 = last ? nB : cB + (size_t)(t + 2) * kstep;
            const char* a3 = a2 + kstep; const char* b3 = b2 + kstep;
            PG8_LDB(B0, 0, 0); PG8_LDB(B1, 0, 1); PG8_SCHED; PG8_LDA(At, 0, 0); PG8_STAGE(PG8_SA(1, 1), a1 + hstepA, voffA);
            PG8_WAIT_V(8); PG8_WAIT_L(0); PG8_BAR; PG8_MMA(0, 0, At, B0); PG8_MMA(0, 1, At, B1); PG8_BAR; PG8_SCHED;
            PG8_LDA(At, 0, 1); PG8_STAGE(PG8_SB(0, 0), b2, voffB); PG8_STAGE(PG8_SB(0, 1), b2 + hstepB, voffB); PG8_STAGE(PG8_SA(0, 0), a2, voffA);
            PG8_WAIT_V(8); PG8_WAIT_L(0); PG8_BAR; PG8_MMA(1, 0, At, B0); PG8_MMA(1, 1, At, B1); PG8_BAR; PG8_SCHED;
            PG8_LDB(B0, 1, 0); PG8_LDB(B1, 1, 1); PG8_SCHED; PG8_LDA(At, 1, 0); PG8_STAGE(PG8_SA(0, 1), a2 + hstepA, voffA);
            PG8_WAIT_V(8); PG8_WAIT_L(0); PG8_BAR; PG8_MMA(0, 0, At, B0); PG8_MMA(0, 1, At, B1); PG8_BAR; PG8_SCHED;
            PG8_LDA(At, 1, 1); PG8_STAGE(PG8_SB(1, 0), b3, voffB); PG8_STAGE(PG8_SB(1, 1), b3 + hstepB, voffB); PG8_STAGE(PG8_SA(1, 0), a3, voffA);
            PG8_WAIT_V(8); PG8_WAIT_L(0); PG8_BAR; PG8_MMA(1, 0, At, B0); PG8_MMA(1, 1, At, B1); PG8_BAR; PG8_SCHED;
        }
        if constexpr (ALIGN_EPI) { if (wr == 0) PG8_BAR; }
        E(acc, cur, ui, wr, wc, fr, fq, lds + EPI_SCR);
        if (!has_next) break;
        E.init(acc, nxt, wr, wc, fr, fq);
        cur = nxt; cA = nA; cB = nB; ++ui;
        if constexpr (ALIGN_EPI) { if (wr == 1) PG8_BAR; }
    }
    PG8_WAIT_V(0);
    if constexpr (!ALIGN_EPI) { if (wr == 0) PG8_BAR; }
    PG8_BAR;
#undef PG8_SA
#undef PG8_SB
#undef PG8_STAGE
#undef PG8_LDA
#undef PG8_LDB
#undef PG8_MMA
#undef PG8_WAIT_V
#undef PG8_WAIT_L
#undef PG8_BAR
#undef PG8_SCHED
}

DI void zero_acc(f32x4 (&acc)[2][2][4][2]) {
#pragma unroll
    for (int a = 0; a < 2; ++a)
#pragma unroll
        for (int b = 0; b < 2; ++b)
#pragma unroll
            for (int m = 0; m < 4; ++m)
#pragma unroll
                for (int n = 0; n < 2; ++n) acc[a][b][m][n] = (f32x4){0.f, 0.f, 0.f, 0.f};
}
template <class Sched> DI void preload_rstd(const Sched& S, const float* ssq4, LAS unsigned char* tab) {
    const int t = otid(); Unit u;
    if (t < 256) for (int i = 0; i < EPI_RS_MAX && S.next(i, u); ++i) { const f32x4 p = *(const f32x4*)(ssq4 + (size_t)(u.pm * BM + t) * 4);
        ((LAS float*)tab)[i * 256 + t] = rsqrtf(((p[0] + p[1]) + (p[2] + p[3])) * (1.0f / 1024.0f) + EPS); }
}
DI void load_rstd(float (&rs)[2][4], LAS unsigned char* scr, int ui, int wr, int fr) {
    const LAS float* tab = (const LAS float*)(scr + 4096) + ui * 256 + wr * 64 + fr;
#pragma unroll
    for (int ai = 0; ai < 2; ++ai)
#pragma unroll
        for (int m = 0; m < 4; ++m) rs[ai][m] = tab[ai * HALF + m * 16];
}
DI u32x4 pack8(const f32x4 v0, const f32x4 v1) { u32x4 w; w.x = cvt_pk_bf16(v0[0], v0[1]); w.y = cvt_pk_bf16(v0[2], v0[3]); w.z = cvt_pk_bf16(v1[0], v1[1]); w.w = cvt_pk_bf16(v1[2], v1[3]); return w; }

template <bool SCALE> struct EpiSwiGLU {
    static constexpr bool PERM = true;
    bf16_t* O; const float* ssq4;
    template <class Sched> DI void preload(const Sched& S, LAS unsigned char* tab) const { if (SCALE) preload_rstd(S, ssq4, tab); }
    DI void init(f32x4 (&acc)[2][2][4][2], const Unit&, int, int, int, int) const { zero_acc(acc); }
    DI void operator()(const f32x4 (&acc)[2][2][4][2], const Unit& u, int ui, int wr, int wc, int fr_, int fq_, LAS unsigned char* scr) const {
        int l_ = fr_ + 16 * fq_; asm volatile("" : "+v"(l_)); const int fr = l_ & 15, fq = l_ >> 4;
        const int row0 = u.pm * BM + wr * 64 + fr, col0 = u.pn * 128 + wc * 32 + 8 * fq;
        float rs[2][4];
        if (SCALE) load_rstd(rs, scr, ui, wr, fr);
#pragma unroll
        for (int ai = 0; ai < 2; ++ai)
#pragma unroll
            for (int m = 0; m < 4; ++m) { const int row = row0 + ai * HALF + m * 16; const float r = SCALE ? rs[ai][m] : 1.0f;
                f32x4 o0, o1;
#pragma unroll
                for (int i = 0; i < 4; ++i) { o0[i] = silu_f(acc[ai][0][m][0][i] * r) * (acc[ai][1][m][0][i] * r); o1[i] = silu_f(acc[ai][0][m][1][i] * r) * (acc[ai][1][m][1][i] * r); }
                *(u32x4*)(O + (size_t)row * INC + col0) = pack8(o0, o1); }
    }
};
template <int MODE> struct EpiResid {
    static constexpr bool PERM = true;
    const float* R; float* out; bf16_t* XB; float* ssq4; int var;
    template <class Sched> DI void preload(const Sched&, LAS unsigned char*) const {}
    DI void init(f32x4 (&acc)[2][2][4][2], const Unit& u, int wr, int wc, int fr_, int fq_) const {
        int l_ = fr_ + 16 * fq_; asm volatile("" : "+v"(l_)); const int fr = l_ & 15, fq = l_ >> 4;
        const int row0 = u.pm * BM + wr * 64 + fr, col0 = u.pn * BM + wc * 32 + 8 * fq;
        if (MODE == 0) {
#pragma unroll
            for (int ai = 0; ai < 2; ++ai)
#pragma unroll
                for (int m = 0; m < 4; ++m)
#pragma unroll
                    for (int bj = 0; bj < 2; ++bj) { const float* p = R + (size_t)(row0 + ai * HALF + m * 16) * D + col0 + bj * HALF;
                        acc[ai][bj][m][0] = *(const f32x4*)p; acc[ai][bj][m][1] = *(const f32x4*)(p + 4); }
        } else {
            u32x4 w[2][4][2];
#pragma unroll
            for (int ai = 0; ai < 2; ++ai)
#pragma unroll
                for (int m = 0; m < 4; ++m)
#pragma unroll
                    for (int bj = 0; bj < 2; ++bj) w[ai][m][bj] = *(const u32x4*)(XB + (size_t)(row0 + ai * HALF + m * 16) * D + col0 + bj * HALF);
#pragma unroll
            for (int ai = 0; ai < 2; ++ai)
#pragma unroll
                for (int m = 0; m < 4; ++m)
#pragma unroll
                    for (int bj = 0; bj < 2; ++bj) { const u32x4 x = w[ai][m][bj];
                        acc[ai][bj][m][0] = (f32x4){bf2f(x[0] & 0xffffu), bf2f(x[0] >> 16), bf2f(x[1] & 0xffffu), bf2f(x[1] >> 16)};
                        acc[ai][bj][m][1] = (f32x4){bf2f(x[2] & 0xffffu), bf2f(x[2] >> 16), bf2f(x[3] & 0xffffu), bf2f(x[3] >> 16)}; }
        }
    }
    DI void operator()(const f32x4 (&acc)[2][2][4][2], const Unit& u, int ui, int wr, int wc, int fr_, int fq_, LAS unsigned char* scr) const {
        int l_ = fr_ + 16 * fq_; asm volatile("" : "+v"(l_)); const int fr = l_ & 15, fq = l_ >> 4;
        const int col0 = u.pn * BM + wc * 32 + 8 * fq;
        LAS float* S = (LAS float*)scr;
#pragma unroll
        for (int ai = 0; ai < 2; ++ai)
#pragma unroll
            for (int m = 0; m < 4; ++m) { const int rl = ai * HALF + wr * 64 + m * 16 + fr; const int row = u.pm * BM + rl; float ss = 0.f;
#pragma unroll
                for (int bj = 0; bj < 2; ++bj) { const size_t off = (size_t)row * D + col0 + bj * HALF;
                    const f32x4 v0 = acc[ai][bj][m][0], v1 = acc[ai][bj][m][1];
                    if (MODE == 2) { *(f32x4*)(out + off) = v0; *(f32x4*)(out + off + 4) = v1; }
                    else { *(u32x4*)(XB + off) = pack8(v0, v1);
                        ss += (v0[0] * v0[0] + v0[1] * v0[1]) + (v0[2] * v0[2] + v0[3] * v0[3]) + (v1[0] * v1[0] + v1[1] * v1[1]) + (v1[2] * v1[2] + v1[3] * v1[3]); } }
                if (MODE != 2) { ss += __shfl_xor(ss, 16); ss += __shfl_xor(ss, 32); if (fq == 0) S[rl * 4 + wc] = ss; } }
        if (MODE != 2) {
            asm volatile("s_waitcnt lgkmcnt(0)" ::: "memory"); __builtin_amdgcn_s_barrier(); asm volatile("" ::: "memory");
            const int t = otid();
            if (t < 256) { const f32x4 p = *(const LAS f32x4*)(S + t * 4); ssq4[(size_t)(u.pm * BM + t) * 4 + u.pn] = (p[0] + p[1]) + (p[2] + p[3]); }
        }
    }
};
template <bool SCALE> struct EpiPlain {
    static constexpr bool PERM = true;
    bf16_t* O; int ldc; const float* ssq4;
    template <class Sched> DI void preload(const Sched& S, LAS unsigned char* tab) const { if (SCALE) preload_rstd(S, ssq4, tab); }
    DI void init(f32x4 (&acc)[2][2][4][2], const Unit&, int, int, int, int) const { zero_acc(acc); }
    DI void operator()(const f32x4 (&acc)[2][2][4][2], const Unit& u, int ui, int wr, int wc, int fr_, int fq_, LAS unsigned char* scr) const {
        int l_ = fr_ + 16 * fq_; asm volatile("" : "+v"(l_)); const int fr = l_ & 15, fq = l_ >> 4;
        const int row0 = u.pm * BM + wr * 64 + fr, col0 = u.pn * BM + wc * 32 + 8 * fq;
        float rs[2][4];
        if (SCALE) load_rstd(rs, scr, ui, wr, fr);
#pragma unroll
        for (int ai = 0; ai < 2; ++ai)
#pragma unroll
            for (int m = 0; m < 4; ++m) { const int row = row0 + ai * HALF + m * 16; const float r = SCALE ? rs[ai][m] : 1.0f;
#pragma unroll
                for (int bj = 0; bj < 2; ++bj) *(u32x4*)(O + (size_t)row * ldc + col0 + bj * HALF) = pack8(acc[ai][bj][m][0] * r, acc[ai][bj][m][1] * r); }
    }
};
struct EpiInProj {
    static constexpr bool PERM = true;
    bf16_t* O; const float* ssq4; const float* cosA; const float* sinA; const float* cosR; const float* sinR;
    template <class Sched> DI void preload(const Sched& S, LAS unsigned char* tab) const { preload_rstd(S, ssq4, tab); }
    DI void init(f32x4 (&acc)[2][2][4][2], const Unit&, int, int, int, int) const { zero_acc(acc); }
    DI void operator()(const f32x4 (&acc)[2][2][4][2], const Unit& u, int ui, int wr, int wc, int fr_, int fq_, LAS unsigned char* scr) const {
        int l_ = fr_ + 16 * fq_; asm volatile("" : "+v"(l_)); const int fr = l_ & 15, fq = l_ >> 4;
        const int row0 = u.pm * BM + wr * 64 + fr, col0 = u.pn * BM + wc * 32 + 8 * fq;
        const int kind = (u.pn < 4) ? 1 : ((u.pn == 6 || u.pn == 7) ? 2 : 0);
        const bool second = (fq & 1) != 0;
        const bool active = (kind == 2) || (kind == 1 && (wc & 1) == 0 && fq < 2);
        const int b16 = 2 * (wc & 1) + (fq >> 1);
        float rs[2][4];
        load_rstd(rs, scr, ui, wr, fr);
        float irev[8];
        { const float l2t = (kind == 1) ? 18.931568569324174f   : 13.287712379549449f  ; const float inv_half = (kind == 1) ? 0.125f : 0.03125f; const int c0 = (kind == 1) ? 0 : 8 * b16;
#pragma unroll
          for (int i = 0; i < 8; ++i) irev[i] = fast_exp2(-l2t * (float)(c0 + i) * inv_half) * 0.15915494309189535f; }
#pragma unroll
        for (int g2 = 0; g2 < 8; ++g2) {
            const int ai = g2 >> 2, m = g2 & 3; const int row = row0 + ai * HALF + m * 16; const float r = rs[ai][m];
            f32x4 c0 = {0.f, 0.f, 0.f, 0.f}, c1 = c0, s0 = c0, s1 = c0;
            if (active) { const float tf = (float)(row & (SEQ - 1));
#pragma unroll
                for (int i = 0; i < 4; ++i) { const float ra = __builtin_amdgcn_fractf(tf * irev[i]), rb = __builtin_amdgcn_fractf(tf * irev[4 + i]);
                    c0[i] = __builtin_amdgcn_cosf(ra); s0[i] = __builtin_amdgcn_sinf(ra); c1[i] = __builtin_amdgcn_cosf(rb); s1[i] = __builtin_amdgcn_sinf(rb); } }
#pragma unroll
                for (int bj = 0; bj < 2; ++bj) { f32x4 v0 = acc[ai][bj][m][0] * r, v1 = acc[ai][bj][m][1] * r;
                    if (kind != 0) { f32x4 p0, p1;
#pragma unroll
                        for (int i = 0; i < 4; ++i) {
                            const auto x0 = __builtin_amdgcn_permlane16_swap(__float_as_uint(v0[i]), __float_as_uint(v0[i]), false, false);
                            const auto x1 = __builtin_amdgcn_permlane16_swap(__float_as_uint(v1[i]), __float_as_uint(v1[i]), false, false);
                            p0[i] = __uint_as_float(second ? x0[0] : x0[1]); p1[i] = __uint_as_float(second ? x1[0] : x1[1]); }
                        const f32x4 r0 = second ? (p0 * s0 + v0 * c0) : (v0 * c0 - p0 * s0);
                        const f32x4 r1 = second ? (p1 * s1 + v1 * c1) : (v1 * c1 - p1 * s1);
                        if (active) { v0 = r0; v1 = r1; } }
                    { const int ct = bj * HALF + wc * 32 + 8 * fq, b = row / SEQ, t = row & (SEQ - 1); size_t off;
                      if (u.pn < 6) { const int cs = (u.pn & 1) * 256 + ct; off = hm_off(512 * (u.pn >> 1), 8, 64, b, cs >> 6, t) + (cs & 63); }
                      else if (u.pn < 8) off = hm_off(1536 + 256 * (u.pn - 6), 4, 64, b, ct >> 6, t) + (ct & 63);
                      else { const int cs = (u.pn & 1) * 256 + ct; off = hm_off(2048 + 512 * ((u.pn - 8) >> 1), 4, 128, b, cs >> 7, t) + (cs & 127); }
                      *(u32x4*)(O + off) = pack8(v0, v1); } }
        }
    }
};
}

constexpr size_t MiB = 1u << 20;
constexpr size_t al(size_t x) { return (x + 255) & ~(size_t)255; }
constexpr size_t WS_CTL = 0, CTL_ZERO_BYTES = 262144;
constexpr size_t WS_W1IN = 1 * MiB;
constexpr size_t WS_W1OUT = WS_W1IN + (size_t)2 * DFF * D * 2;
constexpr size_t WS_WIN = WS_W1OUT + (size_t)D * DFF * 2;
constexpr size_t WS_WOUT = WS_WIN + (size_t)INC * D * 2;
constexpr size_t WS_WCQ = WS_WOUT + (size_t)D * D * 2;
constexpr size_t WS_WCKV = WS_WCQ + (size_t)D * D * 2;
constexpr size_t WS_WCO = WS_WCKV + (size_t)2 * D * D * 2;
constexpr size_t WS_W2IN = WS_WCO + (size_t)D * D * 2;
constexpr size_t WS_W2OUT = WS_W2IN + (size_t)2 * DFF * D * 2;
constexpr size_t WS_TAB = WS_W2OUT + (size_t)D * DFF * 2;
constexpr size_t WS_COSA = WS_TAB, WS_SINA = WS_COSA + (size_t)SEQ * 8 * 4, WS_COSR = WS_SINA + (size_t)SEQ * 8 * 4, WS_SINR = WS_COSR + (size_t)SEQ * 32 * 4;
constexpr size_t WS_MEMN = WS_SINR + (size_t)SEQ * 32 * 4;
constexpr size_t WS_KC = WS_MEMN + (size_t)MROWS * D * 2;
constexpr size_t WS_VT = WS_KC + (size_t)MROWS * D * 2;
constexpr size_t WS_SSQ = WS_VT + (size_t)MROWS * D * 2;
constexpr size_t WS_XB = al(WS_SSQ + (size_t)M * 16 * 4);
constexpr size_t WS_BIG = WS_XB + (size_t)M * D * 2;
constexpr size_t WS_OMIX = WS_BIG + (size_t)M * INC * 2;
constexpr size_t WS_ATT = WS_OMIX + (size_t)M * D * 2;
constexpr size_t WS_ATT_BYTES = (size_t)M * 512 * 2 * 3 + (size_t)M * 8 * 4 * 3;
constexpr size_t WS_RET = WS_ATT + WS_ATT_BYTES;
constexpr size_t WS_XRES = WS_RET + (size_t)NBATCH * 64 * 4 * 64 * 128 * 4;
constexpr size_t WS_OPT_END = WS_XRES + (DBG ? (size_t)M * D * 4 : 0);

constexpr int RING_OFF = 0, RING_BYTES = 131072;
constexpr int LDSCTL_OFF = 163840 - 256, MISC_OFF = LDSCTL_OFF;
constexpr int LDS_BYTES = 163840;
constexpr int NWAVES = 8;

#define XB_TMO      128
#define XB_XCNT(j)  (256  + 64 * (j))
#define XB_XSUB(j)  (1280 + 64 * (j))
#define XB_XGEN(j)  (2304 + 64 * (j))
#define XB_TOP      3328
#define XB_TOPGEN   3392
#define XCD_BAR_WORDS 3456
#define XB_SPIN_CAP (1u << 18)
DI unsigned xb_ld(unsigned* p)              { return __hip_atomic_load(p, __ATOMIC_RELAXED, __HIP_MEMORY_SCOPE_AGENT); }
DI unsigned xb_add(unsigned* p, unsigned v) { return __hip_atomic_fetch_add(p, v, __ATOMIC_RELAXED, __HIP_MEMORY_SCOPE_AGENT); }
DI unsigned xb_xcc_id() { return (unsigned)__builtin_amdgcn_s_getreg((3 << 11) | 20) & 0xFu; }
#define XB_SPIN(cond, bar) do { unsigned _sp = 0; while (cond) { __builtin_amdgcn_s_sleep(1); \
    if ((++_sp & 255u) == 0u) { if (xb_ld(&(bar)[XB_TMO])) break; if (_sp > XB_SPIN_CAP) { atomicAdd(&(bar)[XB_TMO], 1u); break; } } } } while (0)
struct XcdBarrier { unsigned* bar; unsigned x; volatile LAS unsigned* st; unsigned n; };
DI XcdBarrier xcd_barrier_post(unsigned* bar, volatile LAS unsigned* st, unsigned n) {
    XcdBarrier b; b.bar = bar; b.x = xb_xcc_id(); b.st = st; b.n = n;
    if (threadIdx.x == 0) (void)xb_add(&bar[XB_XCNT(b.x)], 1u);
    return b;
}
DI void xcd_barrier_complete(unsigned* bar, unsigned x, unsigned G, unsigned& nloc, unsigned& nx) {
    unsigned sum, cnt, mine, sp = 0u;
    for (;;) {
        sum = 0u; cnt = 0u; mine = 0u;
#pragma unroll
        for (unsigned j = 0; j < 16; ++j) { const unsigned c = xb_ld(&bar[XB_XCNT(j)]); sum += c; cnt += (c > 0u) ? 1u : 0u; mine = (j == x) ? c : mine; }
        if (sum == G) break;
        __builtin_amdgcn_s_sleep(1);
        if ((++sp & 255u) == 0u) { if (xb_ld(&bar[XB_TMO])) break; if (sp > XB_SPIN_CAP) { atomicAdd(&bar[XB_TMO], 1u); break; } }
    }
    nloc = mine > 0u ? mine : 1u; nx = cnt > 0u ? cnt : 1u;
}
DI void xcd_barrier(const XcdBarrier& b) {
    asm volatile("s_waitcnt vmcnt(0)" ::: "memory");
    __syncthreads();
    if (threadIdx.x == 0) {
        unsigned* bar = b.bar;
        __builtin_amdgcn_s_waitcnt(0);
        unsigned nloc = b.st[0], nx = b.st[1];
        if (nloc == 0u) { xcd_barrier_complete(bar, b.x, b.n, nloc, nx); b.st[0] = nloc; b.st[1] = nx; }
        const unsigned old = xb_add(&bar[XB_XSUB(b.x)], 1u);
        const unsigned gen = old / nloc;
        if (old + 1u == (gen + 1u) * nloc) {
            if (nx > 1u) {
            __builtin_amdgcn_fence(__ATOMIC_RELEASE, "agent");
            asm volatile("s_waitcnt vmcnt(0)" ::: "memory"); }
            const unsigned og = xb_add(&bar[XB_TOP], 1u);
            const unsigned tg = og / nx;
            if (og + 1u == (tg + 1u) * nx) xb_add(&bar[XB_TOPGEN], 1u);
            else XB_SPIN(xb_ld(&bar[XB_TOPGEN]) == tg, bar);
            __builtin_amdgcn_fence(__ATOMIC_ACQUIRE, "agent");
            xb_add(&bar[XB_XGEN(b.x)], 1u);
            asm volatile("s_waitcnt vmcnt(0)" ::: "memory");
        } else {
            XB_SPIN(xb_ld(&bar[XB_XGEN(b.x)]) == gen, bar);
            __builtin_amdgcn_fence(__ATOMIC_ACQUIRE, "agent");
            asm volatile("s_waitcnt vmcnt(0)" ::: "memory");
        }
    }
    __syncthreads();
}
constexpr int CW_BAR = 4096;

struct Args {
    const float* in[17]; float* out; unsigned char* ws; float* xres;
    int ph_lo, ph_hi, variant, pad;
};

DI float wave_sum(float v) {
#pragma unroll
    for (int o = 1; o < 64; o <<= 1) v += __shfl_xor(v, o);
    return v;
}
DI float wave_max(float v) {
#pragma unroll
    for (int o = 1; o < 64; o <<= 1) v = fmaxf(v, __shfl_xor(v, o));
    return v;
}

DI int wmap_row(int mat, int n) {
    if (mat == 0 || mat == 7) { const int u = n >= DFF, j = u ? n - DFF : n; return 256 * (j >> 7) + 128 * u + (j & 127); }
    if (mat == 2 && n >= 1536 && n < 2048) { const int c = n & 63, x2 = c >> 5, cc = c & 31; return (n - c) + 16 * (cc >> 3) + 8 * x2 + (cc & 7); }
    return n;
}
DI float wmap_scale(int mat, int n) {
    if (mat == 2) return (n < 512) ? 0.125f * LOG2E : ((n >= 1792 && n < 2048) ? 0.125f : 1.0f);
    if (mat == 4) return 0.0625f * LOG2E;
    if (mat == 1 || mat == 8) return 0.5f;
    return 1.0f;
}
DI void p0_transpose_item(const float* W, int K, int N, bf16_t* WT, int mat, const float* nw, LAS float* scr, int item, int lane) {
    const int nblk = N / 32, kb = item / nblk, nb = item % nblk, k0 = 64 * kb, n0 = 32 * nb;
    float wv[32];
#pragma unroll
    for (int i = 0; i < 32; ++i) wv[i] = W[(size_t)(k0 + 2 * i + (lane >> 5)) * N + n0 + (lane & 31)];
    const float s0 = nw ? nw[k0 + (lane & 31) * 2 + 0] : 1.0f, s1 = nw ? nw[k0 + (lane & 31) * 2 + 1] : 1.0f;
#pragma unroll
    for (int i = 0; i < 32; ++i) { const float sl = __shfl(s0, i), sh = __shfl(s1, i); const int kk = 2 * i + (lane >> 5); scr[kk * 33 + (lane & 31)] = wv[i] * ((lane >> 5) ? sh : sl); }
    asm volatile("s_waitcnt lgkmcnt(0)" ::: "memory");
    const int c = lane & 7;
#pragma unroll
    for (int j = 0; j < 4; ++j) { const int n = (lane >> 3) + 8 * j; const LAS float* s = scr + (8 * c) * 33 + n; const float sc = wmap_scale(mat, n0 + n);
        u32x4 o; o.x = cvt_pk_bf16(s[0 * 33] * sc, s[1 * 33] * sc); o.y = cvt_pk_bf16(s[2 * 33] * sc, s[3 * 33] * sc); o.z = cvt_pk_bf16(s[4 * 33] * sc, s[5 * 33] * sc); o.w = cvt_pk_bf16(s[6 * 33] * sc, s[7 * 33] * sc);
        *(u32x4*)(WT + (size_t)wmap_row(mat, n0 + n) * K + k0 + 8 * c) = o; }
    asm volatile("s_waitcnt lgkmcnt(0)" ::: "memory");
}
DI void rms_row_to_bf16(const float* xrow, const float* w, bf16_t* orow, int lane) {
    const f32x4* xr = (const f32x4*)xrow + lane;
    f32x4 v[4]; float s = 0.f;
#pragma unroll
    for (int j = 0; j < 4; ++j) { v[j] = xr[64 * j]; s += (v[j][0] * v[j][0] + v[j][1] * v[j][1]) + (v[j][2] * v[j][2] + v[j][3] * v[j][3]); }
    const float r = rsqrtf(wave_sum(s) * (1.f / D) + EPS);
    u32x2* o8 = (u32x2*)orow + lane;
#pragma unroll
    for (int j = 0; j < 4; ++j) { const f32x4 ww = ((const f32x4*)w)[lane + 64 * j]; u32x2 o; o.x = cvt_pk_bf16(v[j][0] * r * ww[0], v[j][1] * r * ww[1]); o.y = cvt_pk_bf16(v[j][2] * r * ww[2], v[j][3] * r * ww[3]); o8[64 * j] = o; }
}

DI void rms_row2_to_bf16(const float* xa, const float* xb, const float* w, bf16_t* oa, bf16_t* ob, int lane) {
    const f32x4* ra = (const f32x4*)xa + lane; const f32x4* rb = (const f32x4*)(xb ? xb : xa) + lane;
    f32x4 va[4], vb[4]; float sa = 0.f, sb = 0.f;
#pragma unroll
    for (int j = 0; j < 4; ++j) { va[j] = ra[64 * j]; vb[j] = rb[64 * j]; }
#pragma unroll
    for (int j = 0; j < 4; ++j) { sa += (va[j][0] * va[j][0] + va[j][1] * va[j][1]) + (va[j][2] * va[j][2] + va[j][3] * va[j][3]); sb += (vb[j][0] * vb[j][0] + vb[j][1] * vb[j][1]) + (vb[j][2] * vb[j][2] + vb[j][3] * vb[j][3]); }
    const float r0 = rsqrtf(wave_sum(sa) * (1.f / D) + EPS), r1 = rsqrtf(wave_sum(sb) * (1.f / D) + EPS);
    u32x2* pa = (u32x2*)oa + lane; u32x2* pb = (u32x2*)ob + lane;
#pragma unroll
    for (int j = 0; j < 4; ++j) { const f32x4 ww = ((const f32x4*)w)[lane + 64 * j];
        u32x2 o; o.x = cvt_pk_bf16(va[j][0] * r0 * ww[0], va[j][1] * r0 * ww[1]); o.y = cvt_pk_bf16(va[j][2] * r0 * ww[2], va[j][3] * r0 * ww[3]); pa[64 * j] = o;
        if (xb) { u32x2 p; p.x = cvt_pk_bf16(vb[j][0] * r1 * ww[0], vb[j][1] * r1 * ww[1]); p.y = cvt_pk_bf16(vb[j][2] * r1 * ww[2], vb[j][3] * r1 * ww[3]); pb[64 * j] = p; } }
}

DI void nk_dattn(const bf16_t* proj, bf16_t* omix, int gw, int ngw, int lane) {
    for (int task = gw; task < M * 8; task += ngw) {
        const int row = task >> 3, h = task & 7, t = row & (SEQ - 1), rowb = row - t;
        float q[64];
        { const u32x4* qp = (const u32x4*)(proj + (size_t)row * INC + h * 64);
#pragma unroll
          for (int c = 0; c < 8; ++c) { const u32x4 w = qp[c];
#pragma unroll
            for (int i = 0; i < 4; ++i) { q[8 * c + 2 * i] = bf2f(w[i] & 0xffffu); q[8 * c + 2 * i + 1] = bf2f(w[i] >> 16); } } }
        float og[3], lse[3];
#pragma unroll
        for (int g = 0; g < 3; ++g) {
            const int d = (g == 0) ? 1 : ((g == 1) ? 4 : 16);
            float sc[3];
#pragma unroll
            for (int i = 0; i < 3; ++i) {
                const int j = lane + 64 * i; const int pos = t - j * d;
                float s = -1e30f;
                if (j <= 128 && pos >= 0) {
                    const u32x4* kp = (const u32x4*)(proj + (size_t)(rowb + pos) * INC + 512 + h * 64);
                    float a = 0.f;
#pragma unroll
                    for (int c = 0; c < 8; ++c) { const u32x4 w = kp[c];
#pragma unroll
                        for (int ii = 0; ii < 4; ++ii) a += q[8 * c + 2 * ii] * bf2f(w[ii] & 0xffffu) + q[8 * c + 2 * ii + 1] * bf2f(w[ii] >> 16); }
                    s = a;
                }
                sc[i] = s;
            }
            const float m = wave_max(fmaxf(fmaxf(sc[0], sc[1]), sc[2]));
            float pr[3], l = 0.f;
#pragma unroll
            for (int i = 0; i < 3; ++i) { pr[i] = (sc[i] > -1e29f) ? __expf(sc[i] - m) : 0.f; l += pr[i]; }
            l = wave_sum(l);
            float acc = 0.f;
            for (int j = 0; j <= 128; ++j) {
                const int pos = t - j * d; if (pos < 0) break;
                const float pj = __shfl(j < 64 ? pr[0] : (j < 128 ? pr[1] : pr[2]), j & 63);
                acc += pj * bf2f(proj[(size_t)(rowb + pos) * INC + 1024 + h * 64 + lane]);
            }
            og[g] = acc / l; lse[g] = m + __logf(l);
        }
        const float mm = fmaxf(fmaxf(lse[0], lse[1]), lse[2]);
        const float w0 = __expf(lse[0] - mm), w1 = __expf(lse[1] - mm), w2 = __expf(lse[2] - mm);
        const float o = (w0 * og[0] + w1 * og[1] + w2 * og[2]) / (w0 + w1 + w2);
        omix[(size_t)row * D + h * 64 + lane] = (bf16_t)(cvt_pk_bf16(o, 0.f) & 0xffffu);
    }
}
DI void nk_ret(const bf16_t* proj, float* raw, int grp, int e) {
    const int b = grp >> 2, h = grp & 3;
    const float gamma = 1.0f - exp2f(-5.0f - (float)h);
    float R[64];
#pragma unroll
    for (int d = 0; d < 64; ++d) R[d] = 0.f;
    for (int t = 0; t < SEQ; ++t) {
        const bf16_t* p = proj + (size_t)(b * SEQ + t) * INC;
        const float v = bf2f(p[2048 + h * 128 + e]);
        const u32x4* qp = (const u32x4*)(p + 1536 + h * 64); const u32x4* kp = (const u32x4*)(p + 1792 + h * 64);
        float o = 0.f;
#pragma unroll
        for (int c = 0; c < 8; ++c) { const u32x4 qw = qp[c], kw = kp[c];
#pragma unroll
            for (int i = 0; i < 4; ++i) {
                R[8 * c + 2 * i] = gamma * R[8 * c + 2 * i] + bf2f(kw[i] & 0xffffu) * v; o += bf2f(qw[i] & 0xffffu) * R[8 * c + 2 * i];
                R[8 * c + 2 * i + 1] = gamma * R[8 * c + 2 * i + 1] + bf2f(kw[i] >> 16) * v; o += bf2f(qw[i] >> 16) * R[8 * c + 2 * i + 1]; } }
        raw[(size_t)(b * SEQ + t) * 512 + h * 128 + e] = o;
    }
}
DI void nk_retnorm(const float* raw, const bf16_t* proj, bf16_t* omix, int gw, int ngw, int lane) {
    for (int task = gw; task < M * 4; task += ngw) {
        const int row = task >> 2, h = task & 3;
        const float a = raw[(size_t)row * 512 + h * 128 + lane], b = raw[(size_t)row * 512 + h * 128 + 64 + lane];
        const float r = rsqrtf(wave_sum(a * a + b * b) * (1.0f / 128.0f) + EPS);
        const float g0 = bf2f(proj[(size_t)row * INC + 2560 + h * 128 + lane]), g1 = bf2f(proj[(size_t)row * INC + 2560 + h * 128 + 64 + lane]);
        omix[(size_t)row * D + 512 + h * 128 + lane] = (bf16_t)(cvt_pk_bf16(silu_f(g0) * a * r, 0.f) & 0xffffu);
        omix[(size_t)row * D + 512 + h * 128 + 64 + lane] = (bf16_t)(cvt_pk_bf16(silu_f(g1) * b * r, 0.f) & 0xffffu);
    }
}
DI void nk_xattn(const bf16_t* qc, const bf16_t* kc, const bf16_t* vt, bf16_t* oc, int gw, int ngw, int lane) {
    for (int task = gw; task < M * 4; task += ngw) {
        const int row = task >> 2, h = task & 3, b = row / SEQ;
        float sc[4] = {0.f, 0.f, 0.f, 0.f};
        const u32x4* qp = (const u32x4*)(qc + (size_t)row * D + h * 256);
        for (int c = 0; c < 32; ++c) {
            const u32x4 qw = qp[c];
#pragma unroll
            for (int i = 0; i < 4; ++i) { const u32x4 kw = *(const u32x4*)(kc + (size_t)(b * MEMLEN + lane + 64 * i) * D + h * 256 + 8 * c);
#pragma unroll
                for (int ii = 0; ii < 4; ++ii) sc[i] += bf2f(qw[ii] & 0xffffu) * bf2f(kw[ii] & 0xffffu) + bf2f(qw[ii] >> 16) * bf2f(kw[ii] >> 16); }
        }
        const float m = wave_max(fmaxf(fmaxf(sc[0], sc[1]), fmaxf(sc[2], sc[3])));
        float l = 0.f;
#pragma unroll
        for (int i = 0; i < 4; ++i) { sc[i] = __expf(sc[i] - m); l += sc[i]; }
        l = wave_sum(l);
        float acc[4] = {0.f, 0.f, 0.f, 0.f};
#pragma unroll
        for (int i = 0; i < 4; ++i)
            for (int j = 0; j < 64; j += 8) {
                float p[8];
#pragma unroll
                for (int jj = 0; jj < 8; ++jj) p[jj] = __shfl(sc[i], j + jj);
#pragma unroll
                for (int dd = 0; dd < 4; ++dd) { const u32x4 vw = *(const u32x4*)(vt + (size_t)(h * 256 + 4 * lane + dd) * MROWS + b * MEMLEN + 64 * i + j);
#pragma unroll
                    for (int ii = 0; ii < 4; ++ii) acc[dd] += p[2 * ii] * bf2f(vw[ii] & 0xffffu) + p[2 * ii + 1] * bf2f(vw[ii] >> 16); }
            }
        const float il = 1.0f / l;
        u32x2 o; o.x = cvt_pk_bf16(acc[0] * il, acc[1] * il); o.y = cvt_pk_bf16(acc[2] * il, acc[3] * il);
        *(u32x2*)(oc + (size_t)row * D + h * 256 + 4 * lane) = o;
    }
}


namespace da {
typedef float f32x16 __attribute__((ext_vector_type(16)));
typedef short s16x4 __attribute__((ext_vector_type(4)));
typedef __bf16 bf16x2_t __attribute__((ext_vector_type(2)));
constexpr int K_OFF = 0, V_OFF = 49152, V_D0 = 24640, OST_OFF = V_OFF + V_D0 + 24576;
static_assert(OST_OFF + 8 * 4096 <= MISC_OFF, "attention LDS map");
DI int crow(int r, int hi) { return (r & 3) + 8 * (r >> 2) + 4 * hi; }
DI unsigned cvtpk(float lo, float hi) { f32x2 v = {lo, hi}; bf16x2_t b = __builtin_convertvector(v, bf16x2_t); return __builtin_bit_cast(unsigned, b); }
DI s16x4 vtr(LAS unsigned char* p) { return __builtin_bit_cast(s16x4, __builtin_amdgcn_ds_read_tr16_b64_v4i16((LAS s16x4*)p)); }
struct Dec { int b, h, g, d, r, blk; };
DI Dec decode(int uid) { Dec u; const int u32i = uid & 31, ghb = uid >> 5; u.g = ghb % 3; const int bh = ghb / 3; u.h = bh & 7; u.b = bh >> 3;
    u.d = (u.g == 0) ? 1 : ((u.g == 1) ? 4 : 16); const int nblk = 32 / u.d; u.blk = u32i % nblk; u.r = u32i / nblk; return u; }
struct Regs { u32x4 k[6], v[6], q[4]; };
DI void load_regs(Regs& R, const Dec& u, const bf16_t* proj, int tid) {
    const int lane = tid & 63, w = tid >> 6;
#pragma unroll
    for (int i = 0; i < 6; ++i) { const int id = tid + 512 * i, uk = id >> 3, c = id & 7; int sk = 256 * u.blk - 128 + uk; sk = sk < 0 ? 0 : sk;
        const size_t ro = hm_off(0, 8, 64, u.b, u.h, sk * u.d + u.r) + 8 * c;
        R.k[i] = *(const u32x4*)(proj + (size_t)SEQ * 512 + ro); R.v[i] = *(const u32x4*)(proj + (size_t)SEQ * 1024 + ro); }
    const int s = 256 * u.blk + 32 * w + (lane & 31);
    const bf16_t* qp = proj + hm_off(0, 8, 64, u.b, u.h, s * u.d + u.r) + 8 * (lane >> 5);
#pragma unroll
    for (int ks = 0; ks < 4; ++ks) R.q[ks] = *(const u32x4*)(qp + 16 * ks);
}
DI void write_lds(const Regs& R, const Dec& u, LAS unsigned char* lds, int tid) {
#pragma unroll
    for (int i = 0; i < 6; ++i) { const int id = tid + 512 * i, uk = id >> 3, c = id & 7; const bool valid = (u.blk > 0) || (uk >= 128);
        const u32x4 z = {0u, 0u, 0u, 0u};
        *(LAS u32x4*)(lds + K_OFF + 128 * uk + 16 * (c ^ ((uk >> 1) & 7))) = valid ? R.k[i] : z;
        *(LAS u32x4*)(lds + V_OFF + (c >> 2) * V_D0 + 64 * uk + 16 * (c & 3)) = valid ? R.v[i] : z; }
}
DI void qk_part(f32x16 (&S)[5], const Regs& R, LAS unsigned char* lds, int tid) {
    const int lane = tid & 63, w = __builtin_amdgcn_readfirstlane(tid >> 6), q = lane & 31, hi = lane >> 5;
#pragma unroll
    for (int j = 0; j < 5; ++j) {
        const int uk = 32 * (w + j) + q;
        f32x16 acc;
#pragma unroll
        for (int r = 0; r < 16; ++r) acc[r] = 0.f;
#pragma unroll
        for (int ks = 0; ks < 4; ++ks) { const bf16x8 kf = *(const LAS bf16x8*)(lds + K_OFF + 128 * uk + 16 * ((2 * ks + hi) ^ ((uk >> 1) & 7)));
            acc = __builtin_amdgcn_mfma_f32_32x32x16_bf16(kf, __builtin_bit_cast(bf16x8, R.q[ks]), acc, 0, 0, 0); }
        S[j] = acc;
    }
}
DI void softmax_part(f32x16 (&S)[5], u32x4 (&Pk)[5][2], float& m_out, float& l_out, const Dec& u, int tid) {
    const int lane = tid & 63, w = __builtin_amdgcn_readfirstlane(tid >> 6), q = lane & 31, hi = lane >> 5;
    float m = -1e30f;
#pragma unroll
    for (int r = 0; r < 16; ++r) { const int kk = crow(r, hi); if (kk < q) S[0][r] = -1e30f; if (kk > q) S[4][r] = -1e30f; }
    if (u.blk == 0) {
#pragma unroll
        for (int j = 0; j < 4; ++j) if (w + j < 4) {
#pragma unroll
            for (int r = 0; r < 16; ++r) S[j][r] = -1e30f; }
    }
#pragma unroll
    for (int j = 0; j < 5; ++j)
#pragma unroll
        for (int r = 0; r < 16; ++r) m = fmaxf(m, S[j][r]);
    m = fmaxf(m, __shfl_xor(m, 32));
    float l = 0.f;
#pragma unroll
    for (int j = 0; j < 5; ++j) {
#pragma unroll
        for (int r = 0; r < 16; ++r) { const float p = fast_exp2(S[j][r] - m); S[j][r] = p; l += p; }
#pragma unroll
        for (int s2 = 0; s2 < 2; ++s2) { u32x4 pw; pw.x = cvtpk(S[j][8 * s2 + 0], S[j][8 * s2 + 1]); pw.y = cvtpk(S[j][8 * s2 + 2], S[j][8 * s2 + 3]); pw.z = cvtpk(S[j][8 * s2 + 4], S[j][8 * s2 + 5]); pw.w = cvtpk(S[j][8 * s2 + 6], S[j][8 * s2 + 7]); Pk[j][s2] = pw; }
    }
    l += __shfl_xor(l, 32);
    m_out = m; l_out = l;
}
DI void pv_part(const u32x4 (&Pk)[5][2], float m, float l, const Dec& u, LAS unsigned char* lds, bf16_t* part, float* lsep, int tid) {
    const int lane = tid & 63, w = __builtin_amdgcn_readfirstlane(tid >> 6), q = lane & 31, hi = lane >> 5;
    f32x16 o[2];
#pragma unroll
    for (int r = 0; r < 16; ++r) { o[0][r] = 0.f; o[1][r] = 0.f; }
    const int vlane = ((lane >> 4) & 1) * 32 + (lane & 3) * 8 + (4 * hi + ((lane & 15) >> 2)) * 64;
#pragma unroll
    for (int j = 0; j < 5; ++j)
#pragma unroll
        for (int s2 = 0; s2 < 2; ++s2) {
            const bf16x8 pa = __builtin_bit_cast(bf16x8, Pk[j][s2]);
#pragma unroll
            for (int d0 = 0; d0 < 2; ++d0) { LAS unsigned char* vp = lds + V_OFF + d0 * V_D0 + (32 * (w + j) + 16 * s2) * 64 + vlane;
                const s16x4 lo = vtr(vp), hi4 = vtr(vp + 512);
                const bf16x8 vf = {lo[0], lo[1], lo[2], lo[3], hi4[0], hi4[1], hi4[2], hi4[3]};
                o[d0] = __builtin_amdgcn_mfma_f32_32x32x16_bf16(pa, vf, o[d0], 0, 0, 0); }
        }
    const float linv = fast_rcp(l);
    LAS bf16_t* stg = (LAS bf16_t*)(lds + OST_OFF + w * 4096);
#pragma unroll
    for (int r = 0; r < 16; ++r) { const int orow = crow(r, hi); const float li = __shfl(linv, orow);
#pragma unroll
        for (int d0 = 0; d0 < 2; ++d0) stg[orow * 64 + d0 * 32 + q] = (bf16_t)(cvtpk(o[d0][r] * li, 0.f) & 0xffffu); }
    asm volatile("s_waitcnt lgkmcnt(0)" ::: "memory");
    const int s0 = 256 * u.blk + 32 * w;
#pragma unroll
    for (int i = 0; i < 4; ++i) { const int row = i * 8 + (lane >> 3), ch = lane & 7; const u32x4 v = *(const LAS u32x4*)(stg + row * 64 + ch * 8);
        *(u32x4*)(part + (size_t)(u.b * SEQ + (s0 + row) * u.d + u.r) * 512 + u.h * 64 + ch * 8) = v; }
    if (hi == 0) lsep[(size_t)(u.b * SEQ + (s0 + q) * u.d + u.r) * 8 + u.h] = m + __log2f(l);
}
struct UnitMap { int x, j, GX, NP, per, n, nk;
    DI void init(int x_, int j_, int GX_, int npairs, int nk_) { x = x_; j = j_; GX = GX_; NP = npairs; nk = (nk_ > 0 && GX_ == 32 && nk_ == 8) ? nk_ : 0; per = nk ? 4 : (96 + GX - 1) / GX; n = NP * per; }
    DI int uid(int i) const { const int p = i / per, s = i % per; int k;
        if (nk) { if (s < 3) k = (p == 0 && j < nk) ? 96 : 3 * j + s; else k = (p == 0 && j >= nk) ? j - nk : 96; }
        else k = j * per + s;
        return (k < 96) ? (x * NP + p) * 96 + k : -1; } };
DI void phase(LAS unsigned char* lds, const bf16_t* proj, bf16_t* attp, float* lse, const UnitMap& U) {
    int i = 0; while (i < U.n && U.uid(i) < 0) ++i;
    if (i >= U.n) return;
    Regs R; Dec cur = decode(U.uid(i));
    load_regs(R, cur, proj, otid());
    while (i < U.n) {
        int in = i + 1; while (in < U.n && U.uid(in) < 0) ++in;
        write_lds(R, cur, lds, otid());
        Regs Qc;
#pragma unroll
        for (int k = 0; k < 4; ++k) Qc.q[k] = R.q[k];
        __syncthreads();
        Dec nxt = cur;
        if (in < U.n) { nxt = decode(U.uid(in)); load_regs(R, nxt, proj, otid()); }
        u32x4 Pk[5][2]; float m, l;
        {   f32x16 S[5];
            qk_part(S, Qc, lds, otid());
            softmax_part(S, Pk, m, l, cur, otid()); }
        pv_part(Pk, m, l, cur, lds, attp + (size_t)cur.g * M * 512, lse + (size_t)cur.g * M * 8, otid());
        __syncthreads();
        cur = nxt; i = in;
    }
}
DI void merge(const bf16_t* attp, const float* lse, bf16_t* omix, int row_lo, int nrows, int gtid, int ngt) {
    for (int i = gtid; i < nrows * 64; i += ngt) {
        const int row = row_lo + (i >> 6), h = (i >> 3) & 7, c = i & 7;
        const float l0 = lse[(size_t)row * 8 + h], l1 = lse[(size_t)M * 8 + (size_t)row * 8 + h], l2 = lse[(size_t)2 * M * 8 + (size_t)row * 8 + h];
        const float mm = fmaxf(fmaxf(l0, l1), l2);
        float w0 = fast_exp2(l0 - mm), w1 = fast_exp2(l1 - mm), w2 = fast_exp2(l2 - mm);
        const float inv = fast_rcp(w0 + w1 + w2); w0 *= inv; w1 *= inv; w2 *= inv;
        const size_t off = (size_t)row * 512 + h * 64 + c * 8;
        const u32x4 a = *(const u32x4*)(attp + off), b = *(const u32x4*)(attp + (size_t)M * 512 + off), cc = *(const u32x4*)(attp + (size_t)2 * M * 512 + off);
        u32x4 o;
#pragma unroll
        for (int k = 0; k < 4; ++k) { const float lo = w0 * bf2f(a[k] & 0xffffu) + w1 * bf2f(b[k] & 0xffffu) + w2 * bf2f(cc[k] & 0xffffu);
            const float hi = w0 * bf2f(a[k] >> 16) + w1 * bf2f(b[k] >> 16) + w2 * bf2f(cc[k] >> 16); o[k] = cvt_pk_bf16(lo, hi); }
        *(u32x4*)(omix + (size_t)row * D + h * 64 + c * 8) = o;
    }
}
}


namespace xa {
using da::f32x16; using da::s16x4; using da::crow; using da::cvtpk; using da::vtr;
constexpr int KB = 0, VB = 65536, VB_STRIDE = 32832, V_D0 = 16384 + 64, OST = 32768;
static_assert(VB + 2 * VB_STRIDE <= MISC_OFF, "cross-attention LDS map");
struct St { u32x4 sr[2][4]; u32x4 q[4]; };
DI void dec(int uid, int& b, int& h, int& qblk) { qblk = uid & 31; h = (uid >> 5) & 3; b = uid >> 7; }
DI const bf16_t* q_ptr(int i, int u_lo, const bf16_t* qc, int tid) { int b, h, qblk; dec(u_lo + (i >> 3), b, h, qblk); const int lane = tid & 63, w = tid >> 6;
    return qc + (size_t)(b * SEQ + 256 * qblk + 32 * w + (lane & 31)) * INC + h * 256 + 64 * (i & 7) + 8 * (lane >> 5); }
template <int PAR> DI void stage_load(St& T, int i, int total, int u_lo, const bf16_t* kvc, int tid) {
    if (i >= total) return;
    const int st = i & 7; int b, h, qblk; dec(u_lo + (i >> 3), b, h, qblk);
    const int coff = (st < 4) ? (h * 256 + 64 * st) : (1024 + h * 256 + 64 * (st - 4));
#pragma unroll
    for (int k = 0; k < 4; ++k) { const int id = tid + 512 * k, m = id >> 3, ch = id & 7; T.sr[PAR][k] = *(const u32x4*)(kvc + (size_t)(b * MEMLEN + m) * 2048 + coff + 8 * ch); }
}
template <int PAR> DI void stage_write(const St& T, int i, int total, LAS unsigned char* lds, int tid) {
    if (i >= total) return;
    const int st = i & 7;
    if (st < 4) {
#pragma unroll
        for (int k = 0; k < 4; ++k) { const int id = tid + 512 * k, m = id >> 3, ch = id & 7; *(LAS u32x4*)(lds + KB + (st & 1) * 32768 + 128 * m + 16 * (ch ^ ((m >> 1) & 7))) = T.sr[PAR][k]; }
    } else {
#pragma unroll
        for (int k = 0; k < 4; ++k) { const int id = tid + 512 * k, m = id >> 3, ch = id & 7; *(LAS u32x4*)(lds + VB + (st & 1) * VB_STRIDE + (ch >> 2) * V_D0 + 64 * m + 16 * (ch & 3)) = T.sr[PAR][k]; }
    }
}
template <int st> DI void k_stage(St& T, f32x16 (&S)[8], int i, int u_lo, LAS unsigned char* lds, const bf16_t* qc, int tid) {
    const int lane = tid & 63, q = lane & 31, hi = lane >> 5;
    LAS unsigned char* kb = lds + KB + (st & 1) * 32768;
    const bf16_t* qn = q_ptr(i + 1, u_lo, qc, tid);
#pragma unroll
    for (int ks = 0; ks < 4; ++ks) { const bf16x8 qf = __builtin_bit_cast(bf16x8, T.q[ks]);
#pragma unroll
        for (int kt = 0; kt < 8; ++kt) { const int uk = 32 * kt + q;
            const bf16x8 kf = *(const LAS bf16x8*)(kb + 128 * uk + 16 * ((2 * ks + hi) ^ ((uk >> 1) & 7)));
            S[kt] = __builtin_amdgcn_mfma_f32_32x32x16_bf16(kf, qf, S[kt], 0, 0, 0); }
        if (st < 3) T.q[ks] = *(const u32x4*)(qn + 16 * ks); }
}
DI void softmax(f32x16 (&S)[8], u32x4 (&Pk)[8][2], float& linv) {
    float m = -1e30f;
#pragma unroll
    for (int kt = 0; kt < 8; ++kt)
#pragma unroll
        for (int r = 0; r < 16; ++r) m = fmaxf(m, S[kt][r]);
    m = fmaxf(m, __shfl_xor(m, 32));
    float l = 0.f;
#pragma unroll
    for (int kt = 0; kt < 8; ++kt) {
#pragma unroll
        for (int r = 0; r < 16; ++r) { const float p = fast_exp2(S[kt][r] - m); S[kt][r] = p; l += p; }
#pragma unroll
        for (int s2 = 0; s2 < 2; ++s2) { u32x4 pw; pw.x = cvtpk(S[kt][8 * s2 + 0], S[kt][8 * s2 + 1]); pw.y = cvtpk(S[kt][8 * s2 + 2], S[kt][8 * s2 + 3]); pw.z = cvtpk(S[kt][8 * s2 + 4], S[kt][8 * s2 + 5]); pw.w = cvtpk(S[kt][8 * s2 + 6], S[kt][8 * s2 + 7]); Pk[kt][s2] = pw; }
    }
    l += __shfl_xor(l, 32);
    linv = fast_rcp(l);
}
template <int st> DI void v_stage(St& T, const u32x4 (&Pk)[8][2], float linv, int i, int total, int u_lo, LAS unsigned char* lds, const bf16_t* qc, bf16_t* oc, int tid) {
    const int lane = tid & 63, w = __builtin_amdgcn_readfirstlane(tid >> 6), q = lane & 31, hi = lane >> 5;
    const int vc = st - 4; int b, h, qblk; dec(u_lo + (i >> 3), b, h, qblk);
    if (st == 7 && i + 1 < total) { const bf16_t* qn = q_ptr(i + 1, u_lo, qc, tid);
#pragma unroll
        for (int ks = 0; ks < 4; ++ks) T.q[ks] = *(const u32x4*)(qn + 16 * ks); }
    LAS unsigned char* vb = lds + VB + (st & 1) * VB_STRIDE;
    const int vlane = ((lane >> 4) & 1) * 32 + (lane & 3) * 8 + (4 * hi + ((lane & 15) >> 2)) * 64;
    f32x16 o[2];
#pragma unroll
    for (int r = 0; r < 16; ++r) { o[0][r] = 0.f; o[1][r] = 0.f; }
#pragma unroll
    for (int kt = 0; kt < 8; ++kt)
#pragma unroll
        for (int s2 = 0; s2 < 2; ++s2) { const bf16x8 pa = __builtin_bit_cast(bf16x8, Pk[kt][s2]);
#pragma unroll
            for (int d0 = 0; d0 < 2; ++d0) { LAS unsigned char* vp = vb + d0 * V_D0 + (32 * kt + 16 * s2) * 64 + vlane;
                const s16x4 lo = vtr(vp), hi4 = vtr(vp + 512);
                const bf16x8 vf = {lo[0], lo[1], lo[2], lo[3], hi4[0], hi4[1], hi4[2], hi4[3]};
                o[d0] = __builtin_amdgcn_mfma_f32_32x32x16_bf16(pa, vf, o[d0], 0, 0, 0); } }
    LAS bf16_t* stg = (LAS bf16_t*)(lds + OST + w * 4096);
#pragma unroll
    for (int r = 0; r < 16; ++r) { const int orow = crow(r, hi); const float li = __shfl(linv, orow);
#pragma unroll
        for (int d0 = 0; d0 < 2; ++d0) stg[orow * 64 + d0 * 32 + q] = (bf16_t)(cvtpk(o[d0][r] * li, 0.f) & 0xffffu); }
    asm volatile("s_waitcnt lgkmcnt(0)" ::: "memory");
#pragma unroll
    for (int k = 0; k < 4; ++k) { const int row = k * 8 + (lane >> 3), ch = lane & 7; const u32x4 v = *(const LAS u32x4*)(stg + row * 64 + ch * 8);
        *(u32x4*)(oc + (size_t)(b * SEQ + 256 * qblk + 32 * w + row) * D + h * 256 + 64 * vc + ch * 8) = v; }
}
DI void phase(LAS unsigned char* lds, const bf16_t* qc, const bf16_t* kvc, bf16_t* oc, int u_lo, int u_hi, int) {
    if (u_lo >= u_hi) return;
    const int total = 8 * (u_hi - u_lo);
    St T;
    { const bf16_t* q0 = q_ptr(0, u_lo, qc, otid());
#pragma unroll
      for (int ks = 0; ks < 4; ++ks) T.q[ks] = *(const u32x4*)(q0 + 16 * ks); }
    stage_load<0>(T, 0, total, u_lo, kvc, otid()); stage_write<0>(T, 0, total, lds, otid()); stage_load<1>(T, 1, total, u_lo, kvc, otid()); stage_load<0>(T, 2, total, u_lo, kvc, otid());
    __syncthreads();
    for (int i0 = 0; i0 < total; i0 += 8) {
        u32x4 Pk[8][2]; float linv;
        {   f32x16 S[8];
#pragma unroll
            for (int kt = 0; kt < 8; ++kt)
#pragma unroll
                for (int r = 0; r < 16; ++r) S[kt][r] = 0.f;
#define XA_NEXT(i, P1) do { stage_write<P1>(T, (i) + 1, total, lds, otid()); stage_load<P1>(T, (i) + 3, total, u_lo, kvc, otid()); __syncthreads(); } while (0)
            k_stage<0>(T, S, i0 + 0, u_lo, lds, qc, otid()); XA_NEXT(i0 + 0, 1);
            k_stage<1>(T, S, i0 + 1, u_lo, lds, qc, otid()); XA_NEXT(i0 + 1, 0);
            k_stage<2>(T, S, i0 + 2, u_lo, lds, qc, otid()); XA_NEXT(i0 + 2, 1);
            k_stage<3>(T, S, i0 + 3, u_lo, lds, qc, otid()); XA_NEXT(i0 + 3, 0);
            softmax(S, Pk, linv);
        }
        v_stage<4>(T, Pk, linv, i0 + 4, total, u_lo, lds, qc, oc, otid()); XA_NEXT(i0 + 4, 1);
        v_stage<5>(T, Pk, linv, i0 + 5, total, u_lo, lds, qc, oc, otid()); XA_NEXT(i0 + 5, 0);
        v_stage<6>(T, Pk, linv, i0 + 6, total, u_lo, lds, qc, oc, otid()); XA_NEXT(i0 + 6, 1);
        v_stage<7>(T, Pk, linv, i0 + 7, total, u_lo, lds, qc, oc, otid()); XA_NEXT(i0 + 7, 0);
#undef XA_NEXT
    }
}
}


namespace rt {
using da::f32x16; using da::s16x4; using da::crow; using da::cvtpk; using da::vtr;
constexpr int VS = 8256, RS = 4160;
constexpr int KV_K = 0, KV_V = 2 * VS;
constexpr int O_K = 0, O_V = 16384, O_R = O_V + 4 * VS, O_END = O_R + 4 * RS, O_ST = O_END, O_LD = 132;
static_assert(O_ST + 128 * O_LD * 4 <= MISC_OFF, "retention LDS map");
DI float log2_gamma(int h) { return __log2f(1.0f - exp2f(-5.0f - (float)h)); }
DI void dec(int uid, int& b, int& h, int& n) { n = uid & 63; h = (uid >> 6) & 3; b = uid >> 8; }
DI size_t ret_off(int b, int n, int h) { return ((size_t)(b * 64 + n) * 4 + h) * 8192; }
DI bf16x8 tr_nat(LAS unsigned char* tile, int ks, int lane) { const int hi = lane >> 5;
    LAS unsigned char* p = tile + (16 * ks + 8 * hi + ((lane & 15) >> 2)) * 64 + ((lane >> 4) & 1) * 32 + (lane & 3) * 8;
    const s16x4 lo = vtr(p), h4 = vtr(p + 256); return (bf16x8){lo[0], lo[1], lo[2], lo[3], h4[0], h4[1], h4[2], h4[3]}; }
DI bf16x8 tr_perm(LAS unsigned char* tile, int rowbase, int lane) { const int hi = lane >> 5;
    LAS unsigned char* p = tile + (rowbase + 4 * hi + ((lane & 15) >> 2)) * 64 + ((lane >> 4) & 1) * 32 + (lane & 3) * 8;
    const s16x4 lo = vtr(p), h4 = vtr(p + 512); return (bf16x8){lo[0], lo[1], lo[2], lo[3], h4[0], h4[1], h4[2], h4[3]}; }
struct KvRegs { u32x4 k[2], v[4]; };
DI void kv_load(KvRegs& G, int uid, const bf16_t* proj, int tid) {
    int b, h, n; dec(uid, b, h, n);
    const bf16_t* kb = proj + hm_off(1792, 4, 64, b, h, 128 * n); const bf16_t* vb = proj + hm_off(2048, 4, 128, b, h, 128 * n);
#pragma unroll
    for (int i = 0; i < 2; ++i) G.k[i] = *(const u32x4*)(kb + 8 * (tid + 512 * i));
#pragma unroll
    for (int i = 0; i < 4; ++i) G.v[i] = *(const u32x4*)(vb + 8 * (tid + 512 * i));
}
DI void kv_phase(LAS unsigned char* lds, const bf16_t* proj, float* ret, int u_lo, int u_hi) {
    if (u_lo >= u_hi) return;
    KvRegs G; kv_load(G, u_lo, proj, otid());
    for (int uid = u_lo; uid < u_hi; ++uid) {
        const int tid = otid(), lane = tid & 63, w = __builtin_amdgcn_readfirstlane(tid >> 6);
        int b, h, n; dec(uid, b, h, n);
        const float lg = log2_gamma(h);
#pragma unroll
        for (int i = 0; i < 2; ++i) { const int id = tid + 512 * i, tok = id >> 3, ch = id & 7; const float dk = fast_exp2(lg * (float)(127 - tok)); u32x4 o;
#pragma unroll
            for (int k = 0; k < 4; ++k) o[k] = cvt_pk_bf16(bf2f(G.k[i][k] & 0xffffu) * dk, bf2f(G.k[i][k] >> 16) * dk);
            *(LAS u32x4*)(lds + KV_K + (ch >> 2) * VS + tok * 64 + (ch & 3) * 16) = o; }
#pragma unroll
        for (int i = 0; i < 4; ++i) { const int id = tid + 512 * i, tok = id >> 4, ch = id & 15; *(LAS u32x4*)(lds + KV_V + (ch >> 2) * VS + tok * 64 + (ch & 3) * 16) = G.v[i]; }
        __syncthreads();
        if (uid + 1 < u_hi) kv_load(G, uid + 1, proj, otid());
        const int dt = w >> 2, et = w & 3;
        f32x16 acc;
#pragma unroll
        for (int r = 0; r < 16; ++r) acc[r] = 0.f;
#pragma unroll
        for (int ks = 0; ks < 8; ++ks) { const bf16x8 a = tr_nat(lds + KV_K + dt * VS, ks, lane), bb = tr_nat(lds + KV_V + et * VS, ks, lane);
            acc = __builtin_amdgcn_mfma_f32_32x32x16_bf16(a, bb, acc, 0, 0, 0); }
        float* o = ret + ret_off(b, n, h) + (size_t)(32 * dt) * 128 + 32 * et + (lane & 31);
#pragma unroll
        for (int r = 0; r < 16; ++r) o[(size_t)crow(r, lane >> 5) * 128] = acc[r];
        __syncthreads();
    }
}
DI void scan(float* ret, int b0, int nb, int gtid, int ngt) {
    for (int e = gtid; e < nb * 4 * 8192; e += ngt) {
        const int de = e & 8191, h = (e >> 13) & 3, b = b0 + (e >> 15);
        const float cd = fast_exp2(128.0f * log2_gamma(h));
        float R = 0.f;
        for (int n0 = 0; n0 < 64; n0 += 8) { float t[8];
#pragma unroll
            for (int k = 0; k < 8; ++k) t[k] = ret[ret_off(b, n0 + k, h) + de];
#pragma unroll
            for (int k = 0; k < 8; ++k) { ret[ret_off(b, n0 + k, h) + de] = R; R = cd * R + t[k]; } }
    }
}
struct ORegs { u32x4 k[2], v[4], q[4]; f32x4 r[4]; };
DI void out_load(ORegs& G, int uid, const bf16_t* proj, const float* ret, int tid) {
    int b, h, n; dec(uid, b, h, n);
    const int lane = tid & 63, w = tid >> 6;
    const bf16_t* kb = proj + hm_off(1792, 4, 64, b, h, 128 * n); const bf16_t* vb = proj + hm_off(2048, 4, 128, b, h, 128 * n); const bf16_t* qb = proj + hm_off(1536, 4, 64, b, h, 128 * n);
#pragma unroll
    for (int i = 0; i < 2; ++i) G.k[i] = *(const u32x4*)(kb + 8 * (tid + 512 * i));
#pragma unroll
    for (int i = 0; i < 4; ++i) G.v[i] = *(const u32x4*)(vb + 8 * (tid + 512 * i));
    const float* rp = ret + ret_off(b, n, h);
#pragma unroll
    for (int i = 0; i < 4; ++i) G.r[i] = *(const f32x4*)(rp + 4 * (tid + 512 * i));
    const bf16_t* qp = qb + (size_t)(32 * (w >> 1) + (lane & 31)) * 64 + 8 * (lane >> 5);
#pragma unroll
    for (int ks = 0; ks < 4; ++ks) G.q[ks] = *(const u32x4*)(qp + 16 * ks);
}
DI void out_write(const ORegs& G, int uid, LAS unsigned char* lds, int tid) {
    const int h = (uid >> 6) & 3; const float gam = 1.0f - exp2f(-5.0f - (float)h);
#pragma unroll
    for (int i = 0; i < 2; ++i) { const int id = tid + 512 * i, tok = id >> 3, ch = id & 7; *(LAS u32x4*)(lds + O_K + 128 * tok + 16 * (ch ^ ((tok >> 1) & 7))) = G.k[i]; }
#pragma unroll
    for (int i = 0; i < 4; ++i) { const int id = tid + 512 * i, tok = id >> 4, ch = id & 15; *(LAS u32x4*)(lds + O_V + (ch >> 2) * VS + tok * 64 + (ch & 3) * 16) = G.v[i]; }
#pragma unroll
    for (int i = 0; i < 4; ++i) { const int id = tid + 512 * i, d = id >> 5, e = 4 * (id & 31); u32x2 o; o.x = cvt_pk_bf16(G.r[i][0] * gam, G.r[i][1] * gam); o.y = cvt_pk_bf16(G.r[i][2] * gam, G.r[i][3] * gam);
        *(LAS u32x2*)(lds + O_R + (e >> 5) * RS + d * 64 + (e & 31) * 2) = o; }
}
DI void out_phase(LAS unsigned char* lds, const bf16_t* proj, const float* ret, bf16_t* omix, int u_lo, int u_hi, int) {
    if (u_lo >= u_hi) return;
    ORegs G; out_load(G, u_lo, proj, ret, otid());
    for (int uid = u_lo; uid < u_hi; ++uid) {
        const int tid = otid(), lane = tid & 63, w = __builtin_amdgcn_readfirstlane(tid >> 6), q = lane & 31, hi = lane >> 5;
        const int qt = w >> 1, eh = w & 1;
        int b, h, n; dec(uid, b, h, n);
        const float lg = log2_gamma(h);
        const size_t row0 = (size_t)b * SEQ + 128 * n;
        out_write(G, uid, lds, tid);
        bf16x8 qr[4];
#pragma unroll
        for (int ks = 0; ks < 4; ++ks) qr[ks] = __builtin_bit_cast(bf16x8, G.q[ks]);
        __syncthreads();
        if (uid + 1 < u_hi) out_load(G, uid + 1, proj, ret, otid());
        f32x16 o[2];
#pragma unroll
        for (int r = 0; r < 16; ++r) { o[0][r] = 0.f; o[1][r] = 0.f; }
#pragma unroll
        for (int ks = 0; ks < 4; ++ks)
#pragma unroll
            for (int t = 0; t < 2; ++t) { const bf16x8 rf = tr_nat(lds + O_R + (2 * eh + t) * RS, ks, lane); o[t] = __builtin_amdgcn_mfma_f32_32x32x16_bf16(qr[ks], rf, o[t], 0, 0, 0); }
#pragma unroll
        for (int kt = 0; kt < 4; ++kt) if (kt <= qt) {
            const int uk = 32 * kt + q;
            f32x16 s;
#pragma unroll
            for (int r = 0; r < 16; ++r) s[r] = 0.f;
#pragma unroll
            for (int ks = 0; ks < 4; ++ks) { const bf16x8 kf = *(const LAS bf16x8*)(lds + O_K + 128 * uk + 16 * ((2 * ks + hi) ^ ((uk >> 1) & 7)));
                s = __builtin_amdgcn_mfma_f32_32x32x16_bf16(kf, qr[ks], s, 0, 0, 0); }
#pragma unroll
            for (int r = 0; r < 16; ++r) { const int kk = 32 * kt + crow(r, hi), qq = 32 * qt + q; s[r] = (kk <= qq) ? s[r] * fast_exp2(-lg * (float)kk) : 0.f; }
#pragma unroll
            for (int s2 = 0; s2 < 2; ++s2) { u32x4 pw; pw.x = cvtpk(s[8 * s2 + 0], s[8 * s2 + 1]); pw.y = cvtpk(s[8 * s2 + 2], s[8 * s2 + 3]); pw.z = cvtpk(s[8 * s2 + 4], s[8 * s2 + 5]); pw.w = cvtpk(s[8 * s2 + 6], s[8 * s2 + 7]);
                const bf16x8 pa = __builtin_bit_cast(bf16x8, pw);
#pragma unroll
                for (int t = 0; t < 2; ++t) { const bf16x8 vf = tr_perm(lds + O_V + (2 * eh + t) * VS, 32 * kt + 16 * s2, lane); o[t] = __builtin_amdgcn_mfma_f32_32x32x16_bf16(pa, vf, o[t], 0, 0, 0); } }
        }
        unsigned gq[16];
        { const bf16_t* gb = proj + hm_off(2560, 4, 128, b, h, 128 * n);
#pragma unroll
          for (int k = 0; k < 16; ++k) gq[k] = *(const unsigned*)(gb + (size_t)(16 * w + k) * 128 + 2 * lane); }
        LAS float* st = (LAS float*)(lds + O_ST);
#pragma unroll
        for (int r = 0; r < 16; ++r) { const int qq = 32 * qt + crow(r, hi); const float a = fast_exp2(lg * (float)qq);
#pragma unroll
            for (int t = 0; t < 2; ++t) st[qq * O_LD + 32 * (2 * eh + t) + q] = o[t][r] * a; }
        __syncthreads();
        float rsn;
        { const LAS f32x4* rp = (const LAS f32x4*)(st + (16 * w + (lane >> 2)) * O_LD + 32 * (lane & 3)); float ss = 0.f;
#pragma unroll
          for (int i = 0; i < 8; ++i) { const f32x4 x = rp[i]; ss += (x[0] * x[0] + x[1] * x[1]) + (x[2] * x[2] + x[3] * x[3]); }
          ss += __shfl_xor(ss, 1); ss += __shfl_xor(ss, 2);
          rsn = rsqrtf(ss * (1.0f / 128.0f) + EPS); }
#pragma unroll
        for (int k = 0; k < 16; ++k) { const int rr = 16 * w + k;
            const f32x2 v = *(const LAS f32x2*)(st + rr * O_LD + 2 * lane);
            const float rs = __shfl(rsn, 4 * k);
            const float g0 = bf2f(gq[k] & 0xffffu), g1 = bf2f(gq[k] >> 16);
            *(unsigned*)(omix + (row0 + rr) * D + 512 + h * 128 + 2 * lane) = cvt_pk_bf16(silu_f(g0) * v[0] * rs, silu_f(g1) * v[1] * rs); }
    }
}
}

constexpr int NPH = 14;
__global__ void __launch_bounds__(NWAVES * 64, 2) mk_fwd(Args args) {
    extern __shared__ __attribute__((aligned(16))) unsigned char lds_raw[];
    LAS unsigned char* lds = (LAS unsigned char*)lds_raw;
    volatile LAS unsigned* MISC = (volatile LAS unsigned*)(lds + MISC_OFF);
    const int wave = __builtin_amdgcn_readfirstlane((int)threadIdx.x >> 6);
#define tid (otid())
#define lane (otid() & 63)
    const int G = gridDim.x; const int bx = blockIdx.x;
    const bool grouped = (G % 8 == 0) && (NBATCH % 8 == 0);
    const int NGRP = grouped ? 8 : 1, grp = grouped ? bx % 8 : 0, GL = G / NGRP, BPG = NBATCH / NGRP;
    const int lv = grouped ? bx / 8 : ((G % 8 == 0) ? (bx % 8) * (G / 8) + bx / 8 : bx);
    const int lc = grouped ? bx / 8 : bx;
    const int b0 = grp * BPG, Mg = BPG * SEQ; const size_t rowb = (size_t)b0 * SEQ;
    const int vcu = (G % 8 == 0) ? (bx % 8) * (G / 8) + bx / 8 : bx;
    const int gw = vcu * NWAVES + wave, NGW = G * NWAVES;
    const int gwl = lv * NWAVES + wave, NGWL = GL * NWAVES;
    unsigned char* ws = args.ws;
    unsigned* ctl = (unsigned*)(ws + WS_CTL);
    for (int u = tid; u < (LDS_BYTES - LDSCTL_OFF) / 4; u += NWAVES * 64) ((LAS unsigned*)(lds + LDSCTL_OFF))[u] = 0u;
    __syncthreads();
    XcdBarrier bar_all = xcd_barrier_post(ctl + CW_BAR + 8 * XCD_BAR_WORDS, MISC + 10, (unsigned)G);
    XcdBarrier bar = xcd_barrier_post(ctl + CW_BAR + grp * XCD_BAR_WORDS, MISC + 8, (unsigned)GL);
    const int lo = args.ph_lo, hi = args.ph_hi;
#define IN(k) (lo <= (k) && (k) < hi)
#define SEAM(k) do { if (IN(k) && IN((k) + 1)) xcd_barrier(bar); } while (0)

#define XIN ((const float*)args.in[0])
#define MEMIN ((const float*)args.in[1])
#define W1in ((bf16_t*)(ws + WS_W1IN))
#define W1out ((bf16_t*)(ws + WS_W1OUT))
#define Win ((bf16_t*)(ws + WS_WIN))
#define Wout ((bf16_t*)(ws + WS_WOUT))
#define Wcq ((bf16_t*)(ws + WS_WCQ))
#define Wckv ((bf16_t*)(ws + WS_WCKV))
#define Wco ((bf16_t*)(ws + WS_WCO))
#define W2in ((bf16_t*)(ws + WS_W2IN))
#define W2out ((bf16_t*)(ws + WS_W2OUT))
#define cosA ((float*)(ws + WS_COSA))
#define sinA ((float*)(ws + WS_SINA))
#define cosR ((float*)(ws + WS_COSR))
#define sinR ((float*)(ws + WS_SINR))
#define MEMN ((bf16_t*)(ws + WS_MEMN))
#define KVC ((bf16_t*)(ws + WS_KC))
#define SSQ ((float*)(ws + WS_SSQ))
#define XB ((bf16_t*)(ws + WS_XB))
#define BIG ((bf16_t*)(ws + WS_BIG))
#define OMIX ((bf16_t*)(ws + WS_OMIX))
#define QC ((bf16_t*)(ws + WS_BIG))
#define ATTP ((bf16_t*)(ws + WS_ATT))
#define LSE ((float*)(ws + WS_ATT + (size_t)M * 512 * 2 * 3))
#define RETB ((float*)(ws + WS_RET))
#define xres (args.xres)
    if (IN(0)) {
        LAS float* scr = (LAS float*)(lds + RING_OFF + wave * 16384);
        constexpr int I0 = (D / 64) * (2 * DFF / 32), I1 = (DFF / 64) * (D / 32), I2 = (D / 64) * (INC / 32), I3 = (D / 64) * (D / 32), I5 = (D / 64) * (2 * D / 32);
        constexpr int NITEMS = 2 * I0 + 2 * I1 + I2 + 3 * I3 + I5;
        for (int it = gw; it < NITEMS; it += NGW) {
            int r = it;
            if (r < I0) { p0_transpose_item(args.in[3], D, 2 * DFF, W1in, 0, nullptr, scr, r, lane); continue; } r -= I0;
            if (r < I1) { p0_transpose_item(args.in[4], DFF, D, W1out, 1, nullptr, scr, r, lane); continue; } r -= I1;
            if (r < I2) { p0_transpose_item(args.in[6], D, INC, Win, 2, args.in[5], scr, r, lane); continue; } r -= I2;
            if (r < I3) { p0_transpose_item(args.in[7], D, D, Wout, 3, nullptr, scr, r, lane); continue; } r -= I3;
            if (r < I3) { p0_transpose_item(args.in[10], D, D, Wcq, 4, args.in[8], scr, r, lane); continue; } r -= I3;
            if (r < I5) { p0_transpose_item(args.in[11], D, 2 * D, Wckv, 5, nullptr, scr, r, lane); continue; } r -= I5;
            if (r < I3) { p0_transpose_item(args.in[12], D, D, Wco, 6, nullptr, scr, r, lane); continue; } r -= I3;
            if (r < I0) { p0_transpose_item(args.in[14], D, 2 * DFF, W2in, 7, args.in[13], scr, r, lane); continue; } r -= I0;
            p0_transpose_item(args.in[15], DFF, D, W2out, 8, nullptr, scr, r, lane);
        }
        for (int m = gw; m < M; m += 2 * NGW) rms_row2_to_bf16(XIN + (size_t)m * D, (m + NGW < M) ? XIN + (size_t)(m + NGW) * D : nullptr, args.in[2], XB + (size_t)m * D, XB + (size_t)(m + NGW) * D, lane);
        for (int m = gw; m < MROWS; m += NGW) rms_row_to_bf16(MEMIN + (size_t)m * D, args.in[9], MEMN + (size_t)m * D, lane);
    }
    if (IN(0) && IN(1)) xcd_barrier(bar_all);
    if (IN(1)) {
        pg8::Gemm g{XB + rowb * D, W1in, D, D, D}; pg8::StaticOrder S; S.init(Mg, 2 * DFF, GL, lc, D, D); S.flat = grouped;
        pg8::EpiSwiGLU<false> E{BIG + rowb * INC, nullptr};
        pg8::gemm_phase<pg8::EpiSwiGLU<false>, pg8::StaticOrder, true>(lds + RING_OFF, g, S, E);
    }
    SEAM(1);
    if (IN(2)) {
        pg8::Gemm g{BIG + rowb * INC, W1out, INC, DFF, DFF}; pg8::StaticOrder S; S.init(Mg, D, GL, lc, INC, DFF); S.flat = grouped;
        pg8::EpiResid<0> E{XIN + rowb * D, nullptr, XB + rowb * D, SSQ + rowb * 4, args.variant};
        pg8::gemm_phase<pg8::EpiResid<0>, pg8::StaticOrder, true>(lds + RING_OFF, g, S, E);
    }
    SEAM(2);
    if (IN(3)) {
        pg8::Gemm g{XB + rowb * D, Win, D, D, D}; pg8::StaticOrder S; S.init(Mg, INC, GL, lc, D, D); S.flat = grouped;
        pg8::EpiInProj E{BIG + rowb * INC, SSQ + rowb * 4, cosA, sinA, cosR, sinR};
        pg8::gemm_phase<pg8::EpiInProj, pg8::StaticOrder, true>(lds + RING_OFF, g, S, E);
    }
    SEAM(3);
    if (IN(4)) {
        const int nkvg = BPG * 8;
        { pg8::Gemm g{MEMN + (size_t)b0 * MEMLEN * D, Wckv, D, D, D}; pg8::StaticOrder S; S.init(BPG * MEMLEN, 2 * D, GL, lv, D, D); S.flat = grouped;
          pg8::EpiPlain<false> E{KVC + (size_t)b0 * MEMLEN * 2 * D, 2 * D, nullptr};
          pg8::gemm_phase<pg8::EpiPlain<false>, pg8::StaticOrder, true>(lds + RING_OFF, g, S, E); }
        { da::UnitMap U;
          if (grouped) U.init(grp, lv, GL, BPG * 8, (GL == 32 && nkvg == 8) ? 8 : 0);
          else if (G % 8 == 0) U.init(vcu / (G / 8), vcu % (G / 8), G / 8, NBATCH, 0);
          else U.init(0, vcu, G, NBATCH * 8, 0);
          da::phase(lds, BIG, ATTP, LSE, U); }
        { const int nunits = BPG * 4 * 64; const int per = (nunits + GL - 1) / GL; const int u0 = lv * per, u1 = (u0 + per < nunits) ? u0 + per : nunits;
          rt::kv_phase(lds, BIG, RETB, b0 * 256 + u0, b0 * 256 + u1); }
    }
    SEAM(4);
    if (IN(5)) { rt::scan(RETB, b0, BPG, lv * NWAVES * 64 + tid, GL * NWAVES * 64); da::merge(ATTP, LSE, OMIX, (int)rowb, Mg, lv * NWAVES * 64 + tid, GL * NWAVES * 64); }
    SEAM(5);
    if (IN(6)) { const int nunits = BPG * 4 * 64; const int per = (nunits + GL - 1) / GL; const int u0 = lv * per, u1 = (u0 + per < nunits) ? u0 + per : nunits;
        rt::out_phase(lds, BIG, RETB, OMIX, b0 * 256 + u0, b0 * 256 + u1, tid); }
    SEAM(6);
    if (IN(7)) {
        pg8::Gemm g{OMIX + rowb * D, Wout, D, D, D}; pg8::StaticOrder S; S.init(Mg, D, GL, lc, D, D); S.flat = grouped;
        pg8::EpiResid<1> E{nullptr, nullptr, XB + rowb * D, SSQ + rowb * 4, args.variant};
        pg8::gemm_phase<pg8::EpiResid<1>, pg8::StaticOrder, true>(lds + RING_OFF, g, S, E);
    }
    SEAM(7);
    if (IN(8)) {
        pg8::Gemm g{XB + rowb * D, Wcq, D, D, D}; pg8::StaticOrder S; S.init(Mg, D, GL, lc, D, D); S.flat = grouped;
        pg8::EpiPlain<true> E{QC + rowb * INC, INC, SSQ + rowb * 4};
        pg8::gemm_phase<pg8::EpiPlain<true>, pg8::StaticOrder, true>(lds + RING_OFF, g, S, E);
    }
    SEAM(8);
    if (IN(9)) { const int nunits = BPG * 4 * 32; const int per = (nunits + GL - 1) / GL; const int u0 = lv * per, u1 = (u0 + per < nunits) ? u0 + per : nunits;
        xa::phase(lds, QC, KVC, OMIX, b0 * 128 + u0, b0 * 128 + u1, tid); }
    SEAM(9);
    if (IN(10)) {
        pg8::Gemm g{OMIX + rowb * D, Wco, D, D, D}; pg8::StaticOrder S; S.init(Mg, D, GL, lc, D, D); S.flat = grouped;
        pg8::EpiResid<1> E{nullptr, nullptr, XB + rowb * D, SSQ + rowb * 4, args.variant};
        pg8::gemm_phase<pg8::EpiResid<1>, pg8::StaticOrder, true>(lds + RING_OFF, g, S, E);
    }
    SEAM(10);
    if (IN(11)) {
        pg8::Gemm g{XB + rowb * D, W2in, D, D, D}; pg8::StaticOrder S; S.init(Mg, 2 * DFF, GL, lc, D, D); S.flat = grouped;
        pg8::EpiSwiGLU<true> E{BIG + rowb * INC, SSQ + rowb * 4};
        pg8::gemm_phase<pg8::EpiSwiGLU<true>, pg8::StaticOrder, true>(lds + RING_OFF, g, S, E);
    }
    SEAM(11);
    if (IN(12)) {
        pg8::Gemm g{BIG + rowb * INC, W2out, INC, DFF, DFF}; pg8::StaticOrder S; S.init(Mg, D, GL, lc, INC, DFF); S.flat = grouped;
        pg8::EpiResid<1> E{nullptr, nullptr, XB + rowb * D, SSQ + rowb * 4, args.variant};
        pg8::gemm_phase<pg8::EpiResid<1>, pg8::StaticOrder, true>(lds + RING_OFF, g, S, E);
    }
    SEAM(12);
    if (IN(13)) {
        const float* wf = args.in[16];
        for (int mm = gwl; mm < Mg; mm += NGWL) { const size_t m = rowb + mm;
            const f32x4 p = *(const f32x4*)(SSQ + m * 4);
            const float r = rsqrtf(((p[0] + p[1]) + (p[2] + p[3])) * (1.f / D) + EPS);
            const u32x4* xr = (const u32x4*)(XB + m * D) + lane;
            f32x4* orow = (f32x4*)(xres + m * D) + 2 * lane;
#pragma unroll
            for (int j = 0; j < 2; ++j) { const u32x4 w = xr[64 * j]; const f32x4 w0 = ((const f32x4*)wf)[128 * j + 2 * lane], w1 = ((const f32x4*)wf)[128 * j + 2 * lane + 1];
                f32x4 o0 = {bf2f(w[0] & 0xffffu), bf2f(w[0] >> 16), bf2f(w[1] & 0xffffu), bf2f(w[1] >> 16)}, o1 = {bf2f(w[2] & 0xffffu), bf2f(w[2] >> 16), bf2f(w[3] & 0xffffu), bf2f(w[3] >> 16)};
                orow[128 * j] = o0 * r * w0; orow[128 * j + 1] = o1 * r * w1; }
        }
    }
#undef IN
#undef SEAM
#undef tid
#undef lane
#undef XIN
#undef MEMIN
#undef W1in
#undef W1out
#undef Win
#undef Wout
#undef Wcq
#undef Wckv
#undef Wco
#undef W2in
#undef W2out
#undef cosA
#undef sinA
#undef cosR
#undef sinR
#undef MEMN
#undef KVC
#undef SSQ
#undef XB
#undef BIG
#undef OMIX
#undef QC
#undef ATTP
#undef LSE
#undef RETB
#undef xres
}


#if DBG
__global__ void nv_rmsnorm(const float* x, const float* __restrict__ w, float* y, int rows) {
    const int wave = (blockIdx.x * blockDim.x + threadIdx.x) >> 6, lane = threadIdx.x & 63;
    if (wave >= rows) return;
    const float4* xr = (const float4*)(x + (size_t)wave * D);
    float4 v[4]; float s = 0.f;
#pragma unroll
    for (int j = 0; j < 4; ++j) { v[j] = xr[lane + 64 * j]; s += v[j].x * v[j].x + v[j].y * v[j].y + v[j].z * v[j].z + v[j].w * v[j].w; }
#pragma unroll
    for (int o = 1; o < 64; o <<= 1) s += __shfl_xor(s, o);
    const float r = rsqrtf(s * (1.0f / D) + EPS);
    float4* yr = (float4*)(y + (size_t)wave * D);
#pragma unroll
    for (int j = 0; j < 4; ++j) { const float4 ww = ((const float4*)w)[lane + 64 * j]; float4 o; o.x = v[j].x * r * ww.x; o.y = v[j].y * r * ww.y; o.z = v[j].z * r * ww.z; o.w = v[j].w * r * ww.w; yr[lane + 64 * j] = o; }
}
__global__ void __launch_bounds__(256) nv_gemm(const float* __restrict__ A, int lda, const float* __restrict__ Bm, int ldb, float* C, int ldc, int M_, int N_, int K_, const float* R, float alpha) {
    __shared__ float As[16][68];
    __shared__ float Bs[16][68];
    const int tid = threadIdx.x, tx = tid & 15, ty = tid >> 4;
    const int m0 = blockIdx.y * 64, n0 = blockIdx.x * 64;
    float acc[4][4];
#pragma unroll
    for (int i = 0; i < 4; ++i)
#pragma unroll
        for (int j = 0; j < 4; ++j) acc[i][j] = 0.f;
    const int ar = tid >> 2, ak = (tid & 3) * 4, br = tid >> 4, bc = (tid & 15) * 4;
    for (int k0 = 0; k0 < K_; k0 += 16) {
        const float4 av = *(const float4*)(A + (size_t)(m0 + ar) * lda + k0 + ak);
        const float4 bv = *(const float4*)(Bm + (size_t)(k0 + br) * ldb + n0 + bc);
        As[ak + 0][ar] = av.x; As[ak + 1][ar] = av.y; As[ak + 2][ar] = av.z; As[ak + 3][ar] = av.w;
        *(float4*)&Bs[br][bc] = bv;
        __syncthreads();
#pragma unroll
        for (int k = 0; k < 16; ++k) {
            const float4 a = *(const float4*)&As[k][ty * 4];
            const float4 b = *(const float4*)&Bs[k][tx * 4];
            const float aa[4] = {a.x, a.y, a.z, a.w}, bb[4] = {b.x, b.y, b.z, b.w};
#pragma unroll
            for (int i = 0; i < 4; ++i)
#pragma unroll
                for (int j = 0; j < 4; ++j) acc[i][j] += aa[i] * bb[j];
        }
        __syncthreads();
    }
#pragma unroll
    for (int i = 0; i < 4; ++i) {
        const size_t off = (size_t)(m0 + ty * 4 + i) * ldc + n0 + tx * 4;
        float4 r = R ? *(const float4*)(R + off) : make_float4(0.f, 0.f, 0.f, 0.f);
        r.x += alpha * acc[i][0]; r.y += alpha * acc[i][1]; r.z += alpha * acc[i][2]; r.w += alpha * acc[i][3];
        *(float4*)(C + off) = r;
    }
}
__global__ void nv_swiglu(const float* __restrict__ gu, float* __restrict__ act, int rows) {
    const size_t i = (size_t)blockIdx.x * blockDim.x + threadIdx.x;
    if (i >= (size_t)rows * DFF) return;
    const size_t r = i / DFF; const int c = (int)(i % DFF);
    const float g = gu[r * (2 * DFF) + c], u = gu[r * (2 * DFF) + DFF + c];
    act[i] = g / (1.f + expf(-g)) * u;
}
__global__ void nv_rotary(float* proj) {
    const int idx = blockIdx.x * blockDim.x + threadIdx.x;
    if (idx >= SEQ * 384) return;
    const int t = idx / 384, r = idx % 384;
    float* p = proj + (size_t)t * INC;
    if (r < 128) {
        const int which = r >> 6, h = (r & 63) >> 3, i = r & 7;
        const float inv = expf(-logf(500000.0f) * (float)i / 8.0f);
        const float ang = (float)t * inv, c = cosf(ang), s = sinf(ang);
        float* q = p + which * 512 + h * 64;
        const float x1 = q[i], x2 = q[i + 8];
        q[i] = x1 * c - x2 * s; q[i + 8] = x1 * s + x2 * c;
    } else {
        const int rr = r - 128, which = rr >> 7, h = (rr & 127) >> 5, i = rr & 31;
        const float inv = expf(-logf(10000.0f) * (float)i / 32.0f);
        const float ang = (float)t * inv, c = cosf(ang), s = sinf(ang);
        float* q = p + 1536 + which * 256 + h * 64;
        const float x1 = q[i], x2 = q[i + 32];
        const float sc = which ? 0.125f : 1.0f;
        q[i] = (x1 * c - x2 * s) * sc; q[i + 32] = (x1 * s + x2 * c) * sc;
    }
}
__global__ void __launch_bounds__(256) nv_dattn(const float* __restrict__ proj, float* __restrict__ omix) {
    const int wave = (blockIdx.x * blockDim.x + threadIdx.x) >> 6, lane = threadIdx.x & 63;
    if (wave >= SEQ * 8) return;
    const int t = wave >> 3, h = wave & 7;
    const float* qp = proj + (size_t)t * INC + h * 64;
    float q[64];
#pragma unroll
    for (int d4 = 0; d4 < 16; ++d4) { const float4 v = ((const float4*)qp)[d4]; q[4 * d4] = v.x; q[4 * d4 + 1] = v.y; q[4 * d4 + 2] = v.z; q[4 * d4 + 3] = v.w; }
    float og[3], lse[3];
#pragma unroll
    for (int g = 0; g < 3; ++g) {
        const int d = (g == 0) ? 1 : ((g == 1) ? 4 : 16);
        float sc[3];
#pragma unroll
        for (int i = 0; i < 3; ++i) {
            const int j = lane + 64 * i; const int pos = t - j * d;
            float s = -1e30f;
            if (j <= 128 && pos >= 0) {
                const float4* kp = (const float4*)(proj + (size_t)pos * INC + 512 + h * 64);
                float a = 0.f;
#pragma unroll
                for (int d4 = 0; d4 < 16; ++d4) { const float4 kv = kp[d4]; a += q[4 * d4] * kv.x + q[4 * d4 + 1] * kv.y + q[4 * d4 + 2] * kv.z + q[4 * d4 + 3] * kv.w; }
                s = a * 0.125f;
            }
            sc[i] = s;
        }
        float m = fmaxf(fmaxf(sc[0], sc[1]), sc[2]);
#pragma unroll
        for (int o = 1; o < 64; o <<= 1) m = fmaxf(m, __shfl_xor(m, o));
        float pr[3], l = 0.f;
#pragma unroll
        for (int i = 0; i < 3; ++i) { pr[i] = (sc[i] > -1e29f) ? expf(sc[i] - m) : 0.f; l += pr[i]; }
#pragma unroll
        for (int o = 1; o < 64; o <<= 1) l += __shfl_xor(l, o);
        float acc = 0.f;
        for (int j = 0; j <= 128; ++j) {
            const int pos = t - j * d; if (pos < 0) break;
            const float pj = __shfl(j < 64 ? pr[0] : (j < 128 ? pr[1] : pr[2]), j & 63);
            acc += pj * proj[(size_t)pos * INC + 1024 + h * 64 + lane];
        }
        og[g] = acc / l; lse[g] = m + logf(l);
    }
    const float mm = fmaxf(fmaxf(lse[0], lse[1]), lse[2]);
    const float w0 = expf(lse[0] - mm), w1 = expf(lse[1] - mm), w2 = expf(lse[2] - mm);
    omix[(size_t)t * D + h * 64 + lane] = (w0 * og[0] + w1 * og[1] + w2 * og[2]) / (w0 + w1 + w2);
}
__global__ void __launch_bounds__(128) nv_ret(const float* __restrict__ proj, float* __restrict__ raw) {
    const int h = blockIdx.x, e = threadIdx.x;
    const float gamma = 1.0f - exp2f(-5.0f - (float)h);
    float R[64];
#pragma unroll
    for (int d = 0; d < 64; ++d) R[d] = 0.f;
    for (int t = 0; t < SEQ; ++t) {
        const float* p = proj + (size_t)t * INC;
        const float v = p[2048 + h * 128 + e];
        const float* qp = p + 1536 + h * 64; const float* kp = p + 1792 + h * 64;
        float o = 0.f;
#pragma unroll
        for (int d = 0; d < 64; ++d) { R[d] = gamma * R[d] + kp[d] * v; o += qp[d] * R[d]; }
        raw[(size_t)t * 512 + h * 128 + e] = o;
    }
}
__global__ void nv_retnorm(const float* __restrict__ raw, const float* __restrict__ proj, float* __restrict__ omix) {
    const int wave = (blockIdx.x * blockDim.x + threadIdx.x) >> 6, lane = threadIdx.x & 63;
    if (wave >= SEQ * 4) return;
    const int t = wave >> 2, h = wave & 3;
    const float a = raw[(size_t)t * 512 + h * 128 + lane], b = raw[(size_t)t * 512 + h * 128 + 64 + lane];
    float s = a * a + b * b;
#pragma unroll
    for (int o = 1; o < 64; o <<= 1) s += __shfl_xor(s, o);
    const float r = rsqrtf(s * (1.0f / 128.0f) + EPS);
    const float g0 = proj[(size_t)t * INC + 2560 + h * 128 + lane], g1 = proj[(size_t)t * INC + 2560 + h * 128 + 64 + lane];
    omix[(size_t)t * D + 512 + h * 128 + lane] = g0 / (1.f + expf(-g0)) * a * r;
    omix[(size_t)t * D + 512 + h * 128 + 64 + lane] = g1 / (1.f + expf(-g1)) * b * r;
}
__global__ void __launch_bounds__(256) nv_xattn(const float* __restrict__ qc, const float* __restrict__ kv, float* __restrict__ oc) {
    const int wave = (blockIdx.x * blockDim.x + threadIdx.x) >> 6, lane = threadIdx.x & 63;
    if (wave >= SEQ * 4) return;
    const int t = wave >> 2, h = wave & 3;
    const float4* q4 = (const float4*)(qc + (size_t)t * D + h * 256);
    float sc[4] = {0.f, 0.f, 0.f, 0.f};
    for (int d4 = 0; d4 < 64; ++d4) {
        const float4 qv = q4[d4];
#pragma unroll
        for (int i = 0; i < 4; ++i) { const float4 k4 = *(const float4*)(kv + (size_t)(lane + 64 * i) * 2048 + h * 256 + 4 * d4); sc[i] += qv.x * k4.x + qv.y * k4.y + qv.z * k4.z + qv.w * k4.w; }
    }
    float m = -1e30f;
#pragma unroll
    for (int i = 0; i < 4; ++i) { sc[i] *= 0.0625f; m = fmaxf(m, sc[i]); }
#pragma unroll
    for (int o = 1; o < 64; o <<= 1) m = fmaxf(m, __shfl_xor(m, o));
    float l = 0.f;
#pragma unroll
    for (int i = 0; i < 4; ++i) { sc[i] = expf(sc[i] - m); l += sc[i]; }
#pragma unroll
    for (int o = 1; o < 64; o <<= 1) l += __shfl_xor(l, o);
    float4 acc = make_float4(0.f, 0.f, 0.f, 0.f);
#pragma unroll
    for (int i = 0; i < 4; ++i)
        for (int j = 0; j < 64; ++j) {
            const float p = __shfl(sc[i], j);
            const float4 v4 = *(const float4*)(kv + (size_t)(j + 64 * i) * 2048 + 1024 + h * 256 + 4 * lane);
            acc.x += p * v4.x; acc.y += p * v4.y; acc.z += p * v4.z; acc.w += p * v4.w;
        }
    const float il = 1.0f / l;
    acc.x *= il; acc.y *= il; acc.z *= il; acc.w *= il;
    *(float4*)(oc + (size_t)t * D + h * 256 + 4 * lane) = acc;
}
__global__ void __launch_bounds__(256) dbg_cmp(const void* opt, int opt_bf16, int ldo, const float* ref, int ldr, int rows, int cols, int mode, float scale, float* errs, int code) {
    float num = 0.f, den = 0.f;
    const size_t total = (size_t)rows * cols;
    for (size_t idx = (size_t)blockIdx.x * blockDim.x + threadIdx.x; idx < total; idx += (size_t)gridDim.x * blockDim.x) {
        const int r = (int)(idx / cols), c = (int)(idx % cols);
        float a = 0.f;
        if (mode != 2) a = opt_bf16 ? bf2f(((const bf16_t*)opt)[(size_t)r * ldo + c]) : ((const float*)opt)[(size_t)r * ldo + c];
        float b;
        if (mode == 2) {
            const int secoff = c < 1536 ? (c / 512) * 512 : (c < 2048 ? 1536 + ((c - 1536) / 256) * 256 : 2048 + ((c - 2048) / 512) * 512);
            const int hw = (c < 2048) ? 64 : 128, cs = c - secoff, head = cs / hw; int hc = cs % hw;
            if (c >= 1536 && c < 2048) hc = (hc < 32) ? (16 * (hc >> 3) + (hc & 7)) : (16 * ((hc - 32) >> 3) + 8 + (hc & 7));
            a = bf2f(((const bf16_t*)opt)[(size_t)SEQ * secoff + ((size_t)head * SEQ + r) * hw + hc]);
            const float bb = ref[(size_t)r * ldr + c] * ((c < 512) ? 0.125f * LOG2E : 1.0f);
            const float d0 = a - bb; num += d0 * d0; den += bb * bb; continue;
        }
        if (mode == 0) b = ref[(size_t)r * ldr + c] * scale;
        else if (mode == 3) b = ref[(size_t)c * 2048 + 1024 + r];
        else b = ref[(size_t)r * 2048 + c];
        const float d = a - b; num += d * d; den += b * b;
    }
    __shared__ float sn[256], sd[256];
    sn[threadIdx.x] = num; sd[threadIdx.x] = den; __syncthreads();
    for (int o = 128; o > 0; o >>= 1) { if ((int)threadIdx.x < o) { sn[threadIdx.x] += sn[threadIdx.x + o]; sd[threadIdx.x] += sd[threadIdx.x + o]; } __syncthreads(); }
    if (threadIdx.x == 0) { atomicAdd(&errs[2 * code], sn[0]); atomicAdd(&errs[2 * code + 1], sd[0]); }
}
__global__ void dbg_final(float* errs, int ncodes) {
    int code = 0;
    for (int c = 1; c <= ncodes; ++c) { const float e = errs[2 * c] / errs[2 * c + 1]; if (!(e < 1e-3f)) { code = c; break; } }
    errs[0] = (float)code;
}
__global__ void dbg_scale(float* out, const float* errs, size_t n) {
    const float f = 1.0f + 0.02f * errs[0];
    for (size_t i = (size_t)blockIdx.x * blockDim.x + threadIdx.x; i < n; i += (size_t)gridDim.x * blockDim.x) out[i] *= f;
}
static void nvgemm(hipStream_t st, const float* A, int lda, const float* Bm, int ldb, float* C, int ldc, int M_, int N_, int K_, const float* R, float alpha) {
    hipLaunchKernelGGL(nv_gemm, dim3(N_ / 64, M_ / 64), dim3(256), 0, st, A, lda, Bm, ldb, C, ldc, M_, N_, K_, R, alpha);
}
#endif
extern "C" void kernel_launch(void* const* d_in, const int* in_sizes, int n_in, void* d_out, int out_size, void* d_ws, size_t ws_size, hipStream_t stream) {
    static int grid = 0;
    if (grid == 0) {
        int dev = 0, cus = 0, per_cu = 0;
        if (n_in != 17 || ws_size < WS_OPT_END) { fprintf(stderr, "kernel_launch: unexpected inputs (n_in %d, ws %zu < %zu)\n", n_in, ws_size, (size_t)WS_OPT_END); grid = -1; return; }
        if (hipGetDevice(&dev) != hipSuccess || hipDeviceGetAttribute(&cus, hipDeviceAttributeMultiprocessorCount, dev) != hipSuccess) { grid = -1; return; }
        if (hipFuncSetAttribute((const void*)mk_fwd, hipFuncAttributeMaxDynamicSharedMemorySize, LDS_BYTES) != hipSuccess) { fprintf(stderr, "kernel_launch: hipFuncSetAttribute failed\n"); grid = -1; return; }
        if (hipOccupancyMaxActiveBlocksPerMultiprocessor(&per_cu, (const void*)mk_fwd, NWAVES * 64, LDS_BYTES) != hipSuccess || per_cu < 1) { fprintf(stderr, "kernel_launch: occupancy query says %d blocks per CU\n", per_cu); (void)hipGetLastError(); grid = -1; return; }
        grid = cus;
    }
    if (grid < 0) return;
    (void)hipMemsetAsync((char*)d_ws + WS_CTL, 0, CTL_ZERO_BYTES, stream);
    Args a{};
    for (int i = 0; i < 17; ++i) a.in[i] = (const float*)d_in[i];
    a.out = (float*)d_out; a.ws = (unsigned char*)d_ws;
#if !DBG
    a.xres = (float*)d_out; a.ph_lo = 0; a.ph_hi = NPH;
    hipLaunchKernelGGL(mk_fwd, dim3(grid), dim3(NWAVES * 64), LDS_BYTES, stream, a);
#ifdef PROBE_EXTRA
    {
        const int extra[] = PROBE_EXTRA;
        for (int e : extra) { a.ph_lo = e % 100; a.ph_hi = e % 100 + 1; a.variant = e / 100; a.xres = (float*)((char*)d_ws + WS_ATT); hipLaunchKernelGGL(mk_fwd, dim3(grid), dim3(NWAVES * 64), LDS_BYTES, stream, a); }
    }
#endif
#else
    {
        const float* x = (const float*)d_in[0]; const float* mem = (const float*)d_in[1];
        const float* n_ffn1 = (const float*)d_in[2]; const float* w_ffn1_in = (const float*)d_in[3]; const float* w_ffn1_out = (const float*)d_in[4];
        const float* n_mix = (const float*)d_in[5]; const float* w_in = (const float*)d_in[6]; const float* w_out = (const float*)d_in[7];
        const float* n_cross = (const float*)d_in[8]; const float* n_mem = (const float*)d_in[9]; const float* w_cq = (const float*)d_in[10];
        const float* w_ckv = (const float*)d_in[11]; const float* w_co = (const float*)d_in[12]; const float* n_ffn2 = (const float*)d_in[13];
        const float* w_ffn2_in = (const float*)d_in[14]; const float* w_ffn2_out = (const float*)d_in[15]; const float* n_final = (const float*)d_in[16];
        float* out = (float*)d_out;
        const size_t S = SEQ;
        float* hn = (float*)((char*)d_ws + al(WS_OPT_END));
        float* big = hn + S * D; float* act = big + S * 2 * DFF; float* omix = act + S * DFF; float* raw = omix + S * D; float* qc = raw + S * 512; float* oc = qc + S * D;
        float* memn = oc + S * D; float* kvb = memn + (size_t)MEMLEN * D;
        float* s_hn1 = kvb + (size_t)MEMLEN * 2 * D; float* s_act1 = s_hn1 + S * D; float* s_x1 = s_act1 + S * DFF; float* s_proj = s_x1 + S * D; float* s_omix = s_proj + S * INC;
        float* s_x2 = s_omix + S * D; float* s_qc = s_x2 + S * D; float* s_kv = s_qc + S * D; float* s_oc = s_kv + (size_t)MEMLEN * 2 * D; float* s_x3 = s_oc + S * D; float* s_end = s_x3 + S * D;
        if ((size_t)((char*)s_end - (char*)d_ws) > ws_size) { fprintf(stderr, "DBG: workspace too small\n"); return; }
        float* errs = (float*)((char*)d_ws + 524288);
        (void)hipMemsetAsync(errs, 0, 4096, stream);
        const int rn_blocks = SEQ * 64 / 256;
#define SNAP(dst, srcp, n) do { if (b == 0) (void)hipMemcpyAsync(dst, srcp, (size_t)(n) * 4, hipMemcpyDeviceToDevice, stream); } while (0)
        for (int b = 0; b < NB_ALL; ++b) {
            const float* xb = x + (size_t)b * S * D; float* ob = out + (size_t)b * S * D;
            hipLaunchKernelGGL(nv_rmsnorm, dim3(rn_blocks), dim3(256), 0, stream, xb, n_ffn1, hn, SEQ);
            SNAP(s_hn1, hn, S * D);
            nvgemm(stream, hn, D, w_ffn1_in, 2 * DFF, big, 2 * DFF, SEQ, 2 * DFF, D, nullptr, 1.f);
            hipLaunchKernelGGL(nv_swiglu, dim3((SEQ * DFF + 255) / 256), dim3(256), 0, stream, big, act, SEQ);
            SNAP(s_act1, act, S * DFF);
            nvgemm(stream, act, DFF, w_ffn1_out, D, ob, D, SEQ, D, DFF, xb, 0.5f);
            SNAP(s_x1, ob, S * D);
            hipLaunchKernelGGL(nv_rmsnorm, dim3(rn_blocks), dim3(256), 0, stream, ob, n_mix, hn, SEQ);
            nvgemm(stream, hn, D, w_in, INC, big, INC, SEQ, INC, D, nullptr, 1.f);
            hipLaunchKernelGGL(nv_rotary, dim3((SEQ * 384 + 255) / 256), dim3(256), 0, stream, big);
            SNAP(s_proj, big, S * INC);
            hipLaunchKernelGGL(nv_dattn, dim3(SEQ * 8 / 4), dim3(256), 0, stream, big, omix);
            hipLaunchKernelGGL(nv_ret, dim3(4), dim3(128), 0, stream, big, raw);
            hipLaunchKernelGGL(nv_retnorm, dim3(SEQ * 4 / 4), dim3(256), 0, stream, raw, big, omix);
            SNAP(s_omix, omix, S * D);
            nvgemm(stream, omix, D, w_out, D, ob, D, SEQ, D, D, ob, 1.f);
            SNAP(s_x2, ob, S * D);
            hipLaunchKernelGGL(nv_rmsnorm, dim3(rn_blocks), dim3(256), 0, stream, ob, n_cross, hn, SEQ);
            nvgemm(stream, hn, D, w_cq, D, qc, D, SEQ, D, D, nullptr, 1.f);
            SNAP(s_qc, qc, S * D);
            hipLaunchKernelGGL(nv_rmsnorm, dim3(MEMLEN * 64 / 256), dim3(256), 0, stream, mem + (size_t)b * MEMLEN * D, n_mem, memn, MEMLEN);
            nvgemm(stream, memn, D, w_ckv, 2 * D, kvb, 2 * D, MEMLEN, 2 * D, D, nullptr, 1.f);
            SNAP(s_kv, kvb, (size_t)MEMLEN * 2 * D);
            hipLaunchKernelGGL(nv_xattn, dim3(SEQ * 4 / 4), dim3(256), 0, stream, qc, kvb, oc);
            SNAP(s_oc, oc, S * D);
            nvgemm(stream, oc, D, w_co, D, ob, D, SEQ, D, D, ob, 1.f);
            SNAP(s_x3, ob, S * D);
            hipLaunchKernelGGL(nv_rmsnorm, dim3(rn_blocks), dim3(256), 0, stream, ob, n_ffn2, hn, SEQ);
            nvgemm(stream, hn, D, w_ffn2_in, 2 * DFF, big, 2 * DFF, SEQ, 2 * DFF, D, nullptr, 1.f);
            hipLaunchKernelGGL(nv_swiglu, dim3((SEQ * DFF + 255) / 256), dim3(256), 0, stream, big, act, SEQ);
            nvgemm(stream, act, DFF, w_ffn2_out, D, ob, D, SEQ, D, DFF, ob, 0.5f);
            hipLaunchKernelGGL(nv_rmsnorm, dim3(rn_blocks), dim3(256), 0, stream, ob, n_final, ob, SEQ);
        }
        unsigned char* wsb = (unsigned char*)d_ws;
        float* xres = (float*)(wsb + WS_XRES);
        a.xres = xres;
#define CMP(code, optp, isbf, ldo, refp, ldr, rows, cols, mode, scale) hipLaunchKernelGGL(dbg_cmp, dim3(1024), dim3(256), 0, stream, (const void*)(optp), isbf, ldo, (const float*)(refp), ldr, rows, cols, mode, scale, errs, code)
        for (int ph = 0; ph < NPH; ++ph) {
            a.ph_lo = ph; a.ph_hi = ph + 1;
            hipLaunchKernelGGL(mk_fwd, dim3(grid), dim3(NWAVES * 64), LDS_BYTES, stream, a);
            if (ph == 0) CMP(1, wsb + WS_XB, 1, D, s_hn1, D, SEQ, D, 0, 1.0f);
            if (ph == 1) CMP(2, wsb + WS_BIG, 1, INC, s_act1, DFF, SEQ, DFF, 0, 1.0f);
            if (ph == 2) CMP(3, wsb + WS_XB, 1, D, s_x1, D, SEQ, D, 0, 1.0f);
            if (ph == 3) CMP(4, wsb + WS_BIG, 1, INC, s_proj, INC, SEQ, INC, 2, 1.0f);
            if (ph == 6) { CMP(5, wsb + WS_OMIX, 1, D, s_omix, D, SEQ, 512, 0, 1.0f); CMP(6, wsb + WS_OMIX + 1024, 1, D, s_omix + 512, D, SEQ, 512, 0, 1.0f); }
            if (ph == 7) CMP(7, wsb + WS_XB, 1, D, s_x2, D, SEQ, D, 0, 1.0f);
            if (ph == 8) { CMP(8, wsb + WS_BIG, 1, INC, s_qc, D, SEQ, D, 0, 0.0625f * LOG2E); CMP(9, wsb + WS_KC, 1, 2 * D, s_kv, 2 * D, MEMLEN, D, 4, 1.0f); CMP(10, wsb + WS_KC + 2048, 1, 2 * D, s_kv + D, 2 * D, MEMLEN, D, 0, 1.0f); }
            if (ph == 9) CMP(11, wsb + WS_OMIX, 1, D, s_oc, D, SEQ, D, 0, 1.0f);
            if (ph == 10) CMP(12, wsb + WS_XB, 1, D, s_x3, D, SEQ, D, 0, 1.0f);
            if (ph == 13) CMP(13, xres, 0, D, out, D, SEQ, D, 0, 1.0f);
        }
        hipLaunchKernelGGL(dbg_final, dim3(1), dim3(1), 0, stream, errs, 13);
        hipLaunchKernelGGL(dbg_scale, dim3(2048), dim3(256), 0, stream, out, errs, (size_t)NB_ALL * S * D);
    }
#endif
}
```

```cpp
#include <hip/hip_runtime.h>
#include <cstdio>
#include <cstdint>
#include <cmath>

#define DI __device__ __forceinline__

constexpr int D = 1024, NB_ALL = 8, SEQ = 8192, MEMLEN = 256, DFF = 2816, INC = 3072;
constexpr int NBATCH = 8;
constexpr int M = NBATCH * SEQ;
constexpr int MROWS = NBATCH * MEMLEN;
constexpr float EPS = 1e-6f;
constexpr float LOG2E = 1.4426950408889634f;

typedef unsigned short bf16_t;
typedef short bf16x8 __attribute__((ext_vector_type(8)));
typedef float f32x4 __attribute__((ext_vector_type(4)));
typedef float f32x2 __attribute__((ext_vector_type(2)));
typedef unsigned u32x4 __attribute__((ext_vector_type(4)));
typedef unsigned u32x2 __attribute__((ext_vector_type(2)));
#define LAS __attribute__((address_space(3)))
#define GAS __attribute__((address_space(1)))

DI int otid() { int t = threadIdx.x; asm volatile("" : "+v"(t)); return t; }
DI float bf2f(unsigned u16) { return __uint_as_float(u16 << 16); }
DI unsigned cvt_pk_bf16(float lo, float hi) { unsigned r; asm volatile("v_cvt_pk_bf16_f32 %0, %1, %2" : "=v"(r) : "v"(lo), "v"(hi)); return r; }
DI float fast_exp2(float x) { return __builtin_amdgcn_exp2f(x); }
DI float fast_rcp(float x) { return __builtin_amdgcn_rcpf(x); }
DI float silu_f(float x) { return x * fast_rcp(1.0f + fast_exp2(-x * LOG2E)); }


DI size_t hm_off(int secoff, int nheads, int hw, int b, int head, int t) { return (size_t)b * SEQ * INC + (size_t)SEQ * secoff + ((size_t)head * SEQ + t) * hw; }

namespace pg8 {
constexpr int BM = 256, BK = 64, HALF = 128, HTB = HALF * BK * 2, STAGE_BYTES = 8 * HTB, NXCD = 8, WGM = 8;
constexpr int EPI_SCR = STAGE_BYTES;
constexpr int EPI_RS = EPI_SCR + 4096, EPI_RS_MAX = 24;
__host__ __device__ __forceinline__ int lds_byte(int r, int c) { const int st = (r >> 4) * 2 + (c >> 5), rr = r & 15, cc = c & 31, ob = rr * 64 + cc * 2; return st * 1024 + (ob ^ (((ob >> 9) & 1) << 5)); }
__host__ __device__ __forceinline__ void stage_rc(int b, int& R, int& C) { const int st = b / 1024, sb = b % 1024, swz = sb ^ (((sb >> 9) & 1) << 5); R = (st >> 1) * 16 + swz / 64; C = (st & 1) * 32 + (swz % 64) / 2; }
__host__ __device__ __forceinline__ int perm32(int rho) { const int n = rho >> 4, i = rho & 15; return 8 * (i >> 2) + 4 * n + (i & 3); }

struct Unit { int pm, pn, z; };
struct Gemm { const bf16_t* A; const bf16_t* Bt; int lda, ldb, K; };

struct StaticOrder {
    int nM, nN, nwg, G, c, lda, ldb, flat;
    DI void init(int M_, int N_, int G_, int c_, int lda_, int ldb_) { nM = M_ / BM; nN = N_ / BM; nwg = nM * nN; G = G_; c = c_; lda = lda_; ldb = ldb_; flat = 0; }
    DI bool next(int i, Unit& u) const {
        const long L = (long)i * G + c; if (L >= nwg) return false;
        int wgid = (int)L; if (!flat) { const int q = nwg / NXCD, r = nwg % NXCD, xcd = wgid % NXCD, off = wgid / NXCD; wgid = (xcd < r ? xcd * (q + 1) : r * (q + 1) + (xcd - r) * q) + off; }
        const int nig = WGM * nN, gid = wgid / nig, fm = gid * WGM, gsz = (nM - fm) < WGM ? (nM - fm) : WGM;
        u.pm = fm + ((wgid % nig) % gsz); u.pn = (wgid % nig) / gsz; u.z = 0; return true;
    }
    DI size_t a_off(const Unit& u) const { return (size_t)u.pm * BM * lda; }
    DI size_t b_off(const Unit& u) const { return (size_t)u.pn * BM * ldb; }
};

template <class Epi, class Sched, bool ALIGN_EPI>
DI void gemm_phase(LAS unsigned char* lds, const Gemm g, const Sched& S, const Epi& E) {
    const int tid = otid(), wid = __builtin_amdgcn_readfirstlane(tid >> 6), lane = tid & 63, wr = wid >> 2, wc = wid & 3, fr = lane & 15, fq = lane >> 4;
    const int nt = g.K / BK;
    unsigned voffA[2], voffB[2];
#pragma unroll
    for (int i = 0; i < 2; ++i) { int R, C; stage_rc(tid * 16 + i * 8192, R, C); const int Rb = Epi::PERM ? ((R & ~31) + perm32(R & 31)) : R;
        voffA[i] = (unsigned)(R * g.lda + C) * 2u; voffB[i] = (unsigned)(Rb * g.ldb + C) * 2u; }
    const size_t kstep = (size_t)(BK * 2);
    const size_t hstepA = (size_t)HALF * g.lda * 2, hstepB = (size_t)HALF * g.ldb * 2;
    const unsigned ldsw = (unsigned)wid * 1024u;
    const int aoff = lds_byte(wr * 64 + fr, fq * 8), boff = lds_byte(wc * 32 + fr, fq * 8);
#define PG8_SA(b, h) (((b) * 2 + (h)) * HTB)
#define PG8_SB(b, h) ((4 + (b) * 2 + (h)) * HTB)
#define PG8_STAGE(bufoff, gbase, voff) do { _Pragma("unroll") for (int _i = 0; _i < 2; ++_i) \
        __builtin_amdgcn_global_load_lds((const unsigned*)((const char*)(gbase) + (voff)[_i]), (LAS unsigned*)(lds + (bufoff) + ldsw + _i * 8192), 16, 0, 0); } while (0)
#define PG8_LDA(dst, b, h) do { _Pragma("unroll") for (int m = 0; m < 4; ++m) _Pragma("unroll") for (int k = 0; k < 2; ++k) dst[m][k] = *(const LAS bf16x8*)(lds + PG8_SA(b, h) + aoff + m * 2048 + k * 1024); } while (0)
#define PG8_LDB(dst, b, h) do { _Pragma("unroll") for (int n = 0; n < 2; ++n) _Pragma("unroll") for (int k = 0; k < 2; ++k) dst[n][k] = *(const LAS bf16x8*)(lds + PG8_SB(b, h) + boff + n * 2048 + k * 1024); } while (0)
#define PG8_MMA(ai, bj, At, Bt) do { __builtin_amdgcn_s_setprio(1); _Pragma("unroll") for (int m = 0; m < 4; ++m) _Pragma("unroll") for (int n = 0; n < 2; ++n) _Pragma("unroll") for (int k = 0; k < 2; ++k) \
        acc[ai][bj][m][n] = __builtin_amdgcn_mfma_f32_16x16x32_bf16(Bt[n][k], At[m][k], acc[ai][bj][m][n], 0, 0, 0); __builtin_amdgcn_s_setprio(0); } while (0)
#define PG8_WAIT_V(n) asm volatile("s_waitcnt vmcnt(" #n ")" ::: "memory")
#define PG8_WAIT_L(n) asm volatile("s_waitcnt lgkmcnt(" #n ")" ::: "memory")
#define PG8_BAR __builtin_amdgcn_s_barrier()
#define PG8_SCHED __builtin_amdgcn_sched_barrier(0)
    Unit cur, nxt; int ui = 0;
    if (!S.next(0, cur)) return;
    E.preload(S, lds + EPI_RS);
    f32x4 acc[2][2][4][2];
    E.init(acc, cur, wr, wc, fr, fq);
    bf16x8 At[4][2], B0[2][2], B1[2][2];
    const char* cA = (const char*)(g.A + S.a_off(cur)); const char* cB = (const char*)(g.Bt + S.b_off(cur));
    PG8_STAGE(PG8_SB(0, 0), cB, voffB); PG8_STAGE(PG8_SB(0, 1), cB + hstepB, voffB); PG8_STAGE(PG8_SA(0, 0), cA, voffA); PG8_STAGE(PG8_SA(0, 1), cA + hstepA, voffA);
    if (wr == 1) PG8_BAR;
    PG8_WAIT_V(2); PG8_BAR;
    PG8_STAGE(PG8_SB(1, 0), cB + kstep, voffB); PG8_STAGE(PG8_SA(1, 0), cA + kstep, voffA); PG8_STAGE(PG8_SB(1, 1), cB + hstepB + kstep, voffB);
    PG8_WAIT_V(6); PG8_BAR;
    for (;;) {
        const bool has_next = S.next(ui + 1, nxt);
        const char* nA = has_next ? (const char*)(g.A + S.a_off(nxt)) : cA; const char* nB = has_next ? (const char*)(g.Bt + S.b_off(nxt)) : cB;
        for (int t = 0; t < nt; t += 2) {
            const bool last = (t == nt - 2);
            const char* a1 = cA + (size_t)(t + 1) * kstep;
            const char* a2 = last ? nA : cA + (size_t)(t + 2) * kstep; const char* b2 = last ? nB : cB + (size_t)(t + 2) * kstep;
            const char* a3 = a2 + kstep; const char* b3 = b2 + kstep;
            PG8_LDB(B0, 0, 0); PG8_LDB(B1, 0, 1); PG8_SCHED; PG8_LDA(At, 0, 0); PG8_STAGE(PG8_SA(1, 1), a1 + hstepA, voffA);
            PG8_WAIT_V(8); PG8_WAIT_L(0); PG8_BAR; PG8_MMA(0, 0, At, B0); PG8_MMA(0, 1, At, B1); PG8_BAR; PG8_SCHED;
            PG8_LDA(At, 0, 1); PG8_STAGE(PG8_SB(0, 0), b2, voffB); PG8_STAGE(PG8_SB(0, 1), b2 + hstepB, voffB); PG8_STAGE(PG8_SA(0, 0), a2, voffA);
            PG8_WAIT_V(8); PG8_WAIT_L(0); PG8_BAR; PG8_MMA(1, 0, At, B0); PG8_MMA(1, 1, At, B1); PG8_BAR; PG8_SCHED;
            PG8_LDB(B0, 1, 0); PG8_LDB(B1, 1, 1); PG8_SCHED; PG8_LDA(At, 1, 0); PG8_STAGE(PG8_SA(0, 1), a2 + hstepA, voffA);
            PG8_WAIT_V(8); PG8_WAIT_L(0); PG8_BAR; PG8_MMA(0, 0, At, B0); PG8_MMA(0, 1, At, B1); PG8_BAR; PG8_SCHED;
            PG8_LDA(At, 1, 1); PG8_STAGE(PG8_SB(1, 0), b3, voffB); PG8_STAGE(PG8_SB(1, 1), b3 + hstepB, voffB); PG8_STAGE(PG8_SA(1, 0), a3, voffA);
            PG8_WAIT_V(8); PG8_WAIT_L(0); PG8_BAR; PG8_MMA(1, 0, At, B0); PG8_MMA(1, 1, At, B1); PG8_BAR; PG8_SCHED;
        }
        if constexpr (ALIGN_EPI) { if (wr == 0) PG8_BAR; }
        E(acc, cur, ui, wr, wc, fr, fq, lds + EPI_SCR);
        if (!has_next) break;
        E.init(acc, nxt, wr, wc, fr, fq);
        cur = nxt; cA = nA; cB = nB; ++ui;
        if constexpr (ALIGN_EPI) { if (wr == 1) PG8_BAR; }
    }
    PG8_WAIT_V(0);
    if constexpr (!ALIGN_EPI) { if (wr == 0) PG8_BAR; }
    PG8_BAR;
#undef PG8_SA
#undef PG8_SB
#undef PG8_STAGE
#undef PG8_LDA
#undef PG8_LDB
#undef PG8_MMA
#undef PG8_WAIT_V
#undef PG8_WAIT_L
#undef PG8_BAR
#undef PG8_SCHED
}

DI void zero_acc(f32x4 (&acc)[2][2][4][2]) {
#pragma unroll
    for (int a = 0; a < 2; ++a)
#pragma unroll
        for (int b = 0; b < 2; ++b)
#pragma unroll
            for (int m = 0; m < 4; ++m)
#pragma unroll
                for (int n = 0; n < 2; ++n) acc[a][b][m][n] = (f32x4){0.f, 0.f, 0.f, 0.f};
}
template <class Sched> DI void preload_rstd(const Sched& S, const float* ssq4, LAS unsigned char* tab) {
    const int t = otid(); Unit u;
    if (t < 256) for (int i = 0; i < EPI_RS_MAX && S.next(i, u); ++i) { const f32x4 p = *(const f32x4*)(ssq4 + (size_t)(u.pm * BM + t) * 4);
        ((LAS float*)tab)[i * 256 + t] = rsqrtf(((p[0] + p[1]) + (p[2] + p[3])) * (1.0f / 1024.0f) + EPS); }
}
DI void load_rstd(float (&rs)[2][4], LAS unsigned char* scr, int ui, int wr, int fr) {
    const LAS float* tab = (const LAS float*)(scr + 4096) + ui * 256 + wr * 64 + fr;
#pragma unroll
    for (int ai = 0; ai < 2; ++ai)
#pragma unroll
        for (int m = 0; m < 4; ++m) rs[ai][m] = tab[ai * HALF + m * 16];
}
DI u32x4 pack8(const f32x4 v0, const f32x4 v1) { u32x4 w; w.x = cvt_pk_bf16(v0[0], v0[1]); w.y = cvt_pk_bf16(v0[2], v0[3]); w.z = cvt_pk_bf16(v1[0], v1[1]); w.w = cvt_pk_bf16(v1[2], v1[3]); return w; }

template <bool SCALE> struct EpiSwiGLU {
    static constexpr bool PERM = true;
    bf16_t* O; const float* ssq4;
    template <class Sched> DI void preload(const Sched& S, LAS unsigned char* tab) const { if (SCALE) preload_rstd(S, ssq4, tab); }
    DI void init(f32x4 (&acc)[2][2][4][2], const Unit&, int, int, int, int) const { zero_acc(acc); }
    DI void operator()(const f32x4 (&acc)[2][2][4][2], const Unit& u, int ui, int wr, int wc, int fr_, int fq_, LAS unsigned char* scr) const {
        int l_ = fr_ + 16 * fq_; asm volatile("" : "+v"(l_)); const int fr = l_ & 15, fq = l_ >> 4;
        const int row0 = u.pm * BM + wr * 64 + fr, col0 = u.pn * 128 + wc * 32 + 8 * fq;
        float rs[2][4];
        if (SCALE) load_rstd(rs, scr, ui, wr, fr);
#pragma unroll
        for (int ai = 0; ai < 2; ++ai)
#pragma unroll
            for (int m = 0; m < 4; ++m) { const int row = row0 + ai * HALF + m * 16; const float r = SCALE ? rs[ai][m] : 1.0f;
                f32x4 o0, o1;
#pragma unroll
                for (int i = 0; i < 4; ++i) { o0[i] = silu_f(acc[ai][0][m][0][i] * r) * (acc[ai][1][m][0][i] * r); o1[i] = silu_f(acc[ai][0][m][1][i] * r) * (acc[ai][1][m][1][i] * r); }
                *(u32x4*)(O + (size_t)row * INC + col0) = pack8(o0, o1); }
    }
};
template <int MODE> struct EpiResid {
    static constexpr bool PERM = true;
    const float* R; float* out; bf16_t* XB; float* ssq4;
    template <class Sched> DI void preload(const Sched&, LAS unsigned char*) const {}
    DI void init(f32x4 (&acc)[2][2][4][2], const Unit& u, int wr, int wc, int fr_, int fq_) const {
        int l_ = fr_ + 16 * fq_; asm volatile("" : "+v"(l_)); const int fr = l_ & 15, fq = l_ >> 4;
        const int row0 = u.pm * BM + wr * 64 + fr, col0 = u.pn * BM + wc * 32 + 8 * fq;
        if (MODE == 0) {
#pragma unroll
            for (int ai = 0; ai < 2; ++ai)
#pragma unroll
                for (int m = 0; m < 4; ++m)
#pragma unroll
                    for (int bj = 0; bj < 2; ++bj) { const float* p = R + (size_t)(row0 + ai * HALF + m * 16) * D + col0 + bj * HALF;
                        acc[ai][bj][m][0] = *(const f32x4*)p; acc[ai][bj][m][1] = *(const f32x4*)(p + 4); }
        } else {
            u32x4 w[2][4][2];
#pragma unroll
            for (int ai = 0; ai < 2; ++ai)
#pragma unroll
                for (int m = 0; m < 4; ++m)
#pragma unroll
                    for (int bj = 0; bj < 2; ++bj) w[ai][m][bj] = *(const u32x4*)(XB + (size_t)(row0 + ai * HALF + m * 16) * D + col0 + bj * HALF);
#pragma unroll
            for (int ai = 0; ai < 2; ++ai)
#pragma unroll
                for (int m = 0; m < 4; ++m)
#pragma unroll
                    for (int bj = 0; bj < 2; ++bj) { const u32x4 x = w[ai][m][bj];
                        acc[ai][bj][m][0] = (f32x4){bf2f(x[0] & 0xffffu), bf2f(x[0] >> 16), bf2f(x[1] & 0xffffu), bf2f(x[1] >> 16)};
                        acc[ai][bj][m][1] = (f32x4){bf2f(x[2] & 0xffffu), bf2f(x[2] >> 16), bf2f(x[3] & 0xffffu), bf2f(x[3] >> 16)}; }
        }
    }
    DI void operator()(const f32x4 (&acc)[2][2][4][2], const Unit& u, int ui, int wr, int wc, int fr_, int fq_, LAS unsigned char* scr) const {
        int l_ = fr_ + 16 * fq_; asm volatile("" : "+v"(l_)); const int fr = l_ & 15, fq = l_ >> 4;
        const int col0 = u.pn * BM + wc * 32 + 8 * fq;
        LAS float* S = (LAS float*)scr;
#pragma unroll
        for (int ai = 0; ai < 2; ++ai)
#pragma unroll
            for (int m = 0; m < 4; ++m) { const int rl = ai * HALF + wr * 64 + m * 16 + fr; const int row = u.pm * BM + rl; float ss = 0.f;
#pragma unroll
                for (int bj = 0; bj < 2; ++bj) { const size_t off = (size_t)row * D + col0 + bj * HALF;
                    const f32x4 v0 = acc[ai][bj][m][0], v1 = acc[ai][bj][m][1];
                    if (MODE == 2) { *(f32x4*)(out + off) = v0; *(f32x4*)(out + off + 4) = v1; }
                    else { *(u32x4*)(XB + off) = pack8(v0, v1);
                        ss += (v0[0] * v0[0] + v0[1] * v0[1]) + (v0[2] * v0[2] + v0[3] * v0[3]) + (v1[0] * v1[0] + v1[1] * v1[1]) + (v1[2] * v1[2] + v1[3] * v1[3]); } }
                if (MODE != 2) { ss += __shfl_xor(ss, 16); ss += __shfl_xor(ss, 32); if (fq == 0) S[rl * 4 + wc] = ss; } }
        if (MODE != 2) {
            asm volatile("s_waitcnt lgkmcnt(0)" ::: "memory"); __builtin_amdgcn_s_barrier(); asm volatile("" ::: "memory");
            const int t = otid();
            if (t < 256) { const f32x4 p = *(const LAS f32x4*)(S + t * 4); ssq4[(size_t)(u.pm * BM + t) * 4 + u.pn] = (p[0] + p[1]) + (p[2] + p[3]); }
        }
    }
};
template <bool SCALE> struct EpiPlain {
    static constexpr bool PERM = true;
    bf16_t* O; int ldc; const float* ssq4;
    template <class Sched> DI void preload(const Sched& S, LAS unsigned char* tab) const { if (SCALE) preload_rstd(S, ssq4, tab); }
    DI void init(f32x4 (&acc)[2][2][4][2], const Unit&, int, int, int, int) const { zero_acc(acc); }
    DI void operator()(const f32x4 (&acc)[2][2][4][2], const Unit& u, int ui, int wr, int wc, int fr_, int fq_, LAS unsigned char* scr) const {
        int l_ = fr_ + 16 * fq_; asm volatile("" : "+v"(l_)); const int fr = l_ & 15, fq = l_ >> 4;
        const int row0 = u.pm * BM + wr * 64 + fr, col0 = u.pn * BM + wc * 32 + 8 * fq;
        float rs[2][4];
        if (SCALE) load_rstd(rs, scr, ui, wr, fr);
#pragma unroll
        for (int ai = 0; ai < 2; ++ai)
#pragma unroll
            for (int m = 0; m < 4; ++m) { const int row = row0 + ai * HALF + m * 16; const float r = SCALE ? rs[ai][m] : 1.0f;
#pragma unroll
                for (int bj = 0; bj < 2; ++bj) *(u32x4*)(O + (size_t)row * ldc + col0 + bj * HALF) = pack8(acc[ai][bj][m][0] * r, acc[ai][bj][m][1] * r); }
    }
};
struct EpiInProj {
    static constexpr bool PERM = true;
    bf16_t* O; const float* ssq4; const float* cosA; const float* sinA; const float* cosR; const float* sinR;
    template <class Sched> DI void preload(const Sched& S, LAS unsigned char* tab) const { preload_rstd(S, ssq4, tab); }
    DI void init(f32x4 (&acc)[2][2][4][2], const Unit&, int, int, int, int) const { zero_acc(acc); }
    DI void operator()(const f32x4 (&acc)[2][2][4][2], const Unit& u, int ui, int wr, int wc, int fr_, int fq_, LAS unsigned char* scr) const {
        int l_ = fr_ + 16 * fq_; asm volatile("" : "+v"(l_)); const int fr = l_ & 15, fq = l_ >> 4;
        const int row0 = u.pm * BM + wr * 64 + fr, col0 = u.pn * BM + wc * 32 + 8 * fq;
        const int kind = (u.pn < 4) ? 1 : ((u.pn == 6 || u.pn == 7) ? 2 : 0);
        const bool second = (fq & 1) != 0;
        const bool active = (kind == 2) || (kind == 1 && (wc & 1) == 0 && fq < 2);
        const int b16 = 2 * (wc & 1) + (fq >> 1);
        float rs[2][4];
        load_rstd(rs, scr, ui, wr, fr);
        float irev[8];
        { const float l2t = (kind == 1) ? 18.931568569324174f   : 13.287712379549449f  ; const float inv_half = (kind == 1) ? 0.125f : 0.03125f; const int c0 = (kind == 1) ? 0 : 8 * b16;
#pragma unroll
          for (int i = 0; i < 8; ++i) irev[i] = fast_exp2(-l2t * (float)(c0 + i) * inv_half) * 0.15915494309189535f; }
#pragma unroll
        for (int g2 = 0; g2 < 8; ++g2) {
            const int ai = g2 >> 2, m = g2 & 3; const int row = row0 + ai * HALF + m * 16; const float r = rs[ai][m];
            f32x4 c0 = {0.f, 0.f, 0.f, 0.f}, c1 = c0, s0 = c0, s1 = c0;
            if (active) { const float tf = (float)(row & (SEQ - 1));
#pragma unroll
                for (int i = 0; i < 4; ++i) { const float ra = __builtin_amdgcn_fractf(tf * irev[i]), rb = __builtin_amdgcn_fractf(tf * irev[4 + i]);
                    c0[i] = __builtin_amdgcn_cosf(ra); s0[i] = __builtin_amdgcn_sinf(ra); c1[i] = __builtin_amdgcn_cosf(rb); s1[i] = __builtin_amdgcn_sinf(rb); } }
#pragma unroll
                for (int bj = 0; bj < 2; ++bj) { f32x4 v0 = acc[ai][bj][m][0] * r, v1 = acc[ai][bj][m][1] * r;
                    if (kind != 0) { f32x4 p0, p1;
#pragma unroll
                        for (int i = 0; i < 4; ++i) {
                            const auto x0 = __builtin_amdgcn_permlane16_swap(__float_as_uint(v0[i]), __float_as_uint(v0[i]), false, false);
                            const auto x1 = __builtin_amdgcn_permlane16_swap(__float_as_uint(v1[i]), __float_as_uint(v1[i]), false, false);
                            p0[i] = __uint_as_float(second ? x0[0] : x0[1]); p1[i] = __uint_as_float(second ? x1[0] : x1[1]); }
                        const f32x4 r0 = second ? (p0 * s0 + v0 * c0) : (v0 * c0 - p0 * s0);
                        const f32x4 r1 = second ? (p1 * s1 + v1 * c1) : (v1 * c1 - p1 * s1);
                        if (active) { v0 = r0; v1 = r1; } }
                    { const int ct = bj * HALF + wc * 32 + 8 * fq, b = row / SEQ, t = row & (SEQ - 1); size_t off;
                      if (u.pn < 6) { const int cs = (u.pn & 1) * 256 + ct; off = hm_off(512 * (u.pn >> 1), 8, 64, b, cs >> 6, t) + (cs & 63); }
                      else if (u.pn < 8) off = hm_off(1536 + 256 * (u.pn - 6), 4, 64, b, ct >> 6, t) + (ct & 63);
                      else { const int cs = (u.pn & 1) * 256 + ct; off = hm_off(2048 + 512 * ((u.pn - 8) >> 1), 4, 128, b, cs >> 7, t) + (cs & 127); }
                      *(u32x4*)(O + off) = pack8(v0, v1); } }
        }
    }
};
}

constexpr size_t MiB = 1u << 20;
constexpr size_t al(size_t x) { return (x + 255) & ~(size_t)255; }
constexpr size_t WS_CTL = 0, CTL_ZERO_BYTES = 262144;
constexpr size_t WS_W1IN = 1 * MiB;
constexpr size_t WS_W1OUT = WS_W1IN + (size_t)2 * DFF * D * 2;
constexpr size_t WS_WIN = WS_W1OUT + (size_t)D * DFF * 2;
constexpr size_t WS_WOUT = WS_WIN + (size_t)INC * D * 2;
constexpr size_t WS_WCQ = WS_WOUT + (size_t)D * D * 2;
constexpr size_t WS_WCKV = WS_WCQ + (size_t)D * D * 2;
constexpr size_t WS_WCO = WS_WCKV + (size_t)2 * D * D * 2;
constexpr size_t WS_W2IN = WS_WCO + (size_t)D * D * 2;
constexpr size_t WS_W2OUT = WS_W2IN + (size_t)2 * DFF * D * 2;
constexpr size_t WS_TAB = WS_W2OUT + (size_t)D * DFF * 2;
constexpr size_t WS_COSA = WS_TAB, WS_SINA = WS_COSA + (size_t)SEQ * 8 * 4, WS_COSR = WS_SINA + (size_t)SEQ * 8 * 4, WS_SINR = WS_COSR + (size_t)SEQ * 32 * 4;
constexpr size_t WS_MEMN = WS_SINR + (size_t)SEQ * 32 * 4;
constexpr size_t WS_KC = WS_MEMN + (size_t)MROWS * D * 2;
constexpr size_t WS_VT = WS_KC + (size_t)MROWS * D * 2;
constexpr size_t WS_SSQ = WS_VT + (size_t)MROWS * D * 2;
constexpr size_t WS_XB = al(WS_SSQ + (size_t)M * 16 * 4);
constexpr size_t WS_BIG = WS_XB + (size_t)M * D * 2;
constexpr size_t WS_OMIX = WS_BIG + (size_t)M * INC * 2;
constexpr size_t WS_ATT = WS_OMIX + (size_t)M * D * 2;
constexpr size_t WS_ATT_BYTES = (size_t)M * 512 * 2 * 3 + (size_t)M * 8 * 4 * 3;
constexpr size_t WS_RET = WS_ATT + WS_ATT_BYTES;
constexpr size_t WS_XRES = WS_RET + (size_t)NBATCH * 64 * 4 * 64 * 128 * 4;
constexpr size_t WS_OPT_END = WS_XRES;

constexpr int RING_OFF = 0, RING_BYTES = 131072;
constexpr int LDSCTL_OFF = 163840 - 256, MISC_OFF = LDSCTL_OFF;
constexpr int LDS_BYTES = 163840;
constexpr int NWAVES = 8;

#define XB_TMO      128
#define XB_XCNT(j)  (256  + 64 * (j))
#define XB_XSUB(j)  (1280 + 64 * (j))
#define XB_XGEN(j)  (2304 + 64 * (j))
#define XB_TOP      3328
#define XB_TOPGEN   3392
#define XCD_BAR_WORDS 3456
#define XB_SPIN_CAP (1u << 18)
DI unsigned xb_ld(unsigned* p)              { return __hip_atomic_load(p, __ATOMIC_RELAXED, __HIP_MEMORY_SCOPE_AGENT); }
DI unsigned xb_add(unsigned* p, unsigned v) { return __hip_atomic_fetch_add(p, v, __ATOMIC_RELAXED, __HIP_MEMORY_SCOPE_AGENT); }
DI unsigned xb_xcc_id() { return (unsigned)__builtin_amdgcn_s_getreg((3 << 11) | 20) & 0xFu; }
#define XB_SPIN(cond, bar) do { unsigned _sp = 0; while (cond) { __builtin_amdgcn_s_sleep(1); \
    if ((++_sp & 255u) == 0u) { if (xb_ld(&(bar)[XB_TMO])) break; if (_sp > XB_SPIN_CAP) { atomicAdd(&(bar)[XB_TMO], 1u); break; } } } } while (0)
struct XcdBarrier { unsigned* bar; unsigned x; volatile LAS unsigned* st; unsigned n; };
DI XcdBarrier xcd_barrier_post(unsigned* bar, volatile LAS unsigned* st, unsigned n) {
    XcdBarrier b; b.bar = bar; b.x = xb_xcc_id(); b.st = st; b.n = n;
    if (threadIdx.x == 0) (void)xb_add(&bar[XB_XCNT(b.x)], 1u);
    return b;
}
DI void xcd_barrier_complete(unsigned* bar, unsigned x, unsigned G, unsigned& nloc, unsigned& nx) {
    unsigned sum, cnt, mine, sp = 0u;
    for (;;) {
        sum = 0u; cnt = 0u; mine = 0u;
#pragma unroll
        for (unsigned j = 0; j < 16; ++j) { const unsigned c = xb_ld(&bar[XB_XCNT(j)]); sum += c; cnt += (c > 0u) ? 1u : 0u; mine = (j == x) ? c : mine; }
        if (sum == G) break;
        __builtin_amdgcn_s_sleep(1);
        if ((++sp & 255u) == 0u) { if (xb_ld(&bar[XB_TMO])) break; if (sp > XB_SPIN_CAP) { atomicAdd(&bar[XB_TMO], 1u); break; } }
    }
    nloc = mine > 0u ? mine : 1u; nx = cnt > 0u ? cnt : 1u;
}
DI void xcd_barrier(const XcdBarrier& b) {
    asm volatile("s_waitcnt vmcnt(0)" ::: "memory");
    __syncthreads();
    if (threadIdx.x == 0) {
        unsigned* bar = b.bar;
        __builtin_amdgcn_s_waitcnt(0);
        unsigned nloc = b.st[0], nx = b.st[1];
        if (nloc == 0u) { xcd_barrier_complete(bar, b.x, b.n, nloc, nx); b.st[0] = nloc; b.st[1] = nx; }
        const unsigned old = xb_add(&bar[XB_XSUB(b.x)], 1u);
        const unsigned gen = old / nloc;
        if (old + 1u == (gen + 1u) * nloc) {
            if (nx > 1u) {
            __builtin_amdgcn_fence(__ATOMIC_RELEASE, "agent");
            asm volatile("s_waitcnt vmcnt(0)" ::: "memory"); }
            const unsigned og = xb_add(&bar[XB_TOP], 1u);
            const unsigned tg = og / nx;
            if (og + 1u == (tg + 1u) * nx) xb_add(&bar[XB_TOPGEN], 1u);
            else XB_SPIN(xb_ld(&bar[XB_TOPGEN]) == tg, bar);
            __builtin_amdgcn_fence(__ATOMIC_ACQUIRE, "agent");
            xb_add(&bar[XB_XGEN(b.x)], 1u);
            asm volatile("s_waitcnt vmcnt(0)" ::: "memory");
        } else {
            XB_SPIN(xb_ld(&bar[XB_XGEN(b.x)]) == gen, bar);
            __builtin_amdgcn_fence(__ATOMIC_ACQUIRE, "agent");
            asm volatile("s_waitcnt vmcnt(0)" ::: "memory");
        }
    }
    __syncthreads();
}
constexpr int CW_BAR = 4096;

struct Args {
    const float* in[17]; float* out; unsigned char* ws; float* xres;
    int ph_lo, ph_hi;
};

DI float wave_sum(float v) {
#pragma unroll
    for (int o = 1; o < 64; o <<= 1) v += __shfl_xor(v, o);
    return v;
}
DI float wave_max(float v) {
#pragma unroll
    for (int o = 1; o < 64; o <<= 1) v = fmaxf(v, __shfl_xor(v, o));
    return v;
}

DI int wmap_row(int mat, int n) {
    if (mat == 0 || mat == 7) { const int u = n >= DFF, j = u ? n - DFF : n; return 256 * (j >> 7) + 128 * u + (j & 127); }
    if (mat == 2 && n >= 1536 && n < 2048) { const int c = n & 63, x2 = c >> 5, cc = c & 31; return (n - c) + 16 * (cc >> 3) + 8 * x2 + (cc & 7); }
    return n;
}
DI float wmap_scale(int mat, int n) {
    if (mat == 2) return (n < 512) ? 0.125f * LOG2E : ((n >= 1792 && n < 2048) ? 0.125f : 1.0f);
    if (mat == 4) return 0.0625f * LOG2E;
    if (mat == 1 || mat == 8) return 0.5f;
    return 1.0f;
}
DI void p0_transpose_item(const float* W, int K, int N, bf16_t* WT, int mat, const float* nw, LAS float* scr, int item, int lane) {
    const int nblk = N / 32, kb = item / nblk, nb = item % nblk, k0 = 64 * kb, n0 = 32 * nb;
    float wv[32];
#pragma unroll
    for (int i = 0; i < 32; ++i) wv[i] = W[(size_t)(k0 + 2 * i + (lane >> 5)) * N + n0 + (lane & 31)];
    const float s0 = nw ? nw[k0 + (lane & 31) * 2 + 0] : 1.0f, s1 = nw ? nw[k0 + (lane & 31) * 2 + 1] : 1.0f;
#pragma unroll
    for (int i = 0; i < 32; ++i) { const float sl = __shfl(s0, i), sh = __shfl(s1, i); const int kk = 2 * i + (lane >> 5); scr[kk * 33 + (lane & 31)] = wv[i] * ((lane >> 5) ? sh : sl); }
    asm volatile("s_waitcnt lgkmcnt(0)" ::: "memory");
    const int c = lane & 7;
#pragma unroll
    for (int j = 0; j < 4; ++j) { const int n = (lane >> 3) + 8 * j; const LAS float* s = scr + (8 * c) * 33 + n; const float sc = wmap_scale(mat, n0 + n);
        u32x4 o; o.x = cvt_pk_bf16(s[0 * 33] * sc, s[1 * 33] * sc); o.y = cvt_pk_bf16(s[2 * 33] * sc, s[3 * 33] * sc); o.z = cvt_pk_bf16(s[4 * 33] * sc, s[5 * 33] * sc); o.w = cvt_pk_bf16(s[6 * 33] * sc, s[7 * 33] * sc);
        *(u32x4*)(WT + (size_t)wmap_row(mat, n0 + n) * K + k0 + 8 * c) = o; }
    asm volatile("s_waitcnt lgkmcnt(0)" ::: "memory");
}
DI void rms_row_to_bf16(const float* xrow, const float* w, bf16_t* orow, int lane) {
    const f32x4* xr = (const f32x4*)xrow + lane;
    f32x4 v[4]; float s = 0.f;
#pragma unroll
    for (int j = 0; j < 4; ++j) { v[j] = xr[64 * j]; s += (v[j][0] * v[j][0] + v[j][1] * v[j][1]) + (v[j][2] * v[j][2] + v[j][3] * v[j][3]); }
    const float r = rsqrtf(wave_sum(s) * (1.f / D) + EPS);
    u32x2* o8 = (u32x2*)orow + lane;
#pragma unroll
    for (int j = 0; j < 4; ++j) { const f32x4 ww = ((const f32x4*)w)[lane + 64 * j]; u32x2 o; o.x = cvt_pk_bf16(v[j][0] * r * ww[0], v[j][1] * r * ww[1]); o.y = cvt_pk_bf16(v[j][2] * r * ww[2], v[j][3] * r * ww[3]); o8[64 * j] = o; }
}

DI void rms_row2_to_bf16(const float* xa, const float* xb, const float* w, bf16_t* oa, bf16_t* ob, int lane) {
    const f32x4* ra = (const f32x4*)xa + lane; const f32x4* rb = (const f32x4*)(xb ? xb : xa) + lane;
    f32x4 va[4], vb[4]; float sa = 0.f, sb = 0.f;
#pragma unroll
    for (int j = 0; j < 4; ++j) { va[j] = ra[64 * j]; vb[j] = rb[64 * j]; }
#pragma unroll
    for (int j = 0; j < 4; ++j) { sa += (va[j][0] * va[j][0] + va[j][1] * va[j][1]) + (va[j][2] * va[j][2] + va[j][3] * va[j][3]); sb += (vb[j][0] * vb[j][0] + vb[j][1] * vb[j][1]) + (vb[j][2] * vb[j][2] + vb[j][3] * vb[j][3]); }
    const float r0 = rsqrtf(wave_sum(sa) * (1.f / D) + EPS), r1 = rsqrtf(wave_sum(sb) * (1.f / D) + EPS);
    u32x2* pa = (u32x2*)oa + lane; u32x2* pb = (u32x2*)ob + lane;
#pragma unroll
    for (int j = 0; j < 4; ++j) { const f32x4 ww = ((const f32x4*)w)[lane + 64 * j];
        u32x2 o; o.x = cvt_pk_bf16(va[j][0] * r0 * ww[0], va[j][1] * r0 * ww[1]); o.y = cvt_pk_bf16(va[j][2] * r0 * ww[2], va[j][3] * r0 * ww[3]); pa[64 * j] = o;
        if (xb) { u32x2 p; p.x = cvt_pk_bf16(vb[j][0] * r1 * ww[0], vb[j][1] * r1 * ww[1]); p.y = cvt_pk_bf16(vb[j][2] * r1 * ww[2], vb[j][3] * r1 * ww[3]); pb[64 * j] = p; } }
}

namespace da {
typedef float f32x16 __attribute__((ext_vector_type(16)));
typedef short s16x4 __attribute__((ext_vector_type(4)));
typedef __bf16 bf16x2_t __attribute__((ext_vector_type(2)));
constexpr int K_OFF = 0, V_OFF = 49152, V_D0 = 24640, OST_OFF = V_OFF + V_D0 + 24576;
static_assert(OST_OFF + 8 * 4096 <= MISC_OFF, "attention LDS map");
DI int crow(int r, int hi) { return (r & 3) + 8 * (r >> 2) + 4 * hi; }
DI unsigned cvtpk(float lo, float hi) { f32x2 v = {lo, hi}; bf16x2_t b = __builtin_convertvector(v, bf16x2_t); return __builtin_bit_cast(unsigned, b); }
DI s16x4 vtr(LAS unsigned char* p) { return __builtin_bit_cast(s16x4, __builtin_amdgcn_ds_read_tr16_b64_v4i16((LAS s16x4*)p)); }
struct Dec { int b, h, g, d, r, blk; };
DI Dec decode(int uid) { Dec u; const int u32i = uid & 31, ghb = uid >> 5; u.g = ghb % 3; const int bh = ghb / 3; u.h = bh & 7; u.b = bh >> 3;
    u.d = (u.g == 0) ? 1 : ((u.g == 1) ? 4 : 16); const int nblk = 32 / u.d; u.blk = u32i % nblk; u.r = u32i / nblk; return u; }
struct Regs { u32x4 k[6], v[6], q[4]; };
DI void load_regs(Regs& R, const Dec& u, const bf16_t* proj, int tid) {
    const int lane = tid & 63, w = tid >> 6;
#pragma unroll
    for (int i = 0; i < 6; ++i) { const int id = tid + 512 * i, uk = id >> 3, c = id & 7; int sk = 256 * u.blk - 128 + uk; sk = sk < 0 ? 0 : sk;
        const size_t ro = hm_off(0, 8, 64, u.b, u.h, sk * u.d + u.r) + 8 * c;
        R.k[i] = *(const u32x4*)(proj + (size_t)SEQ * 512 + ro); R.v[i] = *(const u32x4*)(proj + (size_t)SEQ * 1024 + ro); }
    const int s = 256 * u.blk + 32 * w + (lane & 31);
    const bf16_t* qp = proj + hm_off(0, 8, 64, u.b, u.h, s * u.d + u.r) + 8 * (lane >> 5);
#pragma unroll
    for (int ks = 0; ks < 4; ++ks) R.q[ks] = *(const u32x4*)(qp + 16 * ks);
}
DI void write_lds(const Regs& R, const Dec& u, LAS unsigned char* lds, int tid) {
#pragma unroll
    for (int i = 0; i < 6; ++i) { const int id = tid + 512 * i, uk = id >> 3, c = id & 7; const bool valid = (u.blk > 0) || (uk >= 128);
        const u32x4 z = {0u, 0u, 0u, 0u};
        *(LAS u32x4*)(lds + K_OFF + 128 * uk + 16 * (c ^ ((uk >> 1) & 7))) = valid ? R.k[i] : z;
        *(LAS u32x4*)(lds + V_OFF + (c >> 2) * V_D0 + 64 * uk + 16 * (c & 3)) = valid ? R.v[i] : z; }
}
DI void qk_part(f32x16 (&S)[5], const Regs& R, LAS unsigned char* lds, int tid) {
    const int lane = tid & 63, w = __builtin_amdgcn_readfirstlane(tid >> 6), q = lane & 31, hi = lane >> 5;
#pragma unroll
    for (int j = 0; j < 5; ++j) {
        const int uk = 32 * (w + j) + q;
        f32x16 acc;
#pragma unroll
        for (int r = 0; r < 16; ++r) acc[r] = 0.f;
#pragma unroll
        for (int ks = 0; ks < 4; ++ks) { const bf16x8 kf = *(const LAS bf16x8*)(lds + K_OFF + 128 * uk + 16 * ((2 * ks + hi) ^ ((uk >> 1) & 7)));
            acc = __builtin_amdgcn_mfma_f32_32x32x16_bf16(kf, __builtin_bit_cast(bf16x8, R.q[ks]), acc, 0, 0, 0); }
        S[j] = acc;
    }
}
DI void softmax_part(f32x16 (&S)[5], u32x4 (&Pk)[5][2], float& m_out, float& l_out, const Dec& u, int tid) {
    const int lane = tid & 63, w = __builtin_amdgcn_readfirstlane(tid >> 6), q = lane & 31, hi = lane >> 5;
    float m = -1e30f;
#pragma unroll
    for (int r = 0; r < 16; ++r) { const int kk = crow(r, hi); if (kk < q) S[0][r] = -1e30f; if (kk > q) S[4][r] = -1e30f; }
    if (u.blk == 0) {
#pragma unroll
        for (int j = 0; j < 4; ++j) if (w + j < 4) {
#pragma unroll
            for (int r = 0; r < 16; ++r) S[j][r] = -1e30f; }
    }
#pragma unroll
    for (int j = 0; j < 5; ++j)
#pragma unroll
        for (int r = 0; r < 16; ++r) m = fmaxf(m, S[j][r]);
    m = fmaxf(m, __shfl_xor(m, 32));
    float l = 0.f;
#pragma unroll
    for (int j = 0; j < 5; ++j) {
#pragma unroll
        for (int r = 0; r < 16; ++r) { const float p = fast_exp2(S[j][r] - m); S[j][r] = p; l += p; }
#pragma unroll
        for (int s2 = 0; s2 < 2; ++s2) { u32x4 pw; pw.x = cvtpk(S[j][8 * s2 + 0], S[j][8 * s2 + 1]); pw.y = cvtpk(S[j][8 * s2 + 2], S[j][8 * s2 + 3]); pw.z = cvtpk(S[j][8 * s2 + 4], S[j][8 * s2 + 5]); pw.w = cvtpk(S[j][8 * s2 + 6], S[j][8 * s2 + 7]); Pk[j][s2] = pw; }
    }
    l += __shfl_xor(l, 32);
    m_out = m; l_out = l;
}
DI void pv_part(const u32x4 (&Pk)[5][2], float m, float l, const Dec& u, LAS unsigned char* lds, bf16_t* part, float* lsep, int tid) {
    const int lane = tid & 63, w = __builtin_amdgcn_readfirstlane(tid >> 6), q = lane & 31, hi = lane >> 5;
    f32x16 o[2];
#pragma unroll
    for (int r = 0; r < 16; ++r) { o[0][r] = 0.f; o[1][r] = 0.f; }
    const int vlane = ((lane >> 4) & 1) * 32 + (lane & 3) * 8 + (4 * hi + ((lane & 15) >> 2)) * 64;
#pragma unroll
    for (int j = 0; j < 5; ++j)
#pragma unroll
        for (int s2 = 0; s2 < 2; ++s2) {
            const bf16x8 pa = __builtin_bit_cast(bf16x8, Pk[j][s2]);
#pragma unroll
            for (int d0 = 0; d0 < 2; ++d0) { LAS unsigned char* vp = lds + V_OFF + d0 * V_D0 + (32 * (w + j) + 16 * s2) * 64 + vlane;
                const s16x4 lo = vtr(vp), hi4 = vtr(vp + 512);
                const bf16x8 vf = {lo[0], lo[1], lo[2], lo[3], hi4[0], hi4[1], hi4[2], hi4[3]};
                o[d0] = __builtin_amdgcn_mfma_f32_32x32x16_bf16(pa, vf, o[d0], 0, 0, 0); }
        }
    const float linv = fast_rcp(l);
    LAS bf16_t* stg = (LAS bf16_t*)(lds + OST_OFF + w * 4096);
#pragma unroll
    for (int r = 0; r < 16; ++r) { const int orow = crow(r, hi); const float li = __shfl(linv, orow);
#pragma unroll
        for (int d0 = 0; d0 < 2; ++d0) stg[orow * 64 + d0 * 32 + q] = (bf16_t)(cvtpk(o[d0][r] * li, 0.f) & 0xffffu); }
    asm volatile("s_waitcnt lgkmcnt(0)" ::: "memory");
    const int s0 = 256 * u.blk + 32 * w;
#pragma unroll
    for (int i = 0; i < 4; ++i) { const int row = i * 8 + (lane >> 3), ch = lane & 7; const u32x4 v = *(const LAS u32x4*)(stg + row * 64 + ch * 8);
        *(u32x4*)(part + (size_t)(u.b * SEQ + (s0 + row) * u.d + u.r) * 512 + u.h * 64 + ch * 8) = v; }
    if (hi == 0) lsep[(size_t)(u.b * SEQ + (s0 + q) * u.d + u.r) * 8 + u.h] = m + __log2f(l);
}
struct UnitMap { int x, j, GX, NP, per, n, nk;
    DI void init(int x_, int j_, int GX_, int npairs, int nk_) { x = x_; j = j_; GX = GX_; NP = npairs; nk = (nk_ > 0 && GX_ == 32 && nk_ == 8) ? nk_ : 0; per = nk ? 4 : (96 + GX - 1) / GX; n = NP * per; }
    DI int uid(int i) const { const int p = i / per, s = i % per; int k;
        if (nk) { if (s < 3) k = (p == 0 && j < nk) ? 96 : 3 * j + s; else k = (p == 0 && j >= nk) ? j - nk : 96; }
        else k = j * per + s;
        return (k < 96) ? (x * NP + p) * 96 + k : -1; } };
DI void phase(LAS unsigned char* lds, const bf16_t* proj, bf16_t* attp, float* lse, const UnitMap& U) {
    int i = 0; while (i < U.n && U.uid(i) < 0) ++i;
    if (i >= U.n) return;
    Regs R; Dec cur = decode(U.uid(i));
    load_regs(R, cur, proj, otid());
    while (i < U.n) {
        int in = i + 1; while (in < U.n && U.uid(in) < 0) ++in;
        write_lds(R, cur, lds, otid());
        Regs Qc;
#pragma unroll
        for (int k = 0; k < 4; ++k) Qc.q[k] = R.q[k];
        __syncthreads();
        Dec nxt = cur;
        if (in < U.n) { nxt = decode(U.uid(in)); load_regs(R, nxt, proj, otid()); }
        u32x4 Pk[5][2]; float m, l;
        {   f32x16 S[5];
            qk_part(S, Qc, lds, otid());
            softmax_part(S, Pk, m, l, cur, otid()); }
        pv_part(Pk, m, l, cur, lds, attp + (size_t)cur.g * M * 512, lse + (size_t)cur.g * M * 8, otid());
        __syncthreads();
        cur = nxt; i = in;
    }
}
DI void merge(const bf16_t* attp, const float* lse, bf16_t* omix, int row_lo, int nrows, int gtid, int ngt) {
    for (int i = gtid; i < nrows * 64; i += ngt) {
        const int row = row_lo + (i >> 6), h = (i >> 3) & 7, c = i & 7;
        const float l0 = lse[(size_t)row * 8 + h], l1 = lse[(size_t)M * 8 + (size_t)row * 8 + h], l2 = lse[(size_t)2 * M * 8 + (size_t)row * 8 + h];
        const float mm = fmaxf(fmaxf(l0, l1), l2);
        float w0 = fast_exp2(l0 - mm), w1 = fast_exp2(l1 - mm), w2 = fast_exp2(l2 - mm);
        const float inv = fast_rcp(w0 + w1 + w2); w0 *= inv; w1 *= inv; w2 *= inv;
        const size_t off = (size_t)row * 512 + h * 64 + c * 8;
        const u32x4 a = *(const u32x4*)(attp + off), b = *(const u32x4*)(attp + (size_t)M * 512 + off), cc = *(const u32x4*)(attp + (size_t)2 * M * 512 + off);
        u32x4 o;
#pragma unroll
        for (int k = 0; k < 4; ++k) { const float lo = w0 * bf2f(a[k] & 0xffffu) + w1 * bf2f(b[k] & 0xffffu) + w2 * bf2f(cc[k] & 0xffffu);
            const float hi = w0 * bf2f(a[k] >> 16) + w1 * bf2f(b[k] >> 16) + w2 * bf2f(cc[k] >> 16); o[k] = cvt_pk_bf16(lo, hi); }
        *(u32x4*)(omix + (size_t)row * D + h * 64 + c * 8) = o;
    }
}
}


namespace xa {
using da::f32x16; using da::s16x4; using da::crow; using da::cvtpk; using da::vtr;
constexpr int KB = 0, VB = 65536, VB_STRIDE = 32832, V_D0 = 16384 + 64, OST = 32768;
static_assert(VB + 2 * VB_STRIDE <= MISC_OFF, "cross-attention LDS map");
struct St { u32x4 sr[2][4]; u32x4 q[4]; };
DI void dec(int uid, int& b, int& h, int& qblk) { qblk = uid & 31; h = (uid >> 5) & 3; b = uid >> 7; }
DI const bf16_t* q_ptr(int i, int u_lo, const bf16_t* qc, int tid) { int b, h, qblk; dec(u_lo + (i >> 3), b, h, qblk); const int lane = tid & 63, w = tid >> 6;
    return qc + (size_t)(b * SEQ + 256 * qblk + 32 * w + (lane & 31)) * INC + h * 256 + 64 * (i & 7) + 8 * (lane >> 5); }
template <int PAR> DI void stage_load(St& T, int i, int total, int u_lo, const bf16_t* kvc, int tid) {
    if (i >= total) return;
    const int st = i & 7; int b, h, qblk; dec(u_lo + (i >> 3), b, h, qblk);
    const int coff = (st < 4) ? (h * 256 + 64 * st) : (1024 + h * 256 + 64 * (st - 4));
#pragma unroll
    for (int k = 0; k < 4; ++k) { const int id = tid + 512 * k, m = id >> 3, ch = id & 7; T.sr[PAR][k] = *(const u32x4*)(kvc + (size_t)(b * MEMLEN + m) * 2048 + coff + 8 * ch); }
}
template <int PAR> DI void stage_write(const St& T, int i, int total, LAS unsigned char* lds, int tid) {
    if (i >= total) return;
    const int st = i & 7;
    if (st < 4) {
#pragma unroll
        for (int k = 0; k < 4; ++k) { const int id = tid + 512 * k, m = id >> 3, ch = id & 7; *(LAS u32x4*)(lds + KB + (st & 1) * 32768 + 128 * m + 16 * (ch ^ ((m >> 1) & 7))) = T.sr[PAR][k]; }
    } else {
#pragma unroll
        for (int k = 0; k < 4; ++k) { const int id = tid + 512 * k, m = id >> 3, ch = id & 7; *(LAS u32x4*)(lds + VB + (st & 1) * VB_STRIDE + (ch >> 2) * V_D0 + 64 * m + 16 * (ch & 3)) = T.sr[PAR][k]; }
    }
}
template <int st> DI void k_stage(St& T, f32x16 (&S)[8], int i, int u_lo, LAS unsigned char* lds, const bf16_t* qc, int tid) {
    const int lane = tid & 63, q = lane & 31, hi = lane >> 5;
    LAS unsigned char* kb = lds + KB + (st & 1) * 32768;
    const bf16_t* qn = q_ptr(i + 1, u_lo, qc, tid);
#pragma unroll
    for (int ks = 0; ks < 4; ++ks) { const bf16x8 qf = __builtin_bit_cast(bf16x8, T.q[ks]);
#pragma unroll
        for (int kt = 0; kt < 8; ++kt) { const int uk = 32 * kt + q;
            const bf16x8 kf = *(const LAS bf16x8*)(kb + 128 * uk + 16 * ((2 * ks + hi) ^ ((uk >> 1) & 7)));
            S[kt] = __builtin_amdgcn_mfma_f32_32x32x16_bf16(kf, qf, S[kt], 0, 0, 0); }
        if (st < 3) T.q[ks] = *(const u32x4*)(qn + 16 * ks); }
}
DI void softmax(f32x16 (&S)[8], u32x4 (&Pk)[8][2], float& linv) {
    float m = -1e30f;
#pragma unroll
    for (int kt = 0; kt < 8; ++kt)
#pragma unroll
        for (int r = 0; r < 16; ++r) m = fmaxf(m, S[kt][r]);
    m = fmaxf(m, __shfl_xor(m, 32));
    float l = 0.f;
#pragma unroll
    for (int kt = 0; kt < 8; ++kt) {
#pragma unroll
        for (int r = 0; r < 16; ++r) { const float p = fast_exp2(S[kt][r] - m); S[kt][r] = p; l += p; }
#pragma unroll
        for (int s2 = 0; s2 < 2; ++s2) { u32x4 pw; pw.x = cvtpk(S[kt][8 * s2 + 0], S[kt][8 * s2 + 1]); pw.y = cvtpk(S[kt][8 * s2 + 2], S[kt][8 * s2 + 3]); pw.z = cvtpk(S[kt][8 * s2 + 4], S[kt][8 * s2 + 5]); pw.w = cvtpk(S[kt][8 * s2 + 6], S[kt][8 * s2 + 7]); Pk[kt][s2] = pw; }
    }
    l += __shfl_xor(l, 32);
    linv = fast_rcp(l);
}
template <int st> DI void v_stage(St& T, const u32x4 (&Pk)[8][2], float linv, int i, int total, int u_lo, LAS unsigned char* lds, const bf16_t* qc, bf16_t* oc, int tid) {
    const int lane = tid & 63, w = __builtin_amdgcn_readfirstlane(tid >> 6), q = lane & 31, hi = lane >> 5;
    const int vc = st - 4; int b, h, qblk; dec(u_lo + (i >> 3), b, h, qblk);
    if (st == 7 && i + 1 < total) { const bf16_t* qn = q_ptr(i + 1, u_lo, qc, tid);
#pragma unroll
        for (int ks = 0; ks < 4; ++ks) T.q[ks] = *(const u32x4*)(qn + 16 * ks); }
    LAS unsigned char* vb = lds + VB + (st & 1) * VB_STRIDE;
    const int vlane = ((lane >> 4) & 1) * 32 + (lane & 3) * 8 + (4 * hi + ((lane & 15) >> 2)) * 64;
    f32x16 o[2];
#pragma unroll
    for (int r = 0; r < 16; ++r) { o[0][r] = 0.f; o[1][r] = 0.f; }
#pragma unroll
    for (int kt = 0; kt < 8; ++kt)
#pragma unroll
        for (int s2 = 0; s2 < 2; ++s2) { const bf16x8 pa = __builtin_bit_cast(bf16x8, Pk[kt][s2]);
#pragma unroll
            for (int d0 = 0; d0 < 2; ++d0) { LAS unsigned char* vp = vb + d0 * V_D0 + (32 * kt + 16 * s2) * 64 + vlane;
                const s16x4 lo = vtr(vp), hi4 = vtr(vp + 512);
                const bf16x8 vf = {lo[0], lo[1], lo[2], lo[3], hi4[0], hi4[1], hi4[2], hi4[3]};
                o[d0] = __builtin_amdgcn_mfma_f32_32x32x16_bf16(pa, vf, o[d0], 0, 0, 0); } }
    LAS bf16_t* stg = (LAS bf16_t*)(lds + OST + w * 4096);
#pragma unroll
    for (int r = 0; r < 16; ++r) { const int orow = crow(r, hi); const float li = __shfl(linv, orow);
#pragma unroll
        for (int d0 = 0; d0 < 2; ++d0) stg[orow * 64 + d0 * 32 + q] = (bf16_t)(cvtpk(o[d0][r] * li, 0.f) & 0xffffu); }
    asm volatile("s_waitcnt lgkmcnt(0)" ::: "memory");
#pragma unroll
    for (int k = 0; k < 4; ++k) { const int row = k * 8 + (lane >> 3), ch = lane & 7; const u32x4 v = *(const LAS u32x4*)(stg + row * 64 + ch * 8);
        *(u32x4*)(oc + (size_t)(b * SEQ + 256 * qblk + 32 * w + row) * D + h * 256 + 64 * vc + ch * 8) = v; }
}
DI void phase(LAS unsigned char* lds, const bf16_t* qc, const bf16_t* kvc, bf16_t* oc, int u_lo, int u_hi, int) {
    if (u_lo >= u_hi) return;
    const int total = 8 * (u_hi - u_lo);
    St T;
    { const bf16_t* q0 = q_ptr(0, u_lo, qc, otid());
#pragma unroll
      for (int ks = 0; ks < 4; ++ks) T.q[ks] = *(const u32x4*)(q0 + 16 * ks); }
    stage_load<0>(T, 0, total, u_lo, kvc, otid()); stage_write<0>(T, 0, total, lds, otid()); stage_load<1>(T, 1, total, u_lo, kvc, otid()); stage_load<0>(T, 2, total, u_lo, kvc, otid());
    __syncthreads();
    for (int i0 = 0; i0 < total; i0 += 8) {
        u32x4 Pk[8][2]; float linv;
        {   f32x16 S[8];
#pragma unroll
            for (int kt = 0; kt < 8; ++kt)
#pragma unroll
                for (int r = 0; r < 16; ++r) S[kt][r] = 0.f;
#define XA_NEXT(i, P1) do { stage_write<P1>(T, (i) + 1, total, lds, otid()); stage_load<P1>(T, (i) + 3, total, u_lo, kvc, otid()); __syncthreads(); } while (0)
            k_stage<0>(T, S, i0 + 0, u_lo, lds, qc, otid()); XA_NEXT(i0 + 0, 1);
            k_stage<1>(T, S, i0 + 1, u_lo, lds, qc, otid()); XA_NEXT(i0 + 1, 0);
            k_stage<2>(T, S, i0 + 2, u_lo, lds, qc, otid()); XA_NEXT(i0 + 2, 1);
            k_stage<3>(T, S, i0 + 3, u_lo, lds, qc, otid()); XA_NEXT(i0 + 3, 0);
            softmax(S, Pk, linv);
        }
        v_stage<4>(T, Pk, linv, i0 + 4, total, u_lo, lds, qc, oc, otid()); XA_NEXT(i0 + 4, 1);
        v_stage<5>(T, Pk, linv, i0 + 5, total, u_lo, lds, qc, oc, otid()); XA_NEXT(i0 + 5, 0);
        v_stage<6>(T, Pk, linv, i0 + 6, total, u_lo, lds, qc, oc, otid()); XA_NEXT(i0 + 6, 1);
        v_stage<7>(T, Pk, linv, i0 + 7, total, u_lo, lds, qc, oc, otid()); XA_NEXT(i0 + 7, 0);
#undef XA_NEXT
    }
}
}


namespace rt {
using da::f32x16; using da::s16x4; using da::crow; using da::cvtpk; using da::vtr;
constexpr int VS = 8256, RS = 4160;
constexpr int KV_K = 0, KV_V = 2 * VS;
constexpr int O_K = 0, O_V = 16384, O_R = O_V + 4 * VS, O_END = O_R + 4 * RS, O_ST = O_END, O_LD = 132;
static_assert(O_ST + 128 * O_LD * 4 <= MISC_OFF, "retention LDS map");
DI float log2_gamma(int h) { return __log2f(1.0f - exp2f(-5.0f - (float)h)); }
DI void dec(int uid, int& b, int& h, int& n) { n = uid & 63; h = (uid >> 6) & 3; b = uid >> 8; }
DI size_t ret_off(int b, int n, int h) { return ((size_t)(b * 64 + n) * 4 + h) * 8192; }
DI bf16x8 tr_nat(LAS unsigned char* tile, int ks, int lane) { const int hi = lane >> 5;
    LAS unsigned char* p = tile + (16 * ks + 8 * hi + ((lane & 15) >> 2)) * 64 + ((lane >> 4) & 1) * 32 + (lane & 3) * 8;
    const s16x4 lo = vtr(p), h4 = vtr(p + 256); return (bf16x8){lo[0], lo[1], lo[2], lo[3], h4[0], h4[1], h4[2], h4[3]}; }
DI bf16x8 tr_perm(LAS unsigned char* tile, int rowbase, int lane) { const int hi = lane >> 5;
    LAS unsigned char* p = tile + (rowbase + 4 * hi + ((lane & 15) >> 2)) * 64 + ((lane >> 4) & 1) * 32 + (lane & 3) * 8;
    const s16x4 lo = vtr(p), h4 = vtr(p + 512); return (bf16x8){lo[0], lo[1], lo[2], lo[3], h4[0], h4[1], h4[2], h4[3]}; }
struct KvRegs { u32x4 k[2], v[4]; };
DI void kv_load(KvRegs& G, int uid, const bf16_t* proj, int tid) {
    int b, h, n; dec(uid, b, h, n);
    const bf16_t* kb = proj + hm_off(1792, 4, 64, b, h, 128 * n); const bf16_t* vb = proj + hm_off(2048, 4, 128, b, h, 128 * n);
#pragma unroll
    for (int i = 0; i < 2; ++i) G.k[i] = *(const u32x4*)(kb + 8 * (tid + 512 * i));
#pragma unroll
    for (int i = 0; i < 4; ++i) G.v[i] = *(const u32x4*)(vb + 8 * (tid + 512 * i));
}
DI void kv_phase(LAS unsigned char* lds, const bf16_t* proj, float* ret, int u_lo, int u_hi) {
    if (u_lo >= u_hi) return;
    KvRegs G; kv_load(G, u_lo, proj, otid());
    for (int uid = u_lo; uid < u_hi; ++uid) {
        const int tid = otid(), lane = tid & 63, w = __builtin_amdgcn_readfirstlane(tid >> 6);
        int b, h, n; dec(uid, b, h, n);
        const float lg = log2_gamma(h);
#pragma unroll
        for (int i = 0; i < 2; ++i) { const int id = tid + 512 * i, tok = id >> 3, ch = id & 7; const float dk = fast_exp2(lg * (float)(127 - tok)); u32x4 o;
#pragma unroll
            for (int k = 0; k < 4; ++k) o[k] = cvt_pk_bf16(bf2f(G.k[i][k] & 0xffffu) * dk, bf2f(G.k[i][k] >> 16) * dk);
            *(LAS u32x4*)(lds + KV_K + (ch >> 2) * VS + tok * 64 + (ch & 3) * 16) = o; }
#pragma unroll
        for (int i = 0; i < 4; ++i) { const int id = tid + 512 * i, tok = id >> 4, ch = id & 15; *(LAS u32x4*)(lds + KV_V + (ch >> 2) * VS + tok * 64 + (ch & 3) * 16) = G.v[i]; }
        __syncthreads();
        if (uid + 1 < u_hi) kv_load(G, uid + 1, proj, otid());
        const int dt = w >> 2, et = w & 3;
        f32x16 acc;
#pragma unroll
        for (int r = 0; r < 16; ++r) acc[r] = 0.f;
#pragma unroll
        for (int ks = 0; ks < 8; ++ks) { const bf16x8 a = tr_nat(lds + KV_K + dt * VS, ks, lane), bb = tr_nat(lds + KV_V + et * VS, ks, lane);
            acc = __builtin_amdgcn_mfma_f32_32x32x16_bf16(a, bb, acc, 0, 0, 0); }
        float* o = ret + ret_off(b, n, h) + (size_t)(32 * dt) * 128 + 32 * et + (lane & 31);
#pragma unroll
        for (int r = 0; r < 16; ++r) o[(size_t)crow(r, lane >> 5) * 128] = acc[r];
        __syncthreads();
    }
}
DI void scan(float* ret, int b0, int nb, int gtid, int ngt) {
    for (int e = gtid; e < nb * 4 * 8192; e += ngt) {
        const int de = e & 8191, h = (e >> 13) & 3, b = b0 + (e >> 15);
        const float cd = fast_exp2(128.0f * log2_gamma(h));
        float R = 0.f;
        for (int n0 = 0; n0 < 64; n0 += 8) { float t[8];
#pragma unroll
            for (int k = 0; k < 8; ++k) t[k] = ret[ret_off(b, n0 + k, h) + de];
#pragma unroll
            for (int k = 0; k < 8; ++k) { ret[ret_off(b, n0 + k, h) + de] = R; R = cd * R + t[k]; } }
    }
}
struct ORegs { u32x4 k[2], v[4], q[4]; f32x4 r[4]; };
DI void out_load(ORegs& G, int uid, const bf16_t* proj, const float* ret, int tid) {
    int b, h, n; dec(uid, b, h, n);
    const int lane = tid & 63, w = tid >> 6;
    const bf16_t* kb = proj + hm_off(1792, 4, 64, b, h, 128 * n); const bf16_t* vb = proj + hm_off(2048, 4, 128, b, h, 128 * n); const bf16_t* qb = proj + hm_off(1536, 4, 64, b, h, 128 * n);
#pragma unroll
    for (int i = 0; i < 2; ++i) G.k[i] = *(const u32x4*)(kb + 8 * (tid + 512 * i));
#pragma unroll
    for (int i = 0; i < 4; ++i) G.v[i] = *(const u32x4*)(vb + 8 * (tid + 512 * i));
    const float* rp = ret + ret_off(b, n, h);
#pragma unroll
    for (int i = 0; i < 4; ++i) G.r[i] = *(const f32x4*)(rp + 4 * (tid + 512 * i));
    const bf16_t* qp = qb + (size_t)(32 * (w >> 1) + (lane & 31)) * 64 + 8 * (lane >> 5);
#pragma unroll
    for (int ks = 0; ks < 4; ++ks) G.q[ks] = *(const u32x4*)(qp + 16 * ks);
}
DI void out_write(const ORegs& G, int uid, LAS unsigned char* lds, int tid) {
    const int h = (uid >> 6) & 3; const float gam = 1.0f - exp2f(-5.0f - (float)h);
#pragma unroll
    for (int i = 0; i < 2; ++i) { const int id = tid + 512 * i, tok = id >> 3, ch = id & 7; *(LAS u32x4*)(lds + O_K + 128 * tok + 16 * (ch ^ ((tok >> 1) & 7))) = G.k[i]; }
#pragma unroll
    for (int i = 0; i < 4; ++i) { const int id = tid + 512 * i, tok = id >> 4, ch = id & 15; *(LAS u32x4*)(lds + O_V + (ch >> 2) * VS + tok * 64 + (ch & 3) * 16) = G.v[i]; }
#pragma unroll
    for (int i = 0; i < 4; ++i) { const int id = tid + 512 * i, d = id >> 5, e = 4 * (id & 31); u32x2 o; o.x = cvt_pk_bf16(G.r[i][0] * gam, G.r[i][1] * gam); o.y = cvt_pk_bf16(G.r[i][2] * gam, G.r[i][3] * gam);
        *(LAS u32x2*)(lds + O_R + (e >> 5) * RS + d * 64 + (e & 31) * 2) = o; }
}
DI void out_phase(LAS unsigned char* lds, const bf16_t* proj, const float* ret, bf16_t* omix, int u_lo, int u_hi, int) {
    if (u_lo >= u_hi) return;
    ORegs G; out_load(G, u_lo, proj, ret, otid());
    for (int uid = u_lo; uid < u_hi; ++uid) {
        const int tid = otid(), lane = tid & 63, w = __builtin_amdgcn_readfirstlane(tid >> 6), q = lane & 31, hi = lane >> 5;
        const int qt = w >> 1, eh = w & 1;
        int b, h, n; dec(uid, b, h, n);
        const float lg = log2_gamma(h);
        const size_t row0 = (size_t)b * SEQ + 128 * n;
        out_write(G, uid, lds, tid);
        bf16x8 qr[4];
#pragma unroll
        for (int ks = 0; ks < 4; ++ks) qr[ks] = __builtin_bit_cast(bf16x8, G.q[ks]);
        __syncthreads();
        if (uid + 1 < u_hi) out_load(G, uid + 1, proj, ret, otid());
        f32x16 o[2];
#pragma unroll
        for (int r = 0; r < 16; ++r) { o[0][r] = 0.f; o[1][r] = 0.f; }
#pragma unroll
        for (int ks = 0; ks < 4; ++ks)
#pragma unroll
            for (int t = 0; t < 2; ++t) { const bf16x8 rf = tr_nat(lds + O_R + (2 * eh + t) * RS, ks, lane); o[t] = __builtin_amdgcn_mfma_f32_32x32x16_bf16(qr[ks], rf, o[t], 0, 0, 0); }
#pragma unroll
        for (int kt = 0; kt < 4; ++kt) if (kt <= qt) {
            const int uk = 32 * kt + q;
            f32x16 s;
#pragma unroll
            for (int r = 0; r < 16; ++r) s[r] = 0.f;
#pragma unroll
            for (int ks = 0; ks < 4; ++ks) { const bf16x8 kf = *(const LAS bf16x8*)(lds + O_K + 128 * uk + 16 * ((2 * ks + hi) ^ ((uk >> 1) & 7)));
                s = __builtin_amdgcn_mfma_f32_32x32x16_bf16(kf, qr[ks], s, 0, 0, 0); }
#pragma unroll
            for (int r = 0; r < 16; ++r) { const int kk = 32 * kt + crow(r, hi), qq = 32 * qt + q; s[r] = (kk <= qq) ? s[r] * fast_exp2(-lg * (float)kk) : 0.f; }
#pragma unroll
            for (int s2 = 0; s2 < 2; ++s2) { u32x4 pw; pw.x = cvtpk(s[8 * s2 + 0], s[8 * s2 + 1]); pw.y = cvtpk(s[8 * s2 + 2], s[8 * s2 + 3]); pw.z = cvtpk(s[8 * s2 + 4], s[8 * s2 + 5]); pw.w = cvtpk(s[8 * s2 + 6], s[8 * s2 + 7]);
                const bf16x8 pa = __builtin_bit_cast(bf16x8, pw);
#pragma unroll
                for (int t = 0; t < 2; ++t) { const bf16x8 vf = tr_perm(lds + O_V + (2 * eh + t) * VS, 32 * kt + 16 * s2, lane); o[t] = __builtin_amdgcn_mfma_f32_32x32x16_bf16(pa, vf, o[t], 0, 0, 0); } }
        }
        unsigned gq[16];
        { const bf16_t* gb = proj + hm_off(2560, 4, 128, b, h, 128 * n);
#pragma unroll
          for (int k = 0; k < 16; ++k) gq[k] = *(const unsigned*)(gb + (size_t)(16 * w + k) * 128 + 2 * lane); }
        LAS float* st = (LAS float*)(lds + O_ST);
#pragma unroll
        for (int r = 0; r < 16; ++r) { const int qq = 32 * qt + crow(r, hi); const float a = fast_exp2(lg * (float)qq);
#pragma unroll
            for (int t = 0; t < 2; ++t) st[qq * O_LD + 32 * (2 * eh + t) + q] = o[t][r] * a; }
        __syncthreads();
        float rsn;
        { const LAS f32x4* rp = (const LAS f32x4*)(st + (16 * w + (lane >> 2)) * O_LD + 32 * (lane & 3)); float ss = 0.f;
#pragma unroll
          for (int i = 0; i < 8; ++i) { const f32x4 x = rp[i]; ss += (x[0] * x[0] + x[1] * x[1]) + (x[2] * x[2] + x[3] * x[3]); }
          ss += __shfl_xor(ss, 1); ss += __shfl_xor(ss, 2);
          rsn = rsqrtf(ss * (1.0f / 128.0f) + EPS); }
#pragma unroll
        for (int k = 0; k < 16; ++k) { const int rr = 16 * w + k;
            const f32x2 v = *(const LAS f32x2*)(st + rr * O_LD + 2 * lane);
            const float rs = __shfl(rsn, 4 * k);
            const float g0 = bf2f(gq[k] & 0xffffu), g1 = bf2f(gq[k] >> 16);
            *(unsigned*)(omix + (row0 + rr) * D + 512 + h * 128 + 2 * lane) = cvt_pk_bf16(silu_f(g0) * v[0] * rs, silu_f(g1) * v[1] * rs); }
    }
}
}

constexpr int NPH = 14;
__global__ void __launch_bounds__(NWAVES * 64, 2) mk_fwd(Args args) {
    extern __shared__ __attribute__((aligned(16))) unsigned char lds_raw[];
    LAS unsigned char* lds = (LAS unsigned char*)lds_raw;
    volatile LAS unsigned* MISC = (volatile LAS unsigned*)(lds + MISC_OFF);
    const int wave = __builtin_amdgcn_readfirstlane((int)threadIdx.x >> 6);
#define tid (otid())
#define lane (otid() & 63)
    const int G = gridDim.x; const int bx = blockIdx.x;
    const bool grouped = (G % 8 == 0) && (NBATCH % 8 == 0);
    const int NGRP = grouped ? 8 : 1, grp = grouped ? bx % 8 : 0, GL = G / NGRP, BPG = NBATCH / NGRP;
    const int lv = grouped ? bx / 8 : ((G % 8 == 0) ? (bx % 8) * (G / 8) + bx / 8 : bx);
    const int lc = grouped ? bx / 8 : bx;
    const int b0 = grp * BPG, Mg = BPG * SEQ; const size_t rowb = (size_t)b0 * SEQ;
    const int vcu = (G % 8 == 0) ? (bx % 8) * (G / 8) + bx / 8 : bx;
    const int gw = vcu * NWAVES + wave, NGW = G * NWAVES;
    const int gwl = lv * NWAVES + wave, NGWL = GL * NWAVES;
    unsigned char* ws = args.ws;
    unsigned* ctl = (unsigned*)(ws + WS_CTL);
    for (int u = tid; u < (LDS_BYTES - LDSCTL_OFF) / 4; u += NWAVES * 64) ((LAS unsigned*)(lds + LDSCTL_OFF))[u] = 0u;
    __syncthreads();
    XcdBarrier bar_all = xcd_barrier_post(ctl + CW_BAR + 8 * XCD_BAR_WORDS, MISC + 10, (unsigned)G);
    XcdBarrier bar = xcd_barrier_post(ctl + CW_BAR + grp * XCD_BAR_WORDS, MISC + 8, (unsigned)GL);
    const int lo = args.ph_lo, hi = args.ph_hi;
#define IN(k) (lo <= (k) && (k) < hi)
#define SEAM(k) do { if (IN(k) && IN((k) + 1)) xcd_barrier(bar); } while (0)

#define XIN ((const float*)args.in[0])
#define MEMIN ((const float*)args.in[1])
#define W1in ((bf16_t*)(ws + WS_W1IN))
#define W1out ((bf16_t*)(ws + WS_W1OUT))
#define Win ((bf16_t*)(ws + WS_WIN))
#define Wout ((bf16_t*)(ws + WS_WOUT))
#define Wcq ((bf16_t*)(ws + WS_WCQ))
#define Wckv ((bf16_t*)(ws + WS_WCKV))
#define Wco ((bf16_t*)(ws + WS_WCO))
#define W2in ((bf16_t*)(ws + WS_W2IN))
#define W2out ((bf16_t*)(ws + WS_W2OUT))
#define cosA ((float*)(ws + WS_COSA))
#define sinA ((float*)(ws + WS_SINA))
#define cosR ((float*)(ws + WS_COSR))
#define sinR ((float*)(ws + WS_SINR))
#define MEMN ((bf16_t*)(ws + WS_MEMN))
#define KVC ((bf16_t*)(ws + WS_KC))
#define SSQ ((float*)(ws + WS_SSQ))
#define XB ((bf16_t*)(ws + WS_XB))
#define BIG ((bf16_t*)(ws + WS_BIG))
#define OMIX ((bf16_t*)(ws + WS_OMIX))
#define QC ((bf16_t*)(ws + WS_BIG))
#define ATTP ((bf16_t*)(ws + WS_ATT))
#define LSE ((float*)(ws + WS_ATT + (size_t)M * 512 * 2 * 3))
#define RETB ((float*)(ws + WS_RET))
#define xres (args.xres)
    if (IN(0)) {
        LAS float* scr = (LAS float*)(lds + RING_OFF + wave * 16384);
        constexpr int I0 = (D / 64) * (2 * DFF / 32), I1 = (DFF / 64) * (D / 32), I2 = (D / 64) * (INC / 32), I3 = (D / 64) * (D / 32), I5 = (D / 64) * (2 * D / 32);
        constexpr int NITEMS = 2 * I0 + 2 * I1 + I2 + 3 * I3 + I5;
        for (int it = gw; it < NITEMS; it += NGW) {
            int r = it;
            if (r < I0) { p0_transpose_item(args.in[3], D, 2 * DFF, W1in, 0, nullptr, scr, r, lane); continue; } r -= I0;
            if (r < I1) { p0_transpose_item(args.in[4], DFF, D, W1out, 1, nullptr, scr, r, lane); continue; } r -= I1;
            if (r < I2) { p0_transpose_item(args.in[6], D, INC, Win, 2, args.in[5], scr, r, lane); continue; } r -= I2;
            if (r < I3) { p0_transpose_item(args.in[7], D, D, Wout, 3, nullptr, scr, r, lane); continue; } r -= I3;
            if (r < I3) { p0_transpose_item(args.in[10], D, D, Wcq, 4, args.in[8], scr, r, lane); continue; } r -= I3;
            if (r < I5) { p0_transpose_item(args.in[11], D, 2 * D, Wckv, 5, nullptr, scr, r, lane); continue; } r -= I5;
            if (r < I3) { p0_transpose_item(args.in[12], D, D, Wco, 6, nullptr, scr, r, lane); continue; } r -= I3;
            if (r < I0) { p0_transpose_item(args.in[14], D, 2 * DFF, W2in, 7, args.in[13], scr, r, lane); continue; } r -= I0;
            p0_transpose_item(args.in[15], DFF, D, W2out, 8, nullptr, scr, r, lane);
        }
        for (int m = gw; m < M; m += 2 * NGW) rms_row2_to_bf16(XIN + (size_t)m * D, (m + NGW < M) ? XIN + (size_t)(m + NGW) * D : nullptr, args.in[2], XB + (size_t)m * D, XB + (size_t)(m + NGW) * D, lane);
        for (int m = gw; m < MROWS; m += NGW) rms_row_to_bf16(MEMIN + (size_t)m * D, args.in[9], MEMN + (size_t)m * D, lane);
    }
    if (IN(0) && IN(1)) xcd_barrier(bar_all);
    if (IN(1)) {
        pg8::Gemm g{XB + rowb * D, W1in, D, D, D}; pg8::StaticOrder S; S.init(Mg, 2 * DFF, GL, lc, D, D); S.flat = grouped;
        pg8::EpiSwiGLU<false> E{BIG + rowb * INC, nullptr};
        pg8::gemm_phase<pg8::EpiSwiGLU<false>, pg8::StaticOrder, true>(lds + RING_OFF, g, S, E);
    }
    SEAM(1);
    if (IN(2)) {
        pg8::Gemm g{BIG + rowb * INC, W1out, INC, DFF, DFF}; pg8::StaticOrder S; S.init(Mg, D, GL, lc, INC, DFF); S.flat = grouped;
        pg8::EpiResid<0> E{XIN + rowb * D, nullptr, XB + rowb * D, SSQ + rowb * 4};
        pg8::gemm_phase<pg8::EpiResid<0>, pg8::StaticOrder, true>(lds + RING_OFF, g, S, E);
    }
    SEAM(2);
    if (IN(3)) {
        pg8::Gemm g{XB + rowb * D, Win, D, D, D}; pg8::StaticOrder S; S.init(Mg, INC, GL, lc, D, D); S.flat = grouped;
        pg8::EpiInProj E{BIG + rowb * INC, SSQ + rowb * 4, cosA, sinA, cosR, sinR};
        pg8::gemm_phase<pg8::EpiInProj, pg8::StaticOrder, true>(lds + RING_OFF, g, S, E);
    }
    SEAM(3);
    if (IN(4)) {
        const int nkvg = BPG * 8;
        { pg8::Gemm g{MEMN + (size_t)b0 * MEMLEN * D, Wckv, D, D, D}; pg8::StaticOrder S; S.init(BPG * MEMLEN, 2 * D, GL, lv, D, D); S.flat = grouped;
          pg8::EpiPlain<false> E{KVC + (size_t)b0 * MEMLEN * 2 * D, 2 * D, nullptr};
          pg8::gemm_phase<pg8::EpiPlain<false>, pg8::StaticOrder, true>(lds + RING_OFF, g, S, E); }
        { da::UnitMap U;
          if (grouped) U.init(grp, lv, GL, BPG * 8, (GL == 32 && nkvg == 8) ? 8 : 0);
          else if (G % 8 == 0) U.init(vcu / (G / 8), vcu % (G / 8), G / 8, NBATCH, 0);
          else U.init(0, vcu, G, NBATCH * 8, 0);
          da::phase(lds, BIG, ATTP, LSE, U); }
        { const int nunits = BPG * 4 * 64; const int per = (nunits + GL - 1) / GL; const int u0 = lv * per, u1 = (u0 + per < nunits) ? u0 + per : nunits;
          rt::kv_phase(lds, BIG, RETB, b0 * 256 + u0, b0 * 256 + u1); }
    }
    SEAM(4);
    if (IN(5)) { rt::scan(RETB, b0, BPG, lv * NWAVES * 64 + tid, GL * NWAVES * 64); da::merge(ATTP, LSE, OMIX, (int)rowb, Mg, lv * NWAVES * 64 + tid, GL * NWAVES * 64); }
    SEAM(5);
    if (IN(6)) { const int nunits = BPG * 4 * 64; const int per = (nunits + GL - 1) / GL; const int u0 = lv * per, u1 = (u0 + per < nunits) ? u0 + per : nunits;
        rt::out_phase(lds, BIG, RETB, OMIX, b0 * 256 + u0, b0 * 256 + u1, tid); }
    SEAM(6);
    if (IN(7)) {
        pg8::Gemm g{OMIX + rowb * D, Wout, D, D, D}; pg8::StaticOrder S; S.init(Mg, D, GL, lc, D, D); S.flat = grouped;
        pg8::EpiResid<1> E{nullptr, nullptr, XB + rowb * D, SSQ + rowb * 4};
        pg8::gemm_phase<pg8::EpiResid<1>, pg8::StaticOrder, true>(lds + RING_OFF, g, S, E);
    }
    SEAM(7);
    if (IN(8)) {
        pg8::Gemm g{XB + rowb * D, Wcq, D, D, D}; pg8::StaticOrder S; S.init(Mg, D, GL, lc, D, D); S.flat = grouped;
        pg8::EpiPlain<true> E{QC + rowb * INC, INC, SSQ + rowb * 4};
        pg8::gemm_phase<pg8::EpiPlain<true>, pg8::StaticOrder, true>(lds + RING_OFF, g, S, E);
    }
    SEAM(8);
    if (IN(9)) { const int nunits = BPG * 4 * 32; const int per = (nunits + GL - 1) / GL; const int u0 = lv * per, u1 = (u0 + per < nunits) ? u0 + per : nunits;
        xa::phase(lds, QC, KVC, OMIX, b0 * 128 + u0, b0 * 128 + u1, tid); }
    SEAM(9);
    if (IN(10)) {
        pg8::Gemm g{OMIX + rowb * D, Wco, D, D, D}; pg8::StaticOrder S; S.init(Mg, D, GL, lc, D, D); S.flat = grouped;
        pg8::EpiResid<1> E{nullptr, nullptr, XB + rowb * D, SSQ + rowb * 4};
        pg8::gemm_phase<pg8::EpiResid<1>, pg8::StaticOrder, true>(lds + RING_OFF, g, S, E);
    }
    SEAM(10);
    if (IN(11)) {
        pg8::Gemm g{XB + rowb * D, W2in, D, D, D}; pg8::StaticOrder S; S.init(Mg, 2 * DFF, GL, lc, D, D); S.flat = grouped;
        pg8::EpiSwiGLU<true> E{BIG + rowb * INC, SSQ + rowb * 4};
        pg8::gemm_phase<pg8::EpiSwiGLU<true>, pg8::StaticOrder, true>(lds + RING_OFF, g, S, E);
    }
    SEAM(11);
    if (IN(12)) {
        pg8::Gemm g{BIG + rowb * INC, W2out, INC, DFF, DFF}; pg8::StaticOrder S; S.init(Mg, D, GL, lc, INC, DFF); S.flat = grouped;
        pg8::EpiResid<1> E{nullptr, nullptr, XB + rowb * D, SSQ + rowb * 4};
        pg8::gemm_phase<pg8::EpiResid<1>, pg8::StaticOrder, true>(lds + RING_OFF, g, S, E);
    }
    SEAM(12);
    if (IN(13)) {
        const float* wf = args.in[16];
        for (int mm = gwl; mm < Mg; mm += NGWL) { const size_t m = rowb + mm;
            const f32x4 p = *(const f32x4*)(SSQ + m * 4);
            const float r = rsqrtf(((p[0] + p[1]) + (p[2] + p[3])) * (1.f / D) + EPS);
            const u32x4* xr = (const u32x4*)(XB + m * D) + lane;
            f32x4* orow = (f32x4*)(xres + m * D) + 2 * lane;
#pragma unroll
            for (int j = 0; j < 2; ++j) { const u32x4 w = xr[64 * j]; const f32x4 w0 = ((const f32x4*)wf)[128 * j + 2 * lane], w1 = ((const f32x4*)wf)[128 * j + 2 * lane + 1];
                f32x4 o0 = {bf2f(w[0] & 0xffffu), bf2f(w[0] >> 16), bf2f(w[1] & 0xffffu), bf2f(w[1] >> 16)}, o1 = {bf2f(w[2] & 0xffffu), bf2f(w[2] >> 16), bf2f(w[3] & 0xffffu), bf2f(w[3] >> 16)};
                orow[128 * j] = o0 * r * w0; orow[128 * j + 1] = o1 * r * w1; }
        }
    }
#undef IN
#undef SEAM
#undef tid
#undef lane
#undef XIN
#undef MEMIN
#undef W1in
#undef W1out
#undef Win
#undef Wout
#undef Wcq
#undef Wckv
#undef Wco
#undef W2in
#undef W2out
#undef cosA
#undef sinA
#undef cosR
#undef sinR
#undef MEMN
#undef KVC
#undef SSQ
#undef XB
#undef BIG
#undef OMIX
#undef QC
#undef ATTP
#undef LSE
#undef RETB
#undef xres
}


extern "C" void kernel_launch(void* const* d_in, const int* in_sizes, int n_in, void* d_out, int out_size, void* d_ws, size_t ws_size, hipStream_t stream) {
    static int grid = 0;
    if (grid == 0) {
        int dev = 0, cus = 0, per_cu = 0;
        if (n_in != 17 || ws_size < WS_OPT_END) { fprintf(stderr, "kernel_launch: unexpected inputs (n_in %d, ws %zu < %zu)\n", n_in, ws_size, (size_t)WS_OPT_END); grid = -1; return; }
        if (hipGetDevice(&dev) != hipSuccess || hipDeviceGetAttribute(&cus, hipDeviceAttributeMultiprocessorCount, dev) != hipSuccess) { grid = -1; return; }
        if (hipFuncSetAttribute((const void*)mk_fwd, hipFuncAttributeMaxDynamicSharedMemorySize, LDS_BYTES) != hipSuccess) { fprintf(stderr, "kernel_launch: hipFuncSetAttribute failed\n"); grid = -1; return; }
        if (hipOccupancyMaxActiveBlocksPerMultiprocessor(&per_cu, (const void*)mk_fwd, NWAVES * 64, LDS_BYTES) != hipSuccess || per_cu < 1) { fprintf(stderr, "kernel_launch: occupancy query says %d blocks per CU\n", per_cu); (void)hipGetLastError(); grid = -1; return; }
        grid = cus;
    }
    if (grid < 0) return;
    (void)hipMemsetAsync((char*)d_ws + WS_CTL, 0, CTL_ZERO_BYTES, stream);
    Args a{};
    for (int i = 0; i < 17; ++i) a.in[i] = (const float*)d_in[i];
    a.out = (float*)d_out; a.ws = (unsigned char*)d_ws;
    a.xres = (float*)d_out; a.ph_lo = 0; a.ph_hi = NPH;
    hipLaunchKernelGGL(mk_fwd, dim3(grid), dim3(NWAVES * 64), LDS_BYTES, stream, a);
}
```

```cpp
#include <hip/hip_runtime.h>
#include <cstdio>
#include <cstdint>
#include <cmath>

#define DI __device__ __forceinline__

constexpr int D = 1024, NB_ALL = 8, SEQ = 8192, MEMLEN = 256, DFF = 2816, INC = 3072;
constexpr int NBATCH = 8;
constexpr int M = NBATCH * SEQ;
constexpr int MROWS = NBATCH * MEMLEN;
constexpr float EPS = 1e-6f;
constexpr float LOG2E = 1.4426950408889634f;

typedef unsigned short bf16_t;
typedef short bf16x8 __attribute__((ext_vector_type(8)));
typedef float f32x4 __attribute__((ext_vector_type(4)));
typedef float f32x2 __attribute__((ext_vector_type(2)));
typedef unsigned u32x4 __attribute__((ext_vector_type(4)));
typedef unsigned u32x2 __attribute__((ext_vector_type(2)));
#define LAS __attribute__((address_space(3)))
#define GAS __attribute__((address_space(1)))

DI int otid() { int t = threadIdx.x; asm volatile("" : "+v"(t)); return t; }
DI float bf2f(unsigned u16) { return __uint_as_float(u16 << 16); }
DI unsigned cvt_pk_bf16(float lo, float hi) { unsigned r; asm volatile("v_cvt_pk_bf16_f32 %0, %1, %2" : "=v"(r) : "v"(lo), "v"(hi)); return r; }
DI float fast_exp2(float x) { return __builtin_amdgcn_exp2f(x); }
DI float fast_rcp(float x) { return __builtin_amdgcn_rcpf(x); }
DI f32x2 swiglu2(f32x2 g, f32x2 u) { f32x2 e = {fast_exp2(-g[0]), fast_exp2(-g[1])}; e = e + 1.0f; const f32x2 s = {fast_rcp(e[0]), fast_rcp(e[1])}; return (g * u) * s; }
DI float silu_f(float x) { return x * fast_rcp(1.0f + fast_exp2(-x * LOG2E)); }


DI size_t hm_off(int secoff, int nheads, int hw, int b, int head, int t) { return (size_t)b * SEQ * INC + (size_t)SEQ * secoff + ((size_t)head * SEQ + t) * hw; }

namespace pg8 {
constexpr int BM = 256, BK = 64, HALF = 128, HTB = HALF * BK * 2, STAGE_BYTES = 8 * HTB, NXCD = 8, WGM = 8;
constexpr int EPI_SCR = STAGE_BYTES;
constexpr int EPI_RS = EPI_SCR + 4096, EPI_RS_MAX = 24;
__host__ __device__ __forceinline__ int lds_byte(int r, int c) { const int st = (r >> 4) * 2 + (c >> 5), rr = r & 15, cc = c & 31, ob = rr * 64 + cc * 2; return st * 1024 + (ob ^ (((ob >> 9) & 1) << 5)); }
__host__ __device__ __forceinline__ void stage_rc(int b, int& R, int& C) { const int st = b / 1024, sb = b % 1024, swz = sb ^ (((sb >> 9) & 1) << 5); R = (st >> 1) * 16 + swz / 64; C = (st & 1) * 32 + (swz % 64) / 2; }
__host__ __device__ __forceinline__ int perm32(int rho) { const int n = rho >> 4, i = rho & 15; return 8 * (i >> 2) + 4 * n + (i & 3); }

struct Unit { int pm, pn, z; };
struct Gemm { const bf16_t* A; const bf16_t* Bt; int lda, ldb, K; size_t a_plane, b_plane; };

struct StaticOrder {
    int nM, nN, nwg, G, c, lda, ldb, flat;
    DI void init(int M_, int N_, int G_, int c_, int lda_, int ldb_) { nM = M_ / BM; nN = N_ / BM; nwg = nM * nN; G = G_; c = c_; lda = lda_; ldb = ldb_; flat = 0; }
    DI bool next(int i, Unit& u) const {
        const int L = i * G + c; if (L >= nwg) return false;
        int wgid = L; if (!flat) { const int q = nwg / NXCD, r = nwg % NXCD, xcd = wgid % NXCD, off = wgid / NXCD; wgid = (xcd < r ? xcd * (q + 1) : r * (q + 1) + (xcd - r) * q) + off; }
        const int nig = WGM * nN, gid = wgid / nig, fm = gid * WGM, gsz = (nM - fm) < WGM ? (nM - fm) : WGM;
        u.pm = fm + ((wgid % nig) % gsz); u.pn = (wgid % nig) / gsz; u.z = 0; return true;
    }
    DI size_t a_off(const Unit& u) const { return (size_t)u.pm * BM * lda; }
    DI size_t b_off(const Unit& u) const { return (size_t)u.pn * BM * ldb; }
};

template <class Epi, class Sched, bool ALIGN_EPI>
DI void gemm_phase(LAS unsigned char* lds, const Gemm g, const Sched& S, const Epi& E) {
    const int tid = otid(), wid = __builtin_amdgcn_readfirstlane(tid >> 6), lane = tid & 63, wr = wid >> 2, wc = wid & 3, fr = lane & 15, fq = lane >> 4;
    const int nt = g.K / BK;
    unsigned voffA, voffB;
    { int R, C; stage_rc(tid * 16, R, C); const int Rb = Epi::PERM ? ((R & ~31) + perm32(R & 31)) : R;
      voffA = g.a_plane ? (unsigned)((size_t)(C >> 5) * g.a_plane) + (unsigned)(R * 32 + (C & 31)) * 2u : (unsigned)(R * g.lda + C) * 2u; voffB = g.b_plane ? (unsigned)((size_t)(C >> 5) * g.b_plane) + (unsigned)(Rb * 32 + (C & 31)) * 2u : (unsigned)(Rb * g.ldb + C) * 2u; }
    const size_t kstepA = g.a_plane ? 2 * g.a_plane : (size_t)(BK * 2), kstep = g.b_plane ? 2 * g.b_plane : (size_t)(BK * 2);
    const size_t hstepA = (size_t)HALF * g.lda * 2, hstepB = (size_t)HALF * g.ldb * 2;
    const size_t voffA_q = hstepA / 2, voffB_q = hstepB / 2;
    const unsigned ldsw = (unsigned)wid * 1024u;
    const int aoff = lds_byte(wr * 64 + fr, fq * 8), boff = lds_byte(wc * 32 + fr, fq * 8);
#define PG8_SA(b, h) (((b) * 2 + (h)) * HTB)
#define PG8_SB(b, h) ((4 + (b) * 2 + (h)) * HTB)
#define PG8_STAGE(bufoff, gbase, voff) do { _Pragma("unroll") for (int _i = 0; _i < 2; ++_i) \
        __builtin_amdgcn_global_load_lds((const unsigned*)((const char*)(gbase) + (size_t)_i * voff##_q + (voff)), (LAS unsigned*)(lds + (bufoff) + ldsw + _i * 8192), 16, 0, 0); } while (0)
#define PG8_LDA(dst, b, h) do { PG8_ALIGN8; _Pragma("unroll") for (int m = 0; m < 4; ++m) _Pragma("unroll") for (int k = 0; k < 2; ++k) dst[m][k] = *(const LAS bf16x8*)(lds + PG8_SA(b, h) + aoff + m * 2048 + k * 1024); } while (0)
#define PG8_LDB(dst, b, h) do { PG8_ALIGN8; _Pragma("unroll") for (int n = 0; n < 2; ++n) _Pragma("unroll") for (int k = 0; k < 2; ++k) dst[n][k] = *(const LAS bf16x8*)(lds + PG8_SB(b, h) + boff + n * 2048 + k * 1024); } while (0)
#define PG8_MMA(ai, bj, At, Bt) do { __builtin_amdgcn_s_setprio(1); PG8_ALIGN8; _Pragma("unroll") for (int m = 0; m < 4; ++m) _Pragma("unroll") for (int n = 0; n < 2; ++n) _Pragma("unroll") for (int k = 0; k < 2; ++k) \
        acc[ai][bj][m][n] = __builtin_amdgcn_mfma_f32_16x16x32_bf16(Bt[n][k], At[m][k], acc[ai][bj][m][n], 0, 0, 0); __builtin_amdgcn_s_setprio(0); } while (0)
#define PG8_MMAZ(ai, bj, At, Bt) do { __builtin_amdgcn_s_setprio(1); PG8_ALIGN8; _Pragma("unroll") for (int m = 0; m < 4; ++m) _Pragma("unroll") for (int n = 0; n < 2; ++n) { \
        acc[ai][bj][m][n] = __builtin_amdgcn_mfma_f32_16x16x32_bf16(Bt[n][0], At[m][0], (f32x4){0.f, 0.f, 0.f, 0.f}, 0, 0, 0); \
        acc[ai][bj][m][n] = __builtin_amdgcn_mfma_f32_16x16x32_bf16(Bt[n][1], At[m][1], acc[ai][bj][m][n], 0, 0, 0); } __builtin_amdgcn_s_setprio(0); } while (0)
#define PG8_WAIT_V(n) asm volatile("s_waitcnt vmcnt(" #n ")" ::: "memory")
#define PG8_WAIT_L(n) __builtin_amdgcn_s_waitcnt(0xC07F | ((n) << 8))
#define PG8_ALIGN8 asm volatile(".p2align 3")
#define PG8_BAR __builtin_amdgcn_s_barrier()
#define PG8_SCHED __builtin_amdgcn_sched_barrier(0)
    Unit cur, nxt; int ui = 0;
    if (!S.next(0, cur)) return;
    E.preload(S, lds + EPI_RS);
    f32x4 acc[2][2][4][2];
    E.init(acc, cur, wr, wc, fr, fq);
    bf16x8 At[4][2], B0[2][2], B1[2][2];
    const char* cA = (const char*)(g.A + S.a_off(cur)); const char* cB = (const char*)(g.Bt + S.b_off(cur));
    PG8_STAGE(PG8_SB(0, 0), cB, voffB); PG8_STAGE(PG8_SB(0, 1), cB + hstepB, voffB); PG8_STAGE(PG8_SA(0, 0), cA, voffA); PG8_STAGE(PG8_SA(0, 1), cA + hstepA, voffA);
    if (wr == 1) PG8_BAR;
    PG8_WAIT_V(2); PG8_BAR;
    PG8_STAGE(PG8_SB(1, 0), cB + kstep, voffB); PG8_STAGE(PG8_SA(1, 0), cA + kstepA, voffA); PG8_STAGE(PG8_SB(1, 1), cB + hstepB + kstep, voffB);
    PG8_WAIT_V(6); PG8_BAR;
    for (;;) {
        const bool has_next = S.next(ui + 1, nxt);
        const char* nA = has_next ? (const char*)(g.A + S.a_off(nxt)) : cA; const char* nB = has_next ? (const char*)(g.Bt + S.b_off(nxt)) : cB;
#define PG8_ITER { \
            const bool last = (t == nt - 2); \
            const char* a1 = cA + (size_t)(t + 1) * kstepA; \
            const char* a2 = last ? nA : cA + (size_t)(t + 2) * kstepA; const char* b2 = last ? nB : cB + (size_t)(t + 2) * kstep; \
            const char* a3 = a2 + kstepA; const char* b3 = b2 + kstep; \
            PG8_LDB(B0, 0, 0); PG8_LDB(B1, 0, 1); PG8_SCHED; PG8_LDA(At, 0, 0); PG8_STAGE(PG8_SA(1, 1), a1 + hstepA, voffA); \
            PG8_WAIT_V(8); PG8_WAIT_L(0); PG8_BAR; if (Epi::ZERO_INIT && t == 0) { PG8_MMAZ(0, 0, At, B0); PG8_MMAZ(0, 1, At, B1); } else { PG8_MMA(0, 0, At, B0); PG8_MMA(0, 1, At, B1); } PG8_BAR; PG8_SCHED; \
            PG8_LDA(At, 0, 1); PG8_STAGE(PG8_SB(0, 0), b2, voffB); PG8_STAGE(PG8_SB(0, 1), b2 + hstepB, voffB); PG8_STAGE(PG8_SA(0, 0), a2, voffA); \
            PG8_WAIT_V(8); PG8_WAIT_L(0); PG8_BAR; if (Epi::ZERO_INIT && t == 0) { PG8_MMAZ(1, 0, At, B0); PG8_MMAZ(1, 1, At, B1); } else { PG8_MMA(1, 0, At, B0); PG8_MMA(1, 1, At, B1); } PG8_BAR; PG8_SCHED; \
            PG8_LDB(B0, 1, 0); PG8_LDB(B1, 1, 1); PG8_SCHED; PG8_LDA(At, 1, 0); PG8_STAGE(PG8_SA(0, 1), a2 + hstepA, voffA); \
            PG8_WAIT_V(8); PG8_WAIT_L(0); PG8_BAR; PG8_MMA(0, 0, At, B0); PG8_MMA(0, 1, At, B1); PG8_BAR; PG8_SCHED; \
            PG8_LDA(At, 1, 1); PG8_STAGE(PG8_SB(1, 0), b3, voffB); PG8_STAGE(PG8_SB(1, 1), b3 + hstepB, voffB); PG8_STAGE(PG8_SA(1, 0), a3, voffA); \
            PG8_WAIT_V(8); PG8_WAIT_L(0); PG8_BAR; PG8_MMA(1, 0, At, B0); PG8_MMA(1, 1, At, B1); PG8_BAR; PG8_SCHED; }
        asm volatile(".p2align 6");
        for (int t = 0; t < nt; t += 2) PG8_ITER
#undef PG8_ITER
        if constexpr (ALIGN_EPI) { if (wr == 0) PG8_BAR; }
        E(acc, cur, ui, wr, wc, fr, fq, lds + EPI_SCR);
        if (!has_next) break;
        E.init(acc, nxt, wr, wc, fr, fq);
        cur = nxt; cA = nA; cB = nB; ++ui;
        if constexpr (ALIGN_EPI) { if (wr == 1) PG8_BAR; }
    }
    PG8_WAIT_V(0);
    if constexpr (!ALIGN_EPI) { if (wr == 0) PG8_BAR; }
    PG8_BAR;
#undef PG8_SA
#undef PG8_SB
#undef PG8_STAGE
#undef PG8_LDA
#undef PG8_LDB
#undef PG8_MMA
#undef PG8_MMAZ
#undef PG8_ALIGN8
#undef PG8_WAIT_V
#undef PG8_WAIT_L
#undef PG8_BAR
#undef PG8_SCHED
}

DI void zero_acc(f32x4 (&acc)[2][2][4][2]) {
#pragma unroll
    for (int a = 0; a < 2; ++a)
#pragma unroll
        for (int b = 0; b < 2; ++b)
#pragma unroll
            for (int m = 0; m < 4; ++m)
#pragma unroll
                for (int n = 0; n < 2; ++n) acc[a][b][m][n] = (f32x4){0.f, 0.f, 0.f, 0.f};
}
template <class Sched> DI void preload_rstd(const Sched& S, const float* ssq4, LAS unsigned char* tab) {
    const int t = otid();
    if (t < 256) {
#pragma unroll
        for (int i0 = 0; i0 < EPI_RS_MAX; i0 += 8) {
            f32x4 p[8];
#pragma unroll
            for (int i = 0; i < 8; ++i) { Unit u; p[i] = (f32x4){1.f, 1.f, 1.f, 1.f}; if (S.next(i0 + i, u)) { const float* q_ = ssq4 + (size_t)(u.pm * BM + t); p[i] = (f32x4){q_[0], q_[M], q_[2 * (size_t)M], q_[3 * (size_t)M]}; } }
#pragma unroll
            for (int i = 0; i < 8; ++i) { Unit u; if (S.next(i0 + i, u)) ((LAS float*)tab)[(i0 + i) * 256 + t] = rsqrtf(((p[i][0] + p[i][1]) + (p[i][2] + p[i][3])) * (1.0f / 1024.0f) + EPS); }
        }
    }
}
DI void load_rstd(float (&rs)[2][4], LAS unsigned char* scr, int ui, int wr, int fr) {
    const LAS float* tab = (const LAS float*)(scr + 4096) + ui * 256 + wr * 64 + fr;
#pragma unroll
    for (int ai = 0; ai < 2; ++ai)
#pragma unroll
        for (int m = 0; m < 4; ++m) rs[ai][m] = tab[ai * HALF + m * 16];
}
DI u32x4 ror8(const u32x4 v) { u32x4 r;
#pragma unroll
    for (int e = 0; e < 4; ++e) r[e] = (unsigned)__builtin_amdgcn_update_dpp((int)v[e], (int)v[e], 0x128, 0xf, 0xf, false);
    return r; }
template <bool NT = false> DI void store_rows16(GAS bf16_t* g16  , size_t pitch, int fr, int fq, const u32x4 c0, const u32x4 c1) {
    const bool lo = fr < 8;
    const u32x4 rcv = ror8(lo ? c1 : c0);
    const u32x4 A = lo ? c0 : rcv, B = lo ? rcv : c1;
    GAS bf16_t* p = g16 + (size_t)(fr & 7) * pitch + (lo ? 0 : 32) + 8 * fq;
    if (NT) { __builtin_nontemporal_store(A, (GAS u32x4*)p); __builtin_nontemporal_store(B, (GAS u32x4*)(p + 8 * pitch)); }
    else { *(GAS u32x4*)p = A; *(GAS u32x4*)(p + 8 * pitch) = B; }
}
DI u32x4 pack8(const f32x4 v0, const f32x4 v1) { u32x4 w; w.x = cvt_pk_bf16(v0[0], v0[1]); w.y = cvt_pk_bf16(v0[2], v0[3]); w.z = cvt_pk_bf16(v1[0], v1[1]); w.w = cvt_pk_bf16(v1[2], v1[3]); return w; }

template <bool SCALE> struct EpiSwiGLU {
    static constexpr bool PERM = true, ZERO_INIT = true;
    bf16_t* O; const float* ssq4; size_t plane;
    template <class Sched> DI void preload(const Sched& S, LAS unsigned char* tab) const { if (SCALE) preload_rstd(S, ssq4, tab); }
    DI void init(f32x4 (&)[2][2][4][2], const Unit&, int, int, int, int) const {}
    DI void operator()(const f32x4 (&acc)[2][2][4][2], const Unit& u, int ui, int wr, int wc, int fr_, int fq_, LAS unsigned char* scr) const {
        const int l_ = otid() & 63; const int fr = l_ & 15, fq = l_ >> 4;
        const int row0 = u.pm * BM + wr * 64 + fr; const size_t col0 = (size_t)(u.pn * 4 + wc) * plane + 8 * fq;
        bf16_t* Ob = O; asm volatile("" : "+s"(Ob));
        float rs[2][4];
        if (SCALE) load_rstd(rs, scr, ui, wr, fr);
#pragma unroll
        for (int ai = 0; ai < 2; ++ai)
#pragma unroll
            for (int m = 0; m < 4; ++m) { const int row = row0 + ai * HALF + m * 16; const float r = SCALE ? rs[ai][m] : 1.0f;
                f32x4 o[2];
#pragma unroll
                for (int n = 0; n < 2; ++n)
#pragma unroll
                    for (int h = 0; h < 2; ++h) { f32x2 g = {acc[ai][0][m][n][2 * h], acc[ai][0][m][n][2 * h + 1]}, uu = {acc[ai][1][m][n][2 * h], acc[ai][1][m][n][2 * h + 1]};
                        if (SCALE) { g = g * r; uu = uu * r; }
                        const f32x2 v = swiglu2(g, uu); o[n][2 * h] = v[0]; o[n][2 * h + 1] = v[1]; }
                __builtin_nontemporal_store(pack8(o[0], o[1]), (GAS u32x4*)((GAS bf16_t*)Ob + (size_t)row * 32 + col0)); }
    }
};
template <int MODE> struct EpiResid {
    static constexpr bool PERM = true, ZERO_INIT = false;
    const float* R; float* out; bf16_t* XB; float* ssq4;
    template <class Sched> DI void preload(const Sched&, LAS unsigned char*) const {}
    DI void init(f32x4 (&acc)[2][2][4][2], const Unit& u, int wr, int wc, int fr_, int fq_) const {
        const int l_ = otid() & 63; const int fr = l_ & 15, fq = l_ >> 4;
        const int row0 = u.pm * BM + wr * 64 + fr, col0 = u.pn * BM + wc * 64 + 8 * fq;
        if (MODE == 0) {
#pragma unroll
            for (int ai = 0; ai < 2; ++ai)
#pragma unroll
                for (int m = 0; m < 4; ++m)
#pragma unroll
                    for (int bj = 0; bj < 2; ++bj) { const float* p = R + (size_t)(row0 + ai * HALF + m * 16) * D + col0 + bj * 32;
                        acc[ai][bj][m][0] = *(const f32x4*)p; acc[ai][bj][m][1] = *(const f32x4*)(p + 4); }
        } else {
            u32x4 w[2][4][2];
#pragma unroll
            for (int ai = 0; ai < 2; ++ai)
#pragma unroll
                for (int m = 0; m < 4; ++m)
#pragma unroll
                    for (int bj = 0; bj < 2; ++bj) w[ai][m][bj] = *(const u32x4*)(XB + (size_t)(row0 + ai * HALF + m * 16) * D + col0 + bj * 32);
#pragma unroll
            for (int ai = 0; ai < 2; ++ai)
#pragma unroll
                for (int m = 0; m < 4; ++m)
#pragma unroll
                    for (int bj = 0; bj < 2; ++bj) { const u32x4 x = w[ai][m][bj];
                        acc[ai][bj][m][0] = (f32x4){bf2f(x[0] & 0xffffu), bf2f(x[0] >> 16), bf2f(x[1] & 0xffffu), bf2f(x[1] >> 16)};
                        acc[ai][bj][m][1] = (f32x4){bf2f(x[2] & 0xffffu), bf2f(x[2] >> 16), bf2f(x[3] & 0xffffu), bf2f(x[3] >> 16)}; }
        }
    }
    DI void operator()(const f32x4 (&acc)[2][2][4][2], const Unit& u, int ui, int wr, int wc, int fr_, int fq_, LAS unsigned char* scr) const {
        const int l_ = otid() & 63; const int fr = l_ & 15, fq = l_ >> 4;
        const int col0 = u.pn * BM + wc * 64 + 8 * fq;
        LAS float* S = (LAS float*)scr;
#pragma unroll
        for (int ai = 0; ai < 2; ++ai)
#pragma unroll
            for (int m = 0; m < 4; ++m) { const int rl = ai * HALF + wr * 64 + m * 16 + fr; const int row = u.pm * BM + rl; float ss = 0.f;
                if (MODE == 2) {
#pragma unroll
                    for (int bj = 0; bj < 2; ++bj) { const size_t off = (size_t)row * D + col0 + bj * 32; *(f32x4*)(out + off) = acc[ai][bj][m][0]; *(f32x4*)(out + off + 4) = acc[ai][bj][m][1]; }
                } else {
#pragma unroll
                    for (int bj = 0; bj < 2; ++bj) { const f32x4 v0 = acc[ai][bj][m][0], v1 = acc[ai][bj][m][1];
                        ss += (v0[0] * v0[0] + v0[1] * v0[1]) + (v0[2] * v0[2] + v0[3] * v0[3]) + (v1[0] * v1[0] + v1[1] * v1[1]) + (v1[2] * v1[2] + v1[3] * v1[3]); }
                    store_rows16((GAS bf16_t*)XB + (size_t)(row - fr) * D + u.pn * BM + wc * 64, (size_t)D, fr, fq, pack8(acc[ai][0][m][0], acc[ai][0][m][1]), pack8(acc[ai][1][m][0], acc[ai][1][m][1])); }
                if (MODE != 2) { ss += __shfl_xor(ss, 16); ss += __shfl_xor(ss, 32); if (fq == 0) S[rl * 4 + wc] = ss; } }
        if (MODE != 2) {
            asm volatile("s_waitcnt lgkmcnt(0)" ::: "memory"); __builtin_amdgcn_s_barrier(); asm volatile("" ::: "memory");
            const int t = otid();
            if (t < 256) { const f32x4 p = *(const LAS f32x4*)(S + t * 4); ssq4[(size_t)u.pn * M + (u.pm * BM + t)] = (p[0] + p[1]) + (p[2] + p[3]); }
        }
    }
};
template <bool SCALE> struct EpiPlain {
    static constexpr bool PERM = true, ZERO_INIT = true;
    bf16_t* O; int ldc; const float* ssq4;
    template <class Sched> DI void preload(const Sched& S, LAS unsigned char* tab) const { if (SCALE) preload_rstd(S, ssq4, tab); }
    DI void init(f32x4 (&)[2][2][4][2], const Unit&, int, int, int, int) const {}
    DI void operator()(const f32x4 (&acc)[2][2][4][2], const Unit& u, int ui, int wr, int wc, int fr_, int fq_, LAS unsigned char* scr) const {
        const int l_ = otid() & 63; const int fr = l_ & 15, fq = l_ >> 4;
        const int row0 = u.pm * BM + wr * 64;
        bf16_t* Ob = O; asm volatile("" : "+s"(Ob));
        float rs[2][4];
        if (SCALE) load_rstd(rs, scr, ui, wr, fr);
#pragma unroll
        for (int ai = 0; ai < 2; ++ai)
#pragma unroll
            for (int m = 0; m < 4; ++m) { const int row = row0 + ai * HALF + m * 16; const float r = SCALE ? rs[ai][m] : 1.0f;
                store_rows16((GAS bf16_t*)Ob + (size_t)row * ldc + u.pn * BM + wc * 64, (size_t)ldc, fr, fq, pack8(acc[ai][0][m][0] * r, acc[ai][0][m][1] * r), pack8(acc[ai][1][m][0] * r, acc[ai][1][m][1] * r)); }
    }
};
struct EpiInProj {
    static constexpr bool PERM = true, ZERO_INIT = true;
    bf16_t* O; const float* ssq4; const float* cosA; const float* sinA; const float* cosR; const float* sinR;
    template <class Sched> DI void preload(const Sched& S, LAS unsigned char* tab) const { preload_rstd(S, ssq4, tab); }
    DI void init(f32x4 (&)[2][2][4][2], const Unit&, int, int, int, int) const {}
    DI void operator()(const f32x4 (&acc)[2][2][4][2], const Unit& u, int ui, int wr, int wc, int fr_, int fq_, LAS unsigned char* scr) const {
        const int l_ = otid() & 63; const int fr = l_ & 15, fq = l_ >> 4;
        bf16_t* Ob = O; asm volatile("" : "+s"(Ob));
        const int kind = (u.pn < 4) ? 1 : ((u.pn == 6 || u.pn == 7) ? 2 : 0);
        float rs[2][4];
        load_rstd(rs, scr, ui, wr, fr);
        int sec, hw, head, coff;
        if (u.pn < 6) { sec = 512 * (u.pn >> 1); hw = 64; head = (u.pn & 1) * 4 + wc; coff = 0; }
        else if (u.pn < 8) { sec = 1536 + 256 * (u.pn - 6); hw = 64; head = wc; coff = 0; }
        else { sec = 2048 + 512 * ((u.pn - 8) >> 1); hw = 128; head = (u.pn & 1) * 2 + (wc >> 1); coff = (wc & 1) * 64; }
        const int prow = u.pm * BM, b = prow / SEQ, t0 = (prow & (SEQ - 1)) + wr * 64;
        GAS bf16_t* base = (GAS bf16_t*)Ob + ((size_t)b * SEQ * INC + (size_t)SEQ * sec + ((size_t)head * SEQ + t0) * hw) + coff;
        float irev[2][4];
        { const float l2t = (kind == 1) ? 18.931568569324174f   : 13.287712379549449f  ; const float inv_half = (kind == 1) ? 0.125f : 0.03125f;
#pragma unroll
          for (int bj = 0; bj < 2; ++bj) { const bool act = (kind == 2) || (kind == 1 && bj == 0 && fq < 2); const int c0 = 4 * (4 * bj + fq);
#pragma unroll
            for (int i = 0; i < 4; ++i) irev[bj][i] = act ? fast_exp2(-l2t * (float)(c0 + i) * inv_half) * 0.15915494309189535f : 0.0f; } }
        if (kind == 2) body<2>(acc, rs, irev, t0 + fr, base, hw, fr, fq); else if (kind == 1) body<1>(acc, rs, irev, t0 + fr, base, hw, fr, fq); else body<0>(acc, rs, irev, t0 + fr, base, hw, fr, fq);
    }
    template <int NROT> DI void body(const f32x4 (&acc)[2][2][4][2], const float (&rs)[2][4], const float (&irev)[2][4], int t, GAS bf16_t* base, int hw, int fr, int fq) const {
#pragma unroll
        for (int g2 = 0; g2 < 8; ++g2) {
            const int ai = g2 >> 2, m = g2 & 3; const float r = rs[ai][m];
            u32x4 pc[2];
#pragma unroll
            for (int bj = 0; bj < 2; ++bj) { f32x4 v0 = acc[ai][bj][m][0] * r, v1 = acc[ai][bj][m][1] * r;
                if (bj < NROT) { const float tf = (float)(t + ai * HALF + m * 16); f32x4 c, sn;
#pragma unroll
                    for (int i = 0; i < 4; ++i) { const float ra = __builtin_amdgcn_fractf(tf * irev[bj][i]); c[i] = __builtin_amdgcn_cosf(ra); sn[i] = __builtin_amdgcn_sinf(ra); }
                    const f32x4 n0 = v0 * c - v1 * sn, n1 = v1 * c + v0 * sn; v0 = n0; v1 = n1; }
                pc[bj] = pack8(v0, v1); }
            store_rows16<true>(base + (size_t)((8 * ai + m) * 16) * hw, (size_t)hw, fr, fq, pc[0], pc[1]);
        }
    }
};
}

constexpr size_t MiB = 1u << 20;
constexpr size_t al(size_t x) { return (x + 255) & ~(size_t)255; }
constexpr size_t WS_CTL = 0, CTL_ZERO_BYTES = 262144;
constexpr size_t WS_W1IN = 1 * MiB;
constexpr size_t WS_W1OUT = WS_W1IN + (size_t)2 * DFF * D * 2;
constexpr size_t WS_WIN = WS_W1OUT + (size_t)D * DFF * 2;
constexpr size_t WS_WOUT = WS_WIN + (size_t)INC * D * 2;
constexpr size_t WS_WCQ = WS_WOUT + (size_t)D * D * 2;
constexpr size_t WS_WCKV = WS_WCQ + (size_t)D * D * 2;
constexpr size_t WS_WCO = WS_WCKV + (size_t)2 * D * D * 2;
constexpr size_t WS_W2IN = WS_WCO + (size_t)D * D * 2;
constexpr size_t WS_W2OUT = WS_W2IN + (size_t)2 * DFF * D * 2;
constexpr size_t WS_TAB = WS_W2OUT + (size_t)D * DFF * 2;
constexpr size_t WS_COSA = WS_TAB, WS_SINA = WS_COSA + (size_t)SEQ * 8 * 4, WS_COSR = WS_SINA + (size_t)SEQ * 8 * 4, WS_SINR = WS_COSR + (size_t)SEQ * 32 * 4;
constexpr size_t WS_MEMN = WS_SINR + (size_t)SEQ * 32 * 4;
constexpr size_t WS_KC = WS_MEMN + (size_t)MROWS * D * 2;
constexpr size_t WS_VT = WS_KC + (size_t)MROWS * D * 2;
constexpr size_t WS_SSQ = WS_VT + (size_t)MROWS * D * 2;
constexpr size_t WS_XB = al(WS_SSQ + (size_t)M * 16 * 4);
constexpr size_t WS_BIG = WS_XB + (size_t)M * D * 2;
constexpr size_t WS_OMIX = WS_BIG + (size_t)M * INC * 2;
constexpr size_t WS_ATT = WS_OMIX + (size_t)M * D * 2;
constexpr size_t WS_ATT_BYTES = (size_t)M * 512 * 2 * 3 + (size_t)M * 8 * 4 * 3;
constexpr size_t WS_RET = WS_ATT + WS_ATT_BYTES;
constexpr size_t WS_RETH = WS_RET + (size_t)NBATCH * 64 * 4 * 64 * 128 * 4;
constexpr size_t WS_XRES = WS_RETH + (size_t)NBATCH * 64 * 4 * 64 * 128 * 2;
constexpr size_t WS_OPT_END = WS_XRES;
static_assert(WS_XRES <= (size_t)1024 * MiB, "workspace map exceeds 4 x the largest tensor");

constexpr int RING_OFF = 0, RING_BYTES = 131072;
constexpr int LDSCTL_OFF = 163840 - 256, MISC_OFF = LDSCTL_OFF;
constexpr int LDS_BYTES = 163840;
constexpr int NWAVES = 8;

#define XB_TMO      128
#define XB_XCNT(j)  (256  + 64 * (j))
#define XB_XSUB(j)  (1280 + 64 * (j))
#define XB_XGEN(j)  (2304 + 64 * (j))
#define XB_TOP      3328
#define XB_TOPGEN   3392
#define XCD_BAR_WORDS 3456
#define XB_SPIN_CAP (1u << 18)
DI unsigned xb_ld(unsigned* p)              { return __hip_atomic_load(p, __ATOMIC_RELAXED, __HIP_MEMORY_SCOPE_AGENT); }
DI unsigned xb_add(unsigned* p, unsigned v) { return __hip_atomic_fetch_add(p, v, __ATOMIC_RELAXED, __HIP_MEMORY_SCOPE_AGENT); }
DI unsigned xb_xcc_id() { return (unsigned)__builtin_amdgcn_s_getreg((3 << 11) | 20) & 0xFu; }
#define XB_SPIN(cond, bar) do { unsigned _sp = 0; while (cond) { __builtin_amdgcn_s_sleep(1); \
    if ((++_sp & 255u) == 0u) { if (xb_ld(&(bar)[XB_TMO])) break; if (_sp > XB_SPIN_CAP) { atomicAdd(&(bar)[XB_TMO], 1u); break; } } } } while (0)
struct XcdBarrier { unsigned* bar; unsigned x; volatile LAS unsigned* st; unsigned n; };
DI XcdBarrier xcd_barrier_post(unsigned* bar, volatile LAS unsigned* st, unsigned n) {
    XcdBarrier b; b.bar = bar; b.x = xb_xcc_id(); b.st = st; b.n = n;
    if (threadIdx.x == 0) (void)xb_add(&bar[XB_XCNT(b.x)], 1u);
    return b;
}
DI void xcd_barrier_complete(unsigned* bar, unsigned x, unsigned G, unsigned& nloc, unsigned& nx) {
    unsigned sum, cnt, mine, sp = 0u;
    for (;;) {
        sum = 0u; cnt = 0u; mine = 0u;
#pragma unroll
        for (unsigned j = 0; j < 16; ++j) { const unsigned c = xb_ld(&bar[XB_XCNT(j)]); sum += c; cnt += (c > 0u) ? 1u : 0u; mine = (j == x) ? c : mine; }
        if (sum == G) break;
        __builtin_amdgcn_s_sleep(1);
        if ((++sp & 255u) == 0u) { if (xb_ld(&bar[XB_TMO])) break; if (sp > XB_SPIN_CAP) { atomicAdd(&bar[XB_TMO], 1u); break; } }
    }
    nloc = mine > 0u ? mine : 1u; nx = cnt > 0u ? cnt : 1u;
}
DI void xcd_barrier(const XcdBarrier& b) {
    asm volatile("s_waitcnt vmcnt(0)" ::: "memory");
    __syncthreads();
    const unsigned nx0 = b.st[1];
    if (threadIdx.x == 64 && nx0 == 1u) { __builtin_amdgcn_fence(__ATOMIC_ACQUIRE, "agent"); asm volatile("s_waitcnt vmcnt(0)" ::: "memory"); }
    if (threadIdx.x == 0) {
        unsigned* bar = b.bar;
        __builtin_amdgcn_s_waitcnt(0);
        unsigned nloc = b.st[0], nx = b.st[1];
        if (nloc == 0u) { xcd_barrier_complete(bar, b.x, b.n, nloc, nx); b.st[0] = nloc; b.st[1] = nx; }
        const unsigned old = xb_add(&bar[XB_XSUB(b.x)], 1u);
        const unsigned gen = old / nloc;
        if (nx == 1u) {
            if (old + 1u == (gen + 1u) * nloc) xb_add(&bar[XB_XGEN(b.x)], 1u);
            else XB_SPIN(xb_ld(&bar[XB_XGEN(b.x)]) == gen, bar);
            if (nx0 != 1u) __builtin_amdgcn_fence(__ATOMIC_ACQUIRE, "agent");
            asm volatile("s_waitcnt vmcnt(0)" ::: "memory");
        } else if (old + 1u == (gen + 1u) * nloc) {
            __builtin_amdgcn_fence(__ATOMIC_RELEASE, "agent");
            asm volatile("s_waitcnt vmcnt(0)" ::: "memory");
            const unsigned og = xb_add(&bar[XB_TOP], 1u);
            const unsigned tg = og / nx;
            if (og + 1u == (tg + 1u) * nx) xb_add(&bar[XB_TOPGEN], 1u);
            else XB_SPIN(xb_ld(&bar[XB_TOPGEN]) == tg, bar);
            __builtin_amdgcn_fence(__ATOMIC_ACQUIRE, "agent");
            xb_add(&bar[XB_XGEN(b.x)], 1u);
            asm volatile("s_waitcnt vmcnt(0)" ::: "memory");
        } else {
            XB_SPIN(xb_ld(&bar[XB_XGEN(b.x)]) == gen, bar);
            __builtin_amdgcn_fence(__ATOMIC_ACQUIRE, "agent");
            asm volatile("s_waitcnt vmcnt(0)" ::: "memory");
        }
    }
    __syncthreads();
}
constexpr int CW_BAR = 4096;

struct Args {
    const float* in[17]; float* out; unsigned char* ws; float* xres;
    int ph_lo, ph_hi;
};

DI float wave_sum(float v) {
#pragma unroll
    for (int o = 1; o < 64; o <<= 1) v += __shfl_xor(v, o);
    return v;
}
DI float wave_max(float v) {
#pragma unroll
    for (int o = 1; o < 64; o <<= 1) v = fmaxf(v, __shfl_xor(v, o));
    return v;
}

DI int tile_map(int n) { const int j = n & 255; return (n - j) + 128 * ((j >> 5) & 1) + 32 * (j >> 6) + (j & 31); }
DI int wmap_row(int mat, int n) {
    if (mat == 0 || mat == 7) { const int u = n >= DFF, j = u ? n - DFF : n; return 256 * (j >> 7) + 128 * u + (j & 127); }
    if (mat == 2 && n >= 1536 && n < 2048) { const int c = n & 63, x2 = c >> 5, cc = c & 31; return tile_map((n - c) + 8 * (cc >> 2) + 4 * x2 + (cc & 3)); }
    if (mat == 2 && n < 1024 && (n & 63) < 16) { const int c = n & 15, x2 = c >> 3, cc = c & 7; return tile_map((n - c) + 8 * (cc >> 2) + 4 * x2 + (cc & 3)); }
    if (mat == 1 || mat == 2 || mat == 3 || mat == 4 || mat == 5 || mat == 6 || mat == 8) return tile_map(n);
    return n;
}
DI float wmap_scale(int mat, int n) {
    if (mat == 2) return (n < 512) ? 0.125f * LOG2E : ((n >= 1792 && n < 2048) ? 0.125f : 1.0f);
    if (mat == 4) return 0.0625f * LOG2E;
    if (mat == 1 || mat == 8) return 0.5f;
    if (mat == 0 || mat == 7) return (n < DFF) ? LOG2E : (1.0f / LOG2E);
    return 1.0f;
}
DI void p0_transpose_item(const float* W, int K, int N, bf16_t* WT, int mat, const float* nw, LAS float* scr, int item, int lane) {
    const int nblk = N / 32, kb = item / nblk, nb = item % nblk, k0 = 64 * kb, n0 = 32 * nb;
    float wv[32];
#pragma unroll
    for (int i = 0; i < 32; ++i) wv[i] = W[(size_t)(k0 + 2 * i + (lane >> 5)) * N + n0 + (lane & 31)];
    const float s0 = nw ? nw[k0 + (lane & 31) * 2 + 0] : 1.0f, s1 = nw ? nw[k0 + (lane & 31) * 2 + 1] : 1.0f;
#pragma unroll
    for (int i = 0; i < 32; ++i) { const float sl = __shfl(s0, i), sh = __shfl(s1, i); const int kk = 2 * i + (lane >> 5); scr[kk * 33 + (lane & 31)] = wv[i] * ((lane >> 5) ? sh : sl); }
    asm volatile("s_waitcnt lgkmcnt(0)" ::: "memory");
    const int c = lane & 7;
#pragma unroll
    for (int j = 0; j < 4; ++j) { const int n = (lane >> 3) + 8 * j; const LAS float* s = scr + (8 * c) * 33 + n; const float sc = wmap_scale(mat, n0 + n);
        u32x4 o; o.x = cvt_pk_bf16(s[0 * 33] * sc, s[1 * 33] * sc); o.y = cvt_pk_bf16(s[2 * 33] * sc, s[3 * 33] * sc); o.z = cvt_pk_bf16(s[4 * 33] * sc, s[5 * 33] * sc); o.w = cvt_pk_bf16(s[6 * 33] * sc, s[7 * 33] * sc);
        *(u32x4*)(WT + (size_t)((k0 + 8 * c) >> 5) * N * 32 + (size_t)wmap_row(mat, n0 + n) * 32 + ((k0 + 8 * c) & 31)) = o; }
    asm volatile("s_waitcnt lgkmcnt(0)" ::: "memory");
}
DI void rms_row_to_bf16(const float* xrow, const float* w, bf16_t* orow, int lane) {
    const f32x4* xr = (const f32x4*)xrow + lane;
    f32x4 v[4]; float s = 0.f;
#pragma unroll
    for (int j = 0; j < 4; ++j) { v[j] = xr[64 * j]; s += (v[j][0] * v[j][0] + v[j][1] * v[j][1]) + (v[j][2] * v[j][2] + v[j][3] * v[j][3]); }
    const float r = rsqrtf(wave_sum(s) * (1.f / D) + EPS);
    u32x2* o8 = (u32x2*)orow + lane;
#pragma unroll
    for (int j = 0; j < 4; ++j) { const f32x4 ww = ((const f32x4*)w)[lane + 64 * j]; u32x2 o; o.x = cvt_pk_bf16(v[j][0] * r * ww[0], v[j][1] * r * ww[1]); o.y = cvt_pk_bf16(v[j][2] * r * ww[2], v[j][3] * r * ww[3]); o8[64 * j] = o; }
}

DI void rms_row4_to_bf16(const float* x, const float* w, bf16_t* o, int m0, int stride, int mend, int lane) {
    f32x4 v[4][4]; float ss[4];
#pragma unroll
    for (int q = 0; q < 4; ++q) { const int m = (m0 + q * stride < mend) ? m0 + q * stride : m0; const f32x4* r = (const f32x4*)(x + (size_t)m * D);
#pragma unroll
        for (int j = 0; j < 2; ++j) { v[q][2 * j] = r[128 * j + 2 * lane]; v[q][2 * j + 1] = r[128 * j + 2 * lane + 1]; } }
#pragma unroll
    for (int q = 0; q < 4; ++q) { float a = 0.f;
#pragma unroll
        for (int j = 0; j < 4; ++j) a += (v[q][j][0] * v[q][j][0] + v[q][j][1] * v[q][j][1]) + (v[q][j][2] * v[q][j][2] + v[q][j][3] * v[q][j][3]);
        ss[q] = a; }
#pragma unroll
    for (int q = 0; q < 4; ++q) ss[q] = rsqrtf(wave_sum(ss[q]) * (1.f / D) + EPS);
#pragma unroll
    for (int j = 0; j < 2; ++j) { const f32x4 w0 = ((const f32x4*)w)[128 * j + 2 * lane], w1 = ((const f32x4*)w)[128 * j + 2 * lane + 1];
#pragma unroll
        for (int q = 0; q < 4; ++q) if (m0 + q * stride < mend) { const float r = ss[q]; const f32x4 a = v[q][2 * j] * r * w0, b = v[q][2 * j + 1] * r * w1;
            u32x4 ov; ov.x = cvt_pk_bf16(a[0], a[1]); ov.y = cvt_pk_bf16(a[2], a[3]); ov.z = cvt_pk_bf16(b[0], b[1]); ov.w = cvt_pk_bf16(b[2], b[3]);
            ((u32x4*)(o + (size_t)(m0 + q * stride) * D))[64 * j + lane] = ov; } }
}
DI void rms_row2_to_bf16(const float* xa, const float* xb, const float* w, bf16_t* oa, bf16_t* ob, int lane) {
    const f32x4* ra = (const f32x4*)xa + lane; const f32x4* rb = (const f32x4*)(xb ? xb : xa) + lane;
    f32x4 va[4], vb[4]; float sa = 0.f, sb = 0.f;
#pragma unroll
    for (int j = 0; j < 4; ++j) { va[j] = ra[64 * j]; vb[j] = rb[64 * j]; }
#pragma unroll
    for (int j = 0; j < 4; ++j) { sa += (va[j][0] * va[j][0] + va[j][1] * va[j][1]) + (va[j][2] * va[j][2] + va[j][3] * va[j][3]); sb += (vb[j][0] * vb[j][0] + vb[j][1] * vb[j][1]) + (vb[j][2] * vb[j][2] + vb[j][3] * vb[j][3]); }
    const float r0 = rsqrtf(wave_sum(sa) * (1.f / D) + EPS), r1 = rsqrtf(wave_sum(sb) * (1.f / D) + EPS);
    u32x2* pa = (u32x2*)oa + lane; u32x2* pb = (u32x2*)ob + lane;
#pragma unroll
    for (int j = 0; j < 4; ++j) { const f32x4 ww = ((const f32x4*)w)[lane + 64 * j];
        u32x2 o; o.x = cvt_pk_bf16(va[j][0] * r0 * ww[0], va[j][1] * r0 * ww[1]); o.y = cvt_pk_bf16(va[j][2] * r0 * ww[2], va[j][3] * r0 * ww[3]); pa[64 * j] = o;
        if (xb) { u32x2 p; p.x = cvt_pk_bf16(vb[j][0] * r1 * ww[0], vb[j][1] * r1 * ww[1]); p.y = cvt_pk_bf16(vb[j][2] * r1 * ww[2], vb[j][3] * r1 * ww[3]); pb[64 * j] = p; } }
}

namespace da {
typedef float f32x16 __attribute__((ext_vector_type(16)));
typedef short s16x4 __attribute__((ext_vector_type(4)));
typedef __bf16 bf16x2_t __attribute__((ext_vector_type(2)));
constexpr int K_OFF = 0, V_OFF = 49152, V_D0 = 24640, OST_OFF = V_OFF + V_D0 + 24576;
static_assert(OST_OFF + 8 * 4096 <= MISC_OFF, "attention LDS map");
DI int crow(int r, int hi) { return (r & 3) + 8 * (r >> 2) + 4 * hi; }
DI unsigned cvtpk(float lo, float hi) { f32x2 v = {lo, hi}; bf16x2_t b = __builtin_convertvector(v, bf16x2_t); return __builtin_bit_cast(unsigned, b); }
DI s16x4 vtr(LAS unsigned char* p) { return __builtin_bit_cast(s16x4, __builtin_amdgcn_ds_read_tr16_b64_v4i16((LAS s16x4*)p)); }
struct Dec { int b, h, g, d, r, blk; };
DI Dec decode(int uid) { Dec u; const int u32i = uid & 31, ghb = uid >> 5; u.g = ghb % 3; const int bh = ghb / 3; u.h = bh & 7; u.b = bh >> 3;
    u.d = (u.g == 0) ? 1 : ((u.g == 1) ? 4 : 16); const int nblk = 32 / u.d; u.blk = u32i % nblk; u.r = u32i / nblk; return u; }
struct Regs { u32x4 k[6], v[6], q[4]; };
DI void load_regs(Regs& R, const Dec& u, const bf16_t* proj, int tid) {
    const int lane = tid & 63, w = tid >> 6;
#pragma unroll
    for (int i = 0; i < 6; ++i) { const int id = tid + 512 * i, uk = id >> 3, c = id & 7; int sk = 256 * u.blk - 128 + uk; sk = sk < 0 ? 0 : sk;
        const size_t ro = hm_off(0, 8, 64, u.b, u.h, sk * u.d + u.r) + 8 * c;
        R.k[i] = *(const u32x4*)(proj + (size_t)SEQ * 512 + ro); R.v[i] = *(const u32x4*)(proj + (size_t)SEQ * 1024 + ro); }
    const int s = 256 * u.blk + 32 * w + (lane & 31);
    const bf16_t* qp = proj + hm_off(0, 8, 64, u.b, u.h, s * u.d + u.r) + 8 * (lane >> 5);
#pragma unroll
    for (int ks = 0; ks < 4; ++ks) R.q[ks] = *(const u32x4*)(qp + 16 * ks);
}
DI void write_lds(const Regs& R, const Dec& u, LAS unsigned char* lds, int tid) {
#pragma unroll
    for (int i = 0; i < 6; ++i) { const int id = tid + 512 * i, uk = id >> 3, c = id & 7; const bool valid = (u.blk > 0) || (uk >= 128);
        const u32x4 z = {0u, 0u, 0u, 0u};
        *(LAS u32x4*)(lds + K_OFF + 128 * uk + 16 * (c ^ ((uk >> 1) & 7))) = valid ? R.k[i] : z;
        *(LAS u32x4*)(lds + V_OFF + (c >> 2) * V_D0 + 64 * uk + 16 * (c & 3)) = valid ? R.v[i] : z; }
}
DI void qk_part(f32x16 (&S)[5], const Regs& R, LAS unsigned char* lds, int tid) {
    const int lane = tid & 63, w = __builtin_amdgcn_readfirstlane(tid >> 6), q = lane & 31, hi = lane >> 5;
#pragma unroll
    for (int j = 0; j < 5; ++j) {
        const int uk = 32 * (w + j) + q;
        f32x16 acc;
#pragma unroll
        for (int r = 0; r < 16; ++r) acc[r] = 0.f;
#pragma unroll
        for (int ks = 0; ks < 4; ++ks) { const bf16x8 kf = *(const LAS bf16x8*)(lds + K_OFF + 128 * uk + 16 * ((2 * ks + hi) ^ ((uk >> 1) & 7)));
            acc = __builtin_amdgcn_mfma_f32_32x32x16_bf16(kf, __builtin_bit_cast(bf16x8, R.q[ks]), acc, 0, 0, 0); }
        S[j] = acc;
    }
}
DI void softmax_part(f32x16 (&S)[5], u32x4 (&Pk)[5][2], float& m_out, float& l_out, const Dec& u, int tid) {
    const int lane = tid & 63, w = __builtin_amdgcn_readfirstlane(tid >> 6), q = lane & 31, hi = lane >> 5;
    float m = -1e30f;
#pragma unroll
    for (int r = 0; r < 16; ++r) { const int kk = crow(r, hi); if (kk < q) S[0][r] = -1e30f; if (kk > q) S[4][r] = -1e30f; }
    if (u.blk == 0) {
#pragma unroll
        for (int j = 0; j < 4; ++j) if (w + j < 4) {
#pragma unroll
            for (int r = 0; r < 16; ++r) S[j][r] = -1e30f; }
    }
#pragma unroll
    for (int j = 0; j < 5; ++j)
#pragma unroll
        for (int r = 0; r < 16; ++r) m = fmaxf(m, S[j][r]);
    m = fmaxf(m, __shfl_xor(m, 32));
    f32x2 l2 = {0.f, 0.f};
#pragma unroll
    for (int j = 0; j < 5; ++j)
#pragma unroll
        for (int r = 0; r < 16; r += 2) { f32x2 d = {S[j][r], S[j][r + 1]}; d = d - m; const f32x2 p = {fast_exp2(d[0]), fast_exp2(d[1])}; S[j][r] = p[0]; S[j][r + 1] = p[1]; l2 = l2 + p; }
    float l = l2[0] + l2[1];
    l += __shfl_xor(l, 32);
    const float linv = fast_rcp(l);
#pragma unroll
    for (int j = 0; j < 5; ++j)
#pragma unroll
        for (int s2 = 0; s2 < 2; ++s2) { u32x4 pw;
#pragma unroll
            for (int e = 0; e < 4; ++e) { f32x2 v = {S[j][8 * s2 + 2 * e], S[j][8 * s2 + 2 * e + 1]}; v = v * linv; pw[e] = cvtpk(v[0], v[1]); }
            Pk[j][s2] = pw; }
    m_out = m; l_out = l;
}
DI void pv_part(const u32x4 (&Pk)[5][2], float m, float l, const Dec& u, LAS unsigned char* lds, bf16_t* part, float* lsep, int tid) {
    const int lane = tid & 63, w = __builtin_amdgcn_readfirstlane(tid >> 6), q = lane & 31, hi = lane >> 5;
    f32x16 o[2];
#pragma unroll
    for (int r = 0; r < 16; ++r) { o[0][r] = 0.f; o[1][r] = 0.f; }
    const int vlane = ((lane >> 4) & 1) * 32 + (lane & 3) * 8 + (4 * hi + ((lane & 15) >> 2)) * 64;
#pragma unroll
    for (int j = 0; j < 5; ++j)
#pragma unroll
        for (int s2 = 0; s2 < 2; ++s2) {
            const bf16x8 pa = __builtin_bit_cast(bf16x8, Pk[j][s2]);
#pragma unroll
            for (int d0 = 0; d0 < 2; ++d0) { LAS unsigned char* vp = lds + V_OFF + d0 * V_D0 + (32 * (w + j) + 16 * s2) * 64 + vlane;
                const s16x4 lo = vtr(vp), hi4 = vtr(vp + 512);
                const bf16x8 vf = {lo[0], lo[1], lo[2], lo[3], hi4[0], hi4[1], hi4[2], hi4[3]};
                o[d0] = __builtin_amdgcn_mfma_f32_32x32x16_bf16(pa, vf, o[d0], 0, 0, 0); }
        }
    LAS bf16_t* stg = (LAS bf16_t*)(lds + OST_OFF + w * 4096);
#pragma unroll
    for (int r = 0; r < 16; ++r) { const int orow = crow(r, hi);
#pragma unroll
        for (int d0 = 0; d0 < 2; ++d0) stg[orow * 64 + d0 * 32 + q] = (bf16_t)(cvtpk(o[d0][r], 0.f) & 0xffffu); }
    asm volatile("s_waitcnt lgkmcnt(0)" ::: "memory");
    const int s0 = 256 * u.blk + 32 * w;
#pragma unroll
    for (int i = 0; i < 4; ++i) { const int row = i * 8 + (lane >> 3), ch = lane & 7; const u32x4 v = *(const LAS u32x4*)(stg + row * 64 + ch * 8);
        *(u32x4*)(part + (size_t)(u.b * SEQ + (s0 + row) * u.d + u.r) * 512 + u.h * 64 + ch * 8) = v; }
    if (hi == 0) lsep[(size_t)(u.b * 8 + u.h) * SEQ + u.r * (SEQ / u.d) + (s0 + q)] = m + __log2f(l);
}
struct UnitMap { int x, j, GX, NP, per, n, nk;
    DI void init(int x_, int j_, int GX_, int npairs, int nk_) { x = x_; j = j_; GX = GX_; NP = npairs; nk = (nk_ > 0 && GX_ == 32 && nk_ == 8) ? nk_ : 0; per = nk ? 4 : (96 + GX - 1) / GX; n = NP * per; }
    DI int uid(int i) const { const int p = i / per, s = i % per; int k;
        if (nk) { if (s < 3) k = (p == 0 && j < nk) ? 96 : 3 * j + s; else k = (p == 0 && j >= nk) ? j - nk : 96; }
        else k = j * per + s;
        return (k < 96) ? (x * NP + p) * 96 + k : -1; } };
DI void phase(LAS unsigned char* lds, const bf16_t* proj, bf16_t* attp, float* lse, const UnitMap& U) {
    int i = 0; while (i < U.n && U.uid(i) < 0) ++i;
    if (i >= U.n) return;
    Regs R; Dec cur = decode(U.uid(i));
    load_regs(R, cur, proj, otid());
    while (i < U.n) {
        int in = i + 1; while (in < U.n && U.uid(in) < 0) ++in;
        write_lds(R, cur, lds, otid());
        Regs Qc;
#pragma unroll
        for (int k = 0; k < 4; ++k) Qc.q[k] = R.q[k];
        __syncthreads();
        Dec nxt = cur;
        if (in < U.n) { nxt = decode(U.uid(in)); load_regs(R, nxt, proj, otid()); }
        u32x4 Pk[5][2]; float m, l;
        {   f32x16 S[5];
            qk_part(S, Qc, lds, otid());
            softmax_part(S, Pk, m, l, cur, otid()); }
        pv_part(Pk, m, l, cur, lds, attp + (size_t)cur.g * M * 512, lse + (size_t)cur.g * M * 8, otid());
        __syncthreads();
        cur = nxt; i = in;
    }
}
DI void merge(const bf16_t* attp, const float* lse, bf16_t* omix, int row_lo, int nrows, int gtid, int ngt) {
    const int total = nrows * 64;
    for (int i0 = gtid; i0 < total; i0 += 4 * ngt) {
        u32x4 a[4], b[4], cc[4]; float l0[4], l1[4], l2[4];
#pragma unroll
        for (int q = 0; q < 4; ++q) { const int i = (i0 + q * ngt < total) ? i0 + q * ngt : i0; const int row = row_lo + (i >> 6), h = (i >> 3) & 7, c = i & 7;
            { const int bb = row / SEQ, t = row & (SEQ - 1); const size_t bh = (size_t)(bb * 8 + h) * SEQ;
              l0[q] = lse[bh + t]; l1[q] = lse[(size_t)M * 8 + bh + (t & 3) * (SEQ / 4) + (t >> 2)]; l2[q] = lse[(size_t)2 * M * 8 + bh + (t & 15) * (SEQ / 16) + (t >> 4)]; }
            const size_t off = (size_t)row * 512 + h * 64 + c * 8;
            a[q] = __builtin_nontemporal_load((const u32x4*)(attp + off)); b[q] = __builtin_nontemporal_load((const u32x4*)(attp + (size_t)M * 512 + off)); cc[q] = __builtin_nontemporal_load((const u32x4*)(attp + (size_t)2 * M * 512 + off)); }
#pragma unroll
        for (int q = 0; q < 4; ++q) { const int i = i0 + q * ngt; if (i < total) { const int row = row_lo + (i >> 6), h = (i >> 3) & 7, c = i & 7;
            const float mm = fmaxf(fmaxf(l0[q], l1[q]), l2[q]);
            float w0 = fast_exp2(l0[q] - mm), w1 = fast_exp2(l1[q] - mm), w2 = fast_exp2(l2[q] - mm);
            const float inv = fast_rcp(w0 + w1 + w2); w0 *= inv; w1 *= inv; w2 *= inv;
            u32x4 o;
#pragma unroll
            for (int k = 0; k < 4; ++k) { const float lo = w0 * bf2f(a[q][k] & 0xffffu) + w1 * bf2f(b[q][k] & 0xffffu) + w2 * bf2f(cc[q][k] & 0xffffu);
                const float hi = w0 * bf2f(a[q][k] >> 16) + w1 * bf2f(b[q][k] >> 16) + w2 * bf2f(cc[q][k] >> 16); o[k] = cvt_pk_bf16(lo, hi); }
            *(u32x4*)(omix + (size_t)row * D + h * 64 + c * 8) = o; } }
    }
}
}


namespace xa {
using da::f32x16; using da::s16x4; using da::crow; using da::cvtpk; using da::vtr;
constexpr int KB = 0, VB = 65536, VB_STRIDE = 32832, V_D0 = 16384 + 64, OST = 32768;
static_assert(VB + 2 * VB_STRIDE <= MISC_OFF, "cross-attention LDS map");
struct St { u32x4 sr[2][4]; u32x4 q[4]; };
DI void dec(int uid, int& b, int& h, int& qblk) { qblk = uid & 31; h = (uid >> 5) & 3; b = uid >> 7; }
DI const bf16_t* q_ptr(int i, int u_lo, const bf16_t* qc, int tid) { int b, h, qblk; dec(u_lo + (i >> 3), b, h, qblk); const int lane = tid & 63, w = tid >> 6;
    return qc + (size_t)(b * SEQ + 256 * qblk + 32 * w + (lane & 31)) * INC + h * 256 + 64 * (i & 7) + 8 * (lane >> 5); }
template <int PAR> DI void stage_load(St& T, int i, int total, int u_lo, const bf16_t* kvc, int tid) {
    if (i >= total) return;
    const int st = i & 7; int b, h, qblk; dec(u_lo + (i >> 3), b, h, qblk);
    const int coff = (st < 4) ? (h * 256 + 64 * st) : (1024 + h * 256 + 64 * (st - 4));
#pragma unroll
    for (int k = 0; k < 4; ++k) { const int id = tid + 512 * k, m = id >> 3, ch = id & 7; T.sr[PAR][k] = *(const u32x4*)(kvc + (size_t)(b * MEMLEN + m) * 2048 + coff + 8 * ch); }
}
template <int PAR> DI void stage_write(const St& T, int i, int total, LAS unsigned char* lds, int tid) {
    if (i >= total) return;
    const int st = i & 7;
    if (st < 4) {
#pragma unroll
        for (int k = 0; k < 4; ++k) { const int id = tid + 512 * k, m = id >> 3, ch = id & 7; *(LAS u32x4*)(lds + KB + (st & 1) * 32768 + 128 * m + 16 * (ch ^ ((m >> 1) & 7))) = T.sr[PAR][k]; }
    } else {
#pragma unroll
        for (int k = 0; k < 4; ++k) { const int id = tid + 512 * k, m = id >> 3, ch = id & 7; *(LAS u32x4*)(lds + VB + (st & 1) * VB_STRIDE + (ch >> 2) * V_D0 + 64 * m + 16 * (ch & 3)) = T.sr[PAR][k]; }
    }
}
template <int st> DI void k_stage(St& T, f32x16 (&S)[8], int i, int u_lo, LAS unsigned char* lds, const bf16_t* qc, int tid) {
    const int lane = tid & 63, q = lane & 31, hi = lane >> 5;
    LAS unsigned char* kb = lds + KB + (st & 1) * 32768;
    const bf16_t* qn = q_ptr(i + 1, u_lo, qc, tid);
#pragma unroll
    for (int ks = 0; ks < 4; ++ks) { const bf16x8 qf = __builtin_bit_cast(bf16x8, T.q[ks]);
#pragma unroll
        for (int kt = 0; kt < 8; ++kt) { const int uk = 32 * kt + q;
            const bf16x8 kf = *(const LAS bf16x8*)(kb + 128 * uk + 16 * ((2 * ks + hi) ^ ((uk >> 1) & 7)));
            S[kt] = __builtin_amdgcn_mfma_f32_32x32x16_bf16(kf, qf, S[kt], 0, 0, 0); }
        if (st < 3) T.q[ks] = *(const u32x4*)(qn + 16 * ks); }
}
DI void softmax(f32x16 (&S)[8], u32x4 (&Pk)[8][2], float& linv) {
    float m = -1e30f;
#pragma unroll
    for (int kt = 0; kt < 8; ++kt)
#pragma unroll
        for (int r = 0; r < 16; ++r) m = fmaxf(m, S[kt][r]);
    m = fmaxf(m, __shfl_xor(m, 32));
    f32x2 l2 = {0.f, 0.f};
#pragma unroll
    for (int kt = 0; kt < 8; ++kt)
#pragma unroll
        for (int r = 0; r < 16; r += 2) { f32x2 d = {S[kt][r], S[kt][r + 1]}; d = d - m; const f32x2 p = {fast_exp2(d[0]), fast_exp2(d[1])}; S[kt][r] = p[0]; S[kt][r + 1] = p[1]; l2 = l2 + p; }
    float l = l2[0] + l2[1];
    l += __shfl_xor(l, 32);
    linv = fast_rcp(l);
#pragma unroll
    for (int kt = 0; kt < 8; ++kt)
#pragma unroll
        for (int s2 = 0; s2 < 2; ++s2) { u32x4 pw;
#pragma unroll
            for (int e = 0; e < 4; ++e) { f32x2 v = {S[kt][8 * s2 + 2 * e], S[kt][8 * s2 + 2 * e + 1]}; v = v * linv; pw[e] = cvtpk(v[0], v[1]); }
            Pk[kt][s2] = pw; }
}
template <int st> DI void v_stage(St& T, const u32x4 (&Pk)[8][2], float linv, int i, int total, int u_lo, LAS unsigned char* lds, const bf16_t* qc, bf16_t* oc, int tid) {
    const int lane = tid & 63, w = __builtin_amdgcn_readfirstlane(tid >> 6), q = lane & 31, hi = lane >> 5;
    const int vc = st - 4; int b, h, qblk; dec(u_lo + (i >> 3), b, h, qblk);
    if (st == 7 && i + 1 < total) { const bf16_t* qn = q_ptr(i + 1, u_lo, qc, tid);
#pragma unroll
        for (int ks = 0; ks < 4; ++ks) T.q[ks] = *(const u32x4*)(qn + 16 * ks); }
    LAS unsigned char* vb = lds + VB + (st & 1) * VB_STRIDE;
    const int vlane = ((lane >> 4) & 1) * 32 + (lane & 3) * 8 + (4 * hi + ((lane & 15) >> 2)) * 64;
    f32x16 o[2];
#pragma unroll
    for (int r = 0; r < 16; ++r) { o[0][r] = 0.f; o[1][r] = 0.f; }
#pragma unroll
    for (int kt = 0; kt < 8; ++kt)
#pragma unroll
        for (int s2 = 0; s2 < 2; ++s2) { const bf16x8 pa = __builtin_bit_cast(bf16x8, Pk[kt][s2]);
#pragma unroll
            for (int d0 = 0; d0 < 2; ++d0) { LAS unsigned char* vp = vb + d0 * V_D0 + (32 * kt + 16 * s2) * 64 + vlane;
                const s16x4 lo = vtr(vp), hi4 = vtr(vp + 512);
                const bf16x8 vf = {lo[0], lo[1], lo[2], lo[3], hi4[0], hi4[1], hi4[2], hi4[3]};
                o[d0] = __builtin_amdgcn_mfma_f32_32x32x16_bf16(vf, pa, o[d0], 0, 0, 0); } }
    LAS bf16_t* stg = (LAS bf16_t*)(lds + OST + w * 4096);
#pragma unroll
    for (int d0 = 0; d0 < 2; ++d0)
#pragma unroll
        for (int g = 0; g < 4; ++g) { const int pid = 8 * d0 + 2 * g + hi; u32x2 pw; pw.x = cvtpk(o[d0][4 * g], o[d0][4 * g + 1]); pw.y = cvtpk(o[d0][4 * g + 2], o[d0][4 * g + 3]);
            *(LAS u32x2*)((LAS unsigned char*)stg + q * 128 + 8 * (pid ^ (q & 14))) = pw; }
    asm volatile("s_waitcnt lgkmcnt(0)" ::: "memory");
#pragma unroll
    for (int k = 0; k < 4; ++k) { const int row = k * 8 + (lane >> 3), ch = lane & 7; const u32x4 v = *(const LAS u32x4*)((LAS unsigned char*)stg + row * 128 + 16 * (ch ^ ((row >> 1) & 7)));
        *(u32x4*)(oc + (size_t)(b * SEQ + 256 * qblk + 32 * w + row) * D + h * 256 + 64 * vc + ch * 8) = v; }
}
DI void phase(LAS unsigned char* lds, const bf16_t* qc, const bf16_t* kvc, bf16_t* oc, int u_lo, int u_hi, int) {
    if (u_lo >= u_hi) return;
    const int total = 8 * (u_hi - u_lo);
    St T;
    { const bf16_t* q0 = q_ptr(0, u_lo, qc, otid());
#pragma unroll
      for (int ks = 0; ks < 4; ++ks) T.q[ks] = *(const u32x4*)(q0 + 16 * ks); }
    stage_load<0>(T, 0, total, u_lo, kvc, otid()); stage_write<0>(T, 0, total, lds, otid()); stage_load<1>(T, 1, total, u_lo, kvc, otid()); stage_load<0>(T, 2, total, u_lo, kvc, otid());
    __syncthreads();
    for (int i0 = 0; i0 < total; i0 += 8) {
        u32x4 Pk[8][2]; float linv;
        {   f32x16 S[8];
#pragma unroll
            for (int kt = 0; kt < 8; ++kt)
#pragma unroll
                for (int r = 0; r < 16; ++r) S[kt][r] = 0.f;
#define XA_NEXT(i, P1) do { stage_write<P1>(T, (i) + 1, total, lds, otid()); stage_load<P1>(T, (i) + 3, total, u_lo, kvc, otid()); __syncthreads(); } while (0)
            k_stage<0>(T, S, i0 + 0, u_lo, lds, qc, otid()); XA_NEXT(i0 + 0, 1);
            k_stage<1>(T, S, i0 + 1, u_lo, lds, qc, otid()); XA_NEXT(i0 + 1, 0);
            k_stage<2>(T, S, i0 + 2, u_lo, lds, qc, otid()); XA_NEXT(i0 + 2, 1);
            k_stage<3>(T, S, i0 + 3, u_lo, lds, qc, otid()); XA_NEXT(i0 + 3, 0);
            softmax(S, Pk, linv);
        }
        v_stage<4>(T, Pk, linv, i0 + 4, total, u_lo, lds, qc, oc, otid()); XA_NEXT(i0 + 4, 1);
        v_stage<5>(T, Pk, linv, i0 + 5, total, u_lo, lds, qc, oc, otid()); XA_NEXT(i0 + 5, 0);
        v_stage<6>(T, Pk, linv, i0 + 6, total, u_lo, lds, qc, oc, otid()); XA_NEXT(i0 + 6, 1);
        v_stage<7>(T, Pk, linv, i0 + 7, total, u_lo, lds, qc, oc, otid()); XA_NEXT(i0 + 7, 0);
#undef XA_NEXT
    }
}
}


namespace rt {
using da::f32x16; using da::s16x4; using da::crow; using da::cvtpk; using da::vtr;
constexpr int VS = 8256, RS = 4160;
constexpr int KV_K = 0, KV_V = 2 * VS;
constexpr int O_K = 0, O_V = 16384, O_R = O_V + 4 * VS, O_END = O_R + 4 * RS, O_ST = O_END, O_LD = 132;
static_assert(O_ST + 128 * O_LD * 4 <= MISC_OFF, "retention LDS map");
DI float log2_gamma(int h) { return __log2f(1.0f - exp2f(-5.0f - (float)h)); }
DI void dec(int uid, int& b, int& h, int& n) { n = uid & 63; h = (uid >> 6) & 3; b = uid >> 8; }
DI size_t ret_off(int b, int n, int h) { return ((size_t)(b * 64 + n) * 4 + h) * 8192; }
DI bf16x8 tr_nat(LAS unsigned char* tile, int ks, int lane) { const int hi = lane >> 5;
    LAS unsigned char* p = tile + (16 * ks + 8 * hi + ((lane & 15) >> 2)) * 64 + ((lane >> 4) & 1) * 32 + (lane & 3) * 8;
    const s16x4 lo = vtr(p), h4 = vtr(p + 256); return (bf16x8){lo[0], lo[1], lo[2], lo[3], h4[0], h4[1], h4[2], h4[3]}; }
DI bf16x8 tr_perm(LAS unsigned char* tile, int rowbase, int lane) { const int hi = lane >> 5;
    LAS unsigned char* p = tile + (rowbase + 4 * hi + ((lane & 15) >> 2)) * 64 + ((lane >> 4) & 1) * 32 + (lane & 3) * 8;
    const s16x4 lo = vtr(p), h4 = vtr(p + 512); return (bf16x8){lo[0], lo[1], lo[2], lo[3], h4[0], h4[1], h4[2], h4[3]}; }
struct KvRegs { u32x4 k[2], v[4]; };
DI void kv_load(KvRegs& G, int uid, const bf16_t* proj, int tid) {
    int b, h, n; dec(uid, b, h, n);
    const bf16_t* kb = proj + hm_off(1792, 4, 64, b, h, 128 * n); const bf16_t* vb = proj + hm_off(2048, 4, 128, b, h, 128 * n);
#pragma unroll
    for (int i = 0; i < 2; ++i) G.k[i] = *(const u32x4*)(kb + 8 * (tid + 512 * i));
#pragma unroll
    for (int i = 0; i < 4; ++i) G.v[i] = *(const u32x4*)(vb + 8 * (tid + 512 * i));
}
DI void kv_phase(LAS unsigned char* lds, const bf16_t* proj, float* ret, int u_lo, int u_hi) {
    if (u_lo >= u_hi) return;
    KvRegs G; kv_load(G, u_lo, proj, otid());
    for (int uid = u_lo; uid < u_hi; ++uid) {
        const int tid = otid(), lane = tid & 63, w = __builtin_amdgcn_readfirstlane(tid >> 6);
        int b, h, n; dec(uid, b, h, n);
        const float lg = log2_gamma(h);
#pragma unroll
        for (int i = 0; i < 2; ++i) { const int id = tid + 512 * i, tok = id >> 3, ch = id & 7; const float dk = fast_exp2(lg * (float)(127 - tok)); u32x4 o;
#pragma unroll
            for (int k = 0; k < 4; ++k) o[k] = cvt_pk_bf16(bf2f(G.k[i][k] & 0xffffu) * dk, bf2f(G.k[i][k] >> 16) * dk);
            *(LAS u32x4*)(lds + KV_K + (ch >> 2) * VS + tok * 64 + (ch & 3) * 16) = o; }
#pragma unroll
        for (int i = 0; i < 4; ++i) { const int id = tid + 512 * i, tok = id >> 4, ch = id & 15; *(LAS u32x4*)(lds + KV_V + (ch >> 2) * VS + tok * 64 + (ch & 3) * 16) = G.v[i]; }
        __syncthreads();
        if (uid + 1 < u_hi) kv_load(G, uid + 1, proj, otid());
        const int dt = w >> 2, et = w & 3;
        f32x16 acc;
#pragma unroll
        for (int r = 0; r < 16; ++r) acc[r] = 0.f;
#pragma unroll
        for (int ks = 0; ks < 8; ++ks) { const bf16x8 a = tr_nat(lds + KV_K + dt * VS, ks, lane), bb = tr_nat(lds + KV_V + et * VS, ks, lane);
            acc = __builtin_amdgcn_mfma_f32_32x32x16_bf16(a, bb, acc, 0, 0, 0); }
        float* o = ret + ret_off(b, n, h) + (size_t)(32 * dt) * 128 + 32 * et + (lane & 31);
#pragma unroll
        for (int r = 0; r < 16; ++r) o[(size_t)crow(r, lane >> 5) * 128] = acc[r];
        __syncthreads();
    }
}
DI void scan(const float* ret, bf16_t* reth, int b0, int nb, int gtid, int ngt) {
    for (int e = gtid; e < nb * 4 * 4096; e += ngt) {
        const int de = 2 * (e & 4095), h = (e >> 12) & 3, b = b0 + (e >> 14);
        const float cd = fast_exp2(128.0f * log2_gamma(h)), gam = 1.0f - exp2f(-5.0f - (float)h);
        f32x2 R = {0.f, 0.f};
        for (int n0 = 0; n0 < 64; n0 += 16) { f32x2 t[16];
#pragma unroll
            for (int k = 0; k < 16; ++k) t[k] = __builtin_nontemporal_load((const f32x2*)(ret + ret_off(b, n0 + k, h) + de));
#pragma unroll
            for (int k = 0; k < 16; ++k) { *(unsigned*)(reth + ret_off(b, n0 + k, h) + de) = cvt_pk_bf16(R[0] * gam, R[1] * gam); R = R * cd + t[k]; } }
    }
}
struct ORegs { u32x4 k[2], v[4], q[4]; u32x2 r[4]; };
DI void out_load(ORegs& G, int uid, const bf16_t* proj, const bf16_t* reth, int tid) {
    int b, h, n; dec(uid, b, h, n);
    const int lane = tid & 63, w = tid >> 6;
    const bf16_t* kb = proj + hm_off(1792, 4, 64, b, h, 128 * n); const bf16_t* vb = proj + hm_off(2048, 4, 128, b, h, 128 * n); const bf16_t* qb = proj + hm_off(1536, 4, 64, b, h, 128 * n);
#pragma unroll
    for (int i = 0; i < 2; ++i) G.k[i] = *(const u32x4*)(kb + 8 * (tid + 512 * i));
#pragma unroll
    for (int i = 0; i < 4; ++i) G.v[i] = *(const u32x4*)(vb + 8 * (tid + 512 * i));
    const bf16_t* rp = reth + ret_off(b, n, h);
#pragma unroll
    for (int i = 0; i < 4; ++i) G.r[i] = *(const u32x2*)(rp + 4 * (tid + 512 * i));
    const bf16_t* qp = qb + (size_t)(32 * (w >> 1) + (lane & 31)) * 64 + 8 * (lane >> 5);
#pragma unroll
    for (int ks = 0; ks < 4; ++ks) G.q[ks] = *(const u32x4*)(qp + 16 * ks);
}
DI void out_write(const ORegs& G, int uid, LAS unsigned char* lds, int tid) {
    const int h = (uid >> 6) & 3; const float gam = 1.0f - exp2f(-5.0f - (float)h);
#pragma unroll
    for (int i = 0; i < 2; ++i) { const int id = tid + 512 * i, tok = id >> 3, ch = id & 7; *(LAS u32x4*)(lds + O_K + 128 * tok + 16 * (ch ^ ((tok >> 1) & 7))) = G.k[i]; }
#pragma unroll
    for (int i = 0; i < 4; ++i) { const int id = tid + 512 * i, tok = id >> 4, ch = id & 15; *(LAS u32x4*)(lds + O_V + (ch >> 2) * VS + tok * 64 + (ch & 3) * 16) = G.v[i]; }
#pragma unroll
    for (int i = 0; i < 4; ++i) { const int id = tid + 512 * i, d = id >> 5, e = 4 * (id & 31);
        *(LAS u32x2*)(lds + O_R + (e >> 5) * RS + d * 64 + (e & 31) * 2) = G.r[i]; }
}
DI void out_phase(LAS unsigned char* lds, const bf16_t* proj, const bf16_t* ret, bf16_t* omix, int u_lo, int u_hi, int) {
    if (u_lo >= u_hi) return;
    ORegs G; out_load(G, u_lo, proj, ret, otid());
    for (int uid = u_lo; uid < u_hi; ++uid) {
        const int tid = otid(), lane = tid & 63, w = __builtin_amdgcn_readfirstlane(tid >> 6), q = lane & 31, hi = lane >> 5;
        const int qt = w >> 1, eh = w & 1;
        int b, h, n; dec(uid, b, h, n);
        const float lg = log2_gamma(h);
        const size_t row0 = (size_t)b * SEQ + 128 * n;
        out_write(G, uid, lds, tid);
        bf16x8 qr[4];
#pragma unroll
        for (int ks = 0; ks < 4; ++ks) qr[ks] = __builtin_bit_cast(bf16x8, G.q[ks]);
        __syncthreads();
        if (uid + 1 < u_hi) out_load(G, uid + 1, proj, ret, otid());
        f32x16 o[2];
#pragma unroll
        for (int r = 0; r < 16; ++r) { o[0][r] = 0.f; o[1][r] = 0.f; }
#pragma unroll
        for (int ks = 0; ks < 4; ++ks)
#pragma unroll
            for (int t = 0; t < 2; ++t) { const bf16x8 rf = tr_nat(lds + O_R + (2 * eh + t) * RS, ks, lane); o[t] = __builtin_amdgcn_mfma_f32_32x32x16_bf16(qr[ks], rf, o[t], 0, 0, 0); }
        float dk[16];
#pragma unroll
        for (int r = 0; r < 16; ++r) dk[r] = fast_exp2(-lg * (float)crow(r, hi));
#pragma unroll
        for (int kt = 0; kt < 4; ++kt) if (kt <= qt) {
            const int uk = 32 * kt + q;
            f32x16 s;
#pragma unroll
            for (int r = 0; r < 16; ++r) s[r] = 0.f;
#pragma unroll
            for (int ks = 0; ks < 4; ++ks) { const bf16x8 kf = *(const LAS bf16x8*)(lds + O_K + 128 * uk + 16 * ((2 * ks + hi) ^ ((uk >> 1) & 7)));
                s = __builtin_amdgcn_mfma_f32_32x32x16_bf16(kf, qr[ks], s, 0, 0, 0); }
            { const float fk = fast_exp2(-lg * (float)(32 * kt));
              if (kt == qt) {
#pragma unroll
                for (int r = 0; r < 16; ++r) s[r] = (crow(r, hi) <= q) ? s[r] * (dk[r] * fk) : 0.f;
              } else {
#pragma unroll
                for (int r = 0; r < 16; ++r) s[r] = s[r] * (dk[r] * fk); } }
#pragma unroll
            for (int s2 = 0; s2 < 2; ++s2) { u32x4 pw; pw.x = cvtpk(s[8 * s2 + 0], s[8 * s2 + 1]); pw.y = cvtpk(s[8 * s2 + 2], s[8 * s2 + 3]); pw.z = cvtpk(s[8 * s2 + 4], s[8 * s2 + 5]); pw.w = cvtpk(s[8 * s2 + 6], s[8 * s2 + 7]);
                const bf16x8 pa = __builtin_bit_cast(bf16x8, pw);
#pragma unroll
                for (int t = 0; t < 2; ++t) { const bf16x8 vf = tr_perm(lds + O_V + (2 * eh + t) * VS, 32 * kt + 16 * s2, lane); o[t] = __builtin_amdgcn_mfma_f32_32x32x16_bf16(pa, vf, o[t], 0, 0, 0); } }
        }
        unsigned gq[16];
        { const bf16_t* gb = proj + hm_off(2560, 4, 128, b, h, 128 * n);
#pragma unroll
          for (int k = 0; k < 16; ++k) gq[k] = *(const unsigned*)(gb + (size_t)(16 * w + k) * 128 + 2 * lane); }
        LAS float* st = (LAS float*)(lds + O_ST);
#pragma unroll
        for (int r = 0; r < 16; ++r) { const int qq = 32 * qt + crow(r, hi); const float a = fast_exp2(lg * (float)qq);
#pragma unroll
            for (int t = 0; t < 2; ++t) st[qq * O_LD + 32 * (2 * eh + t) + q] = o[t][r] * a; }
        __syncthreads();
        float rsn;
        { const LAS f32x4* rp = (const LAS f32x4*)(st + (16 * w + (lane >> 2)) * O_LD + 32 * (lane & 3)); float ss = 0.f;
#pragma unroll
          for (int i = 0; i < 8; ++i) { const f32x4 x = rp[i]; ss += (x[0] * x[0] + x[1] * x[1]) + (x[2] * x[2] + x[3] * x[3]); }
          ss += __shfl_xor(ss, 1); ss += __shfl_xor(ss, 2);
          rsn = rsqrtf(ss * (1.0f / 128.0f) + EPS); }
#pragma unroll
        for (int k = 0; k < 16; ++k) { const int rr = 16 * w + k;
            const f32x2 v = *(const LAS f32x2*)(st + rr * O_LD + 2 * lane);
            const float rs = __shfl(rsn, 4 * k);
            const float g0 = bf2f(gq[k] & 0xffffu), g1 = bf2f(gq[k] >> 16);
            *(unsigned*)(omix + (row0 + rr) * D + 512 + h * 128 + 2 * lane) = cvt_pk_bf16(silu_f(g0) * v[0] * rs, silu_f(g1) * v[1] * rs); }
    }
}
}

constexpr int NPH = 14;
__global__ void __launch_bounds__(NWAVES * 64, 2) mk_fwd(Args args) {
    extern __shared__ __attribute__((aligned(16))) unsigned char lds_raw[];
    LAS unsigned char* lds = (LAS unsigned char*)lds_raw;
    volatile LAS unsigned* MISC = (volatile LAS unsigned*)(lds + MISC_OFF);
    const int wave = __builtin_amdgcn_readfirstlane((int)threadIdx.x >> 6);
#define tid (otid())
#define lane (otid() & 63)
    const int G = gridDim.x; const int bx = blockIdx.x;
    const bool grouped = (G % 8 == 0) && (NBATCH % 8 == 0);
    const int NGRP = grouped ? 8 : 1, grp = grouped ? bx % 8 : 0, GL = G / NGRP, BPG = NBATCH / NGRP;
    const int lv = grouped ? bx / 8 : ((G % 8 == 0) ? (bx % 8) * (G / 8) + bx / 8 : bx);
    const int lc = grouped ? bx / 8 : bx;
    const int b0 = grp * BPG, Mg = BPG * SEQ; const size_t rowb = (size_t)b0 * SEQ;
    const int vcu = (G % 8 == 0) ? (bx % 8) * (G / 8) + bx / 8 : bx;
    const int gw = vcu * NWAVES + wave, NGW = G * NWAVES;
    const int gwl = lv * NWAVES + wave, NGWL = GL * NWAVES;
    unsigned char* ws = args.ws;
    unsigned* ctl = (unsigned*)(ws + WS_CTL);
    for (int u = tid; u < (LDS_BYTES - LDSCTL_OFF) / 4; u += NWAVES * 64) ((LAS unsigned*)(lds + LDSCTL_OFF))[u] = 0u;
    __syncthreads();
    XcdBarrier bar_all = xcd_barrier_post(ctl + CW_BAR + 8 * XCD_BAR_WORDS, MISC + 10, (unsigned)G);
    XcdBarrier bar = xcd_barrier_post(ctl + CW_BAR + grp * XCD_BAR_WORDS, MISC + 8, (unsigned)GL);
    const int lo = args.ph_lo, hi = args.ph_hi;
#define IN(k) (lo <= (k) && (k) < hi)
#define SEAM(k) do { if (IN(k) && IN((k) + 1)) xcd_barrier(bar); } while (0)

#define XIN ((const float*)args.in[0])
#define MEMIN ((const float*)args.in[1])
#define W1in ((bf16_t*)(ws + WS_W1IN))
#define W1out ((bf16_t*)(ws + WS_W1OUT))
#define Win ((bf16_t*)(ws + WS_WIN))
#define Wout ((bf16_t*)(ws + WS_WOUT))
#define Wcq ((bf16_t*)(ws + WS_WCQ))
#define Wckv ((bf16_t*)(ws + WS_WCKV))
#define Wco ((bf16_t*)(ws + WS_WCO))
#define W2in ((bf16_t*)(ws + WS_W2IN))
#define W2out ((bf16_t*)(ws + WS_W2OUT))
#define cosA ((float*)(ws + WS_COSA))
#define sinA ((float*)(ws + WS_SINA))
#define cosR ((float*)(ws + WS_COSR))
#define sinR ((float*)(ws + WS_SINR))
#define MEMN ((bf16_t*)(ws + WS_MEMN))
#define KVC ((bf16_t*)(ws + WS_KC))
#define SSQ ((float*)(ws + WS_SSQ))
#define XB ((bf16_t*)(ws + WS_XB))
#define BIG ((bf16_t*)(ws + WS_BIG))
#define OMIX ((bf16_t*)(ws + WS_OMIX))
#define QC ((bf16_t*)(ws + WS_BIG))
#define ATTP ((bf16_t*)(ws + WS_ATT))
#define LSE ((float*)(ws + WS_ATT + (size_t)M * 512 * 2 * 3))
#define RETB ((float*)(ws + WS_RET))
#define RETH ((bf16_t*)(ws + WS_RETH))
#define xres (args.xres)
    if (IN(0)) { asm volatile(".p2align 8");
        LAS float* scr = (LAS float*)(lds + RING_OFF + wave * 16384);
        constexpr int I0 = (D / 64) * (2 * DFF / 32), I1 = (DFF / 64) * (D / 32), I2 = (D / 64) * (INC / 32), I3 = (D / 64) * (D / 32), I5 = (D / 64) * (2 * D / 32);
        constexpr int NITEMS = 2 * I0 + 2 * I1 + I2 + 3 * I3 + I5;
        for (int it = gw; it < NITEMS; it += NGW) {
            int r = it;
            if (r < I0) { p0_transpose_item(args.in[3], D, 2 * DFF, W1in, 0, nullptr, scr, r, lane); continue; } r -= I0;
            if (r < I1) { p0_transpose_item(args.in[4], DFF, D, W1out, 1, nullptr, scr, r, lane); continue; } r -= I1;
            if (r < I2) { p0_transpose_item(args.in[6], D, INC, Win, 2, args.in[5], scr, r, lane); continue; } r -= I2;
            if (r < I3) { p0_transpose_item(args.in[7], D, D, Wout, 3, nullptr, scr, r, lane); continue; } r -= I3;
            if (r < I3) { p0_transpose_item(args.in[10], D, D, Wcq, 4, args.in[8], scr, r, lane); continue; } r -= I3;
            if (r < I5) { p0_transpose_item(args.in[11], D, 2 * D, Wckv, 5, nullptr, scr, r, lane); continue; } r -= I5;
            if (r < I3) { p0_transpose_item(args.in[12], D, D, Wco, 6, nullptr, scr, r, lane); continue; } r -= I3;
            if (r < I0) { p0_transpose_item(args.in[14], D, 2 * DFF, W2in, 7, args.in[13], scr, r, lane); continue; } r -= I0;
            p0_transpose_item(args.in[15], DFF, D, W2out, 8, nullptr, scr, r, lane);
        }
        for (int m = gw; m < M; m += 4 * NGW) rms_row4_to_bf16(XIN, args.in[2], XB, m, NGW, M, lane);
        for (int m = gw; m < MROWS; m += NGW) rms_row_to_bf16(MEMIN + (size_t)m * D, args.in[9], MEMN + (size_t)m * D, lane);
    }
    if (IN(0) && IN(1)) xcd_barrier(bar_all);
    if (IN(1)) { asm volatile(".p2align 8");
        pg8::Gemm g{XB + rowb * D, W1in, D, 32, D, 0, (size_t)(2 * DFF) * 64}; pg8::StaticOrder S; S.init(Mg, 2 * DFF, GL, lc, D, 32); S.flat = grouped;
        pg8::EpiSwiGLU<false> E{BIG + rowb * INC, nullptr, (size_t)Mg * 32};
        pg8::gemm_phase<pg8::EpiSwiGLU<false>, pg8::StaticOrder, true>(lds + RING_OFF, g, S, E);
    }
    SEAM(1);
    if (IN(2)) { asm volatile(".p2align 8");
        pg8::Gemm g{BIG + rowb * INC, W1out, 32, 32, DFF, (size_t)Mg * 64, (size_t)(D) * 64}; pg8::StaticOrder S; S.init(Mg, D, GL, lc, 32, 32); S.flat = grouped;
        pg8::EpiResid<0> E{XIN + rowb * D, nullptr, XB + rowb * D, SSQ + rowb};
        pg8::gemm_phase<pg8::EpiResid<0>, pg8::StaticOrder, true>(lds + RING_OFF, g, S, E);
    }
    SEAM(2);
    if (IN(3)) { asm volatile(".p2align 8");
        pg8::Gemm g{XB + rowb * D, Win, D, 32, D, 0, (size_t)(INC) * 64}; pg8::StaticOrder S; S.init(Mg, INC, GL, lc, D, 32); S.flat = grouped;
        pg8::EpiInProj E{BIG + rowb * INC, SSQ + rowb, cosA, sinA, cosR, sinR};
        pg8::gemm_phase<pg8::EpiInProj, pg8::StaticOrder, true>(lds + RING_OFF, g, S, E);
    }
    SEAM(3);
    if (IN(4)) { asm volatile(".p2align 8");
        const int nkvg = BPG * 8;
        { pg8::Gemm g{MEMN + (size_t)b0 * MEMLEN * D, Wckv, D, 32, D, 0, (size_t)(2 * D) * 64}; pg8::StaticOrder S; S.init(BPG * MEMLEN, 2 * D, GL, lv, D, 32); S.flat = grouped;
          pg8::EpiPlain<false> E{KVC + (size_t)b0 * MEMLEN * 2 * D, 2 * D, nullptr};
          pg8::gemm_phase<pg8::EpiPlain<false>, pg8::StaticOrder, true>(lds + RING_OFF, g, S, E); }
        { da::UnitMap U;
          if (grouped) U.init(grp, lv, GL, BPG * 8, (GL == 32 && nkvg == 8) ? 8 : 0);
          else if (G % 8 == 0) U.init(vcu / (G / 8), vcu % (G / 8), G / 8, NBATCH, 0);
          else U.init(0, vcu, G, NBATCH * 8, 0);
          da::phase(lds, BIG, ATTP, LSE, U); }
        { const int nunits = BPG * 4 * 64; const int per = (nunits + GL - 1) / GL; const int u0 = lv * per, u1 = (u0 + per < nunits) ? u0 + per : nunits;
          rt::kv_phase(lds, BIG, RETB, b0 * 256 + u0, b0 * 256 + u1); }
    }
    SEAM(4);
    if (IN(5)) { asm volatile(".p2align 8"); rt::scan(RETB, RETH, b0, BPG, lv * NWAVES * 64 + tid, GL * NWAVES * 64); da::merge(ATTP, LSE, OMIX, (int)rowb, Mg, lv * NWAVES * 64 + tid, GL * NWAVES * 64); }
    SEAM(5);
    if (IN(6)) { asm volatile(".p2align 8"); const int nunits = BPG * 4 * 64; const int per = (nunits + GL - 1) / GL; const int u0 = lv * per, u1 = (u0 + per < nunits) ? u0 + per : nunits;
        rt::out_phase(lds, BIG, RETH, OMIX, b0 * 256 + u0, b0 * 256 + u1, tid); }
    SEAM(6);
    if (IN(7)) { asm volatile(".p2align 8");
        pg8::Gemm g{OMIX + rowb * D, Wout, D, 32, D, 0, (size_t)(D) * 64}; pg8::StaticOrder S; S.init(Mg, D, GL, lc, D, 32); S.flat = grouped;
        pg8::EpiResid<1> E{nullptr, nullptr, XB + rowb * D, SSQ + rowb};
        pg8::gemm_phase<pg8::EpiResid<1>, pg8::StaticOrder, true>(lds + RING_OFF, g, S, E);
    }
    SEAM(7);
    if (IN(8)) { asm volatile(".p2align 8");
        pg8::Gemm g{XB + rowb * D, Wcq, D, 32, D, 0, (size_t)(D) * 64}; pg8::StaticOrder S; S.init(Mg, D, GL, lc, D, 32); S.flat = grouped;
        pg8::EpiPlain<true> E{QC + rowb * INC, INC, SSQ + rowb};
        pg8::gemm_phase<pg8::EpiPlain<true>, pg8::StaticOrder, true>(lds + RING_OFF, g, S, E);
    }
    SEAM(8);
    if (IN(9)) { asm volatile(".p2align 8"); const int nunits = BPG * 4 * 32; const int per = (nunits + GL - 1) / GL; const int u0 = lv * per, u1 = (u0 + per < nunits) ? u0 + per : nunits;
        xa::phase(lds, QC, KVC, OMIX, b0 * 128 + u0, b0 * 128 + u1, tid); }
    SEAM(9);
    if (IN(10)) { asm volatile(".p2align 8");
        pg8::Gemm g{OMIX + rowb * D, Wco, D, 32, D, 0, (size_t)(D) * 64}; pg8::StaticOrder S; S.init(Mg, D, GL, lc, D, 32); S.flat = grouped;
        pg8::EpiResid<1> E{nullptr, nullptr, XB + rowb * D, SSQ + rowb};
        pg8::gemm_phase<pg8::EpiResid<1>, pg8::StaticOrder, true>(lds + RING_OFF, g, S, E);
    }
    SEAM(10);
    if (IN(11)) { asm volatile(".p2align 8");
        pg8::Gemm g{XB + rowb * D, W2in, D, 32, D, 0, (size_t)(2 * DFF) * 64}; pg8::StaticOrder S; S.init(Mg, 2 * DFF, GL, lc, D, 32); S.flat = grouped;
        pg8::EpiSwiGLU<true> E{BIG + rowb * INC, SSQ + rowb, (size_t)Mg * 32};
        pg8::gemm_phase<pg8::EpiSwiGLU<true>, pg8::StaticOrder, true>(lds + RING_OFF, g, S, E);
    }
    SEAM(11);
    if (IN(12)) { asm volatile(".p2align 8");
        pg8::Gemm g{BIG + rowb * INC, W2out, 32, 32, DFF, (size_t)Mg * 64, (size_t)(D) * 64}; pg8::StaticOrder S; S.init(Mg, D, GL, lc, 32, 32); S.flat = grouped;
        pg8::EpiResid<1> E{nullptr, nullptr, XB + rowb * D, SSQ + rowb};
        pg8::gemm_phase<pg8::EpiResid<1>, pg8::StaticOrder, true>(lds + RING_OFF, g, S, E);
    }
    SEAM(12);
    if (IN(13)) { asm volatile(".p2align 8");
        const float* wf = args.in[16];
        const int ln = lane;
        f32x4 wv[4];
#pragma unroll
        for (int k = 0; k < 4; ++k) wv[k] = ((const f32x4*)wf)[64 * k + ln];
        for (int mm = gwl; mm < Mg; mm += 4 * NGWL) {
            u32x2 xv[4][4]; f32x4 p[4];
#pragma unroll
            for (int q = 0; q < 4; ++q) { const int mq = mm + q * NGWL; const size_t m = rowb + (mq < Mg ? mq : mm);
                p[q] = (f32x4){SSQ[m], SSQ[(size_t)M + m], SSQ[2 * (size_t)M + m], SSQ[3 * (size_t)M + m]};
#pragma unroll
                for (int k = 0; k < 4; ++k) xv[q][k] = ((const u32x2*)(XB + m * D))[64 * k + ln]; }
#pragma unroll
            for (int q = 0; q < 4; ++q) { const int mq = mm + q * NGWL; if (mq < Mg) { const size_t m = rowb + mq;
                const float r = rsqrtf(((p[q][0] + p[q][1]) + (p[q][2] + p[q][3])) * (1.f / D) + EPS);
                f32x4* orow = (f32x4*)(xres + m * D);
#pragma unroll
                for (int k = 0; k < 4; ++k) { const u32x2 w = xv[q][k]; const f32x4 o = {bf2f(w[0] & 0xffffu), bf2f(w[0] >> 16), bf2f(w[1] & 0xffffu), bf2f(w[1] >> 16)};
                    orow[64 * k + ln] = o * r * wv[k]; } } }
        }
    }
#undef IN
#undef SEAM
#undef tid
#undef lane
#undef XIN
#undef MEMIN
#undef W1in
#undef W1out
#undef Win
#undef Wout
#undef Wcq
#undef Wckv
#undef Wco
#undef W2in
#undef W2out
#undef cosA
#undef sinA
#undef cosR
#undef sinR
#undef MEMN
#undef KVC
#undef SSQ
#undef XB
#undef BIG
#undef OMIX
#undef QC
#undef ATTP
#undef LSE
#undef RETB
#undef RETH
#undef xres
}


extern "C" void kernel_launch(void* const* d_in, const int* in_sizes, int n_in, void* d_out, int out_size, void* d_ws, size_t ws_size, hipStream_t stream) {
    static int grid = 0;
    if (grid == 0) {
        int dev = 0, cus = 0, per_cu = 0;
        if (n_in != 17 || ws_size < WS_OPT_END) { fprintf(stderr, "kernel_launch: unexpected inputs (n_in %d, ws %zu < %zu)\n", n_in, ws_size, (size_t)WS_OPT_END); grid = -1; return; }
        if (hipGetDevice(&dev) != hipSuccess || hipDeviceGetAttribute(&cus, hipDeviceAttributeMultiprocessorCount, dev) != hipSuccess) { grid = -1; return; }
        if (hipFuncSetAttribute((const void*)mk_fwd, hipFuncAttributeMaxDynamicSharedMemorySize, LDS_BYTES) != hipSuccess) { fprintf(stderr, "kernel_launch: hipFuncSetAttribute failed\n"); grid = -1; return; }
        if (hipOccupancyMaxActiveBlocksPerMultiprocessor(&per_cu, (const void*)mk_fwd, NWAVES * 64, LDS_BYTES) != hipSuccess || per_cu < 1) { fprintf(stderr, "kernel_launch: occupancy query says %d blocks per CU\n", per_cu); (void)hipGetLastError(); grid = -1; return; }
        grid = cus;
    }
    if (grid < 0) return;
    (void)hipMemsetAsync((char*)d_ws + WS_CTL, 0, CTL_ZERO_BYTES, stream);
    Args a{};
    for (int i = 0; i < 17; ++i) a.in[i] = (const float*)d_in[i];
    a.out = (float*)d_out; a.ws = (unsigned char*)d_ws;
    a.xres = (float*)d_out; a.ph_lo = 0; a.ph_hi = NPH;
    hipLaunchKernelGGL(mk_fwd, dim3(grid), dim3(NWAVES * 64), LDS_BYTES, stream, a);
}
```
